# Optimizing an MI355X kernel written in HIP

```python
import jax, jax.numpy as jnp
from jax import lax
import numpy as np

D_MODEL = 1024
BATCH = 8
SEQ = 4096
DEPTH = 1

HEAD_DIM = 64
N_Q_HEADS = 8
N_KV_HEADS = 2
Q_PER_KV = N_Q_HEADS // N_KV_HEADS
ATTN_WIDTH = N_Q_HEADS * HEAD_DIM
KV_WIDTH = N_KV_HEADS * HEAD_DIM
IDX_HEADS = 4
IDX_DIM = 64
TOPK_MAX = 256
Q_BLOCK = 128
RNN_WIDTH = D_MODEL
RNN_BLOCKS = 16
RNN_BLOCK_DIM = RNN_WIDTH // RNN_BLOCKS
CONV_WIDTH = 4
LRU_C = 8.0
D_FF = 2816
FFN_CONV_WIDTH = 3
EPS = 1e-6

IN_WIDTHS = (ATTN_WIDTH, KV_WIDTH, KV_WIDTH, IDX_HEADS * IDX_DIM, IDX_DIM, IDX_HEADS,
             RNN_WIDTH, RNN_WIDTH, D_MODEL, D_MODEL)
IN_TOTAL = ATTN_WIDTH + 2 * KV_WIDTH + IDX_HEADS * IDX_DIM + IDX_DIM + IDX_HEADS + 2 * RNN_WIDTH + 2 * D_MODEL

kernel_name = "hybrid_dsa_rglru_convffn"


def rms_norm(x, g):
    xf = x.astype(jnp.float32)
    y = xf * lax.rsqrt(jnp.mean(xf * xf, axis=-1, keepdims=True) + EPS)
    return (y * g.astype(jnp.float32)).astype(x.dtype)


def causal_dwconv(x, w, b):
    K = w.shape[0]
    L = x.shape[1]
    xp = jnp.pad(x, ((0, 0), (K - 1, 0), (0, 0)))
    y = b
    for j in range(K):
        y = y + w[j] * xp[:, j:j + L]
    return y


def dsa_attention(q, k, v, qi, ki, wi, top_k):
    B, L = q.shape[0], q.shape[1]
    nblk = L // Q_BLOCK

    def to_blocks(a):
        return jnp.moveaxis(a.reshape((B, nblk, Q_BLOCK) + a.shape[2:]), 1, 0)

    key_pos = jnp.arange(L)
    gather = jax.vmap(lambda src, idx: src[idx])

    def one_block(args):
        blk, q_b, qi_b, wi_b = args
        q_pos = blk * Q_BLOCK + jnp.arange(Q_BLOCK)
        causal = key_pos[None, :] <= q_pos[:, None]
        rel = jax.nn.relu(jnp.einsum('bqhd,bsd->bqhs', qi_b, ki).astype(jnp.float32))
        score = jnp.einsum('bqh,bqhs->bqs', wi_b.astype(jnp.float32), rel)
        score = jnp.where(causal[None], score, -jnp.inf)
        _, sel = lax.top_k(score, top_k)
        valid = sel <= q_pos[None, :, None]
        k_sel = gather(k, sel)
        v_sel = gather(v, sel)
        qg = q_b.reshape(B, Q_BLOCK, N_KV_HEADS, Q_PER_KV, HEAD_DIM)
        logits = jnp.einsum('bqgrd,bqkgd->bqgrk', qg, k_sel).astype(jnp.float32) * (HEAD_DIM ** -0.5)
        logits = jnp.where(valid[:, :, None, None, :], logits, -jnp.inf)
        p = jax.nn.softmax(logits, axis=-1).astype(v.dtype)
        o = jnp.einsum('bqgrk,bqkgd->bqgrd', p, v_sel)
        return o.reshape(B, Q_BLOCK, ATTN_WIDTH)

    out = lax.map(one_block, (jnp.arange(nblk), to_blocks(q), to_blocks(qi), to_blocks(wi)))
    return jnp.moveaxis(out, 0, 1).reshape(B, L, ATTN_WIDTH)


def rg_lru(xc, wa, ba, wx, bx, lam):
    B, L, W = xc.shape
    xb = xc.reshape(B, L, RNN_BLOCKS, RNN_BLOCK_DIM)
    r = jax.nn.sigmoid(jnp.einsum('blnd,nde->blne', xb, wa).reshape(B, L, W) + ba)
    i = jax.nn.sigmoid(jnp.einsum('blnd,nde->blne', xb, wx).reshape(B, L, W) + bx)
    log_a = LRU_C * r.astype(jnp.float32) * jax.nn.log_sigmoid(lam.astype(jnp.float32))
    a = jnp.exp(log_a)
    b = jnp.sqrt(-jnp.expm1(2.0 * log_a)) * (i * xc).astype(jnp.float32)

    def step(h, ab):
        h = ab[0] * h + ab[1]
        return h, h

    _, hs = lax.scan(step, jnp.zeros((B, W), jnp.float32),
                     (jnp.swapaxes(a, 0, 1), jnp.swapaxes(b, 0, 1)))
    return jnp.swapaxes(hs, 0, 1).astype(xc.dtype)


def hybrid_layer(x, top_k, norm1_g, w_in, q_norm_g, k_norm_g, kidx_norm_g,
                 conv_w, conv_b, rg_wa, rg_ba, rg_wx, rg_bx, rg_lambda,
                 w_o_attn, w_o_rnn, w_out, norm2_g, w_up, ffn_conv_w, ffn_conv_b, w_down):
    B, L, _ = x.shape
    xn = rms_norm(x, norm1_g)
    proj = xn @ w_in
    split_points = np.cumsum(IN_WIDTHS)[:-1].tolist()
    q, k, v, qi, ki, wi, rx, rgate, ga, gb = jnp.split(proj, split_points, axis=-1)

    q = rms_norm(q.reshape(B, L, N_Q_HEADS, HEAD_DIM), q_norm_g)
    k = rms_norm(k.reshape(B, L, N_KV_HEADS, HEAD_DIM), k_norm_g)
    v = v.reshape(B, L, N_KV_HEADS, HEAD_DIM)
    qi = qi.reshape(B, L, IDX_HEADS, IDX_DIM) * (IDX_DIM ** -0.5)
    ki = rms_norm(ki, kidx_norm_g)
    wi = wi * (IDX_HEADS ** -0.5)
    attn = dsa_attention(q, k, v, qi, ki, wi, top_k)

    xc = causal_dwconv(rx, conv_w, conv_b)
    rnn = rg_lru(xc, rg_wa, rg_ba, rg_wx, rg_bx, rg_lambda) * jax.nn.gelu(rgate)

    merged = jax.nn.sigmoid(ga) * (attn @ w_o_attn) + jax.nn.sigmoid(gb) * (rnn @ w_o_rnn)
    x = x + merged @ w_out

    u = causal_dwconv(rms_norm(x, norm2_g) @ w_up, ffn_conv_w, ffn_conv_b)
    gate, val = jnp.split(u, [D_FF], axis=-1)
    return x + (jax.nn.silu(gate) * val) @ w_down


def setup_inputs(seed: int = 0) -> dict:
    key = jax.random.key(seed)
    ks = jax.random.split(key, 24)
    f32 = jnp.float32

    def nrm(k, shape, scale):
        return jax.random.normal(k, shape, f32) * scale

    def gain(k, shape):
        return 1.0 + 0.02 * jax.random.normal(k, shape, f32)

    a0 = jax.random.uniform(ks[13], (DEPTH, RNN_WIDTH), f32, 0.9, 0.999)
    s = a0 ** (1.0 / LRU_C)
    rg_lambda = jnp.log(s) - jnp.log1p(-s)
    return {
        "x": jax.random.normal(ks[0], (BATCH, SEQ, D_MODEL), f32),
        "norm1_g": gain(ks[1], (DEPTH, D_MODEL)),
        "w_in": nrm(ks[2], (DEPTH, D_MODEL, IN_TOTAL), D_MODEL ** -0.5),
        "q_norm_g": gain(ks[3], (DEPTH, HEAD_DIM)),
        "k_norm_g": gain(ks[4], (DEPTH, HEAD_DIM)),
        "kidx_norm_g": gain(ks[5], (DEPTH, IDX_DIM)),
        "conv_w": nrm(ks[6], (DEPTH, CONV_WIDTH, RNN_WIDTH), CONV_WIDTH ** -0.5),
        "conv_b": nrm(ks[7], (DEPTH, RNN_WIDTH), 0.01),
        "rg_wa": nrm(ks[8], (DEPTH, RNN_BLOCKS, RNN_BLOCK_DIM, RNN_BLOCK_DIM), RNN_BLOCK_DIM ** -0.5),
        "rg_ba": nrm(ks[9], (DEPTH, RNN_WIDTH), 0.01),
        "rg_wx": nrm(ks[10], (DEPTH, RNN_BLOCKS, RNN_BLOCK_DIM, RNN_BLOCK_DIM), RNN_BLOCK_DIM ** -0.5),
        "rg_bx": nrm(ks[11], (DEPTH, RNN_WIDTH), 0.01),
        "rg_lambda": rg_lambda,
        "w_o_attn": nrm(ks[14], (DEPTH, ATTN_WIDTH, D_MODEL), ATTN_WIDTH ** -0.5),
        "w_o_rnn": nrm(ks[15], (DEPTH, RNN_WIDTH, D_MODEL), RNN_WIDTH ** -0.5),
        "w_out": nrm(ks[16], (DEPTH, D_MODEL, D_MODEL), D_MODEL ** -0.5),
        "norm2_g": gain(ks[17], (DEPTH, D_MODEL)),
        "w_up": nrm(ks[18], (DEPTH, D_MODEL, 2 * D_FF), D_MODEL ** -0.5),
        "ffn_conv_w": nrm(ks[19], (DEPTH, FFN_CONV_WIDTH, 2 * D_FF), FFN_CONV_WIDTH ** -0.5),
        "ffn_conv_b": nrm(ks[20], (DEPTH, 2 * D_FF), 0.01),
        "w_down": nrm(ks[21], (DEPTH, D_FF, D_MODEL), D_FF ** -0.5),
    }


def reference(x, norm1_g, w_in, q_norm_g, k_norm_g, kidx_norm_g, conv_w, conv_b,
              rg_wa, rg_ba, rg_wx, rg_bx, rg_lambda, w_o_attn, w_o_rnn, w_out,
              norm2_g, w_up, ffn_conv_w, ffn_conv_b, w_down):
    L = x.shape[1]
    top_k = min(TOPK_MAX, L // 4)
    h = x
    for l in range(DEPTH):
        h = hybrid_layer(h, top_k, norm1_g[l], w_in[l], q_norm_g[l], k_norm_g[l], kidx_norm_g[l],
                         conv_w[l], conv_b[l], rg_wa[l], rg_ba[l], rg_wx[l], rg_bx[l], rg_lambda[l],
                         w_o_attn[l], w_o_rnn[l], w_out[l], norm2_g[l], w_up[l],
                         ffn_conv_w[l], ffn_conv_b[l], w_down[l])
    return h
```

```cpp
#include <hip/hip_runtime.h>
#include <cstdio>
#include <cstdint>
namespace pg8 {
#define PG8_LAS __attribute__((address_space(3)))
typedef unsigned short bf16_t;
typedef short bf16x8 __attribute__((ext_vector_type(8)));
typedef float f32x4 __attribute__((ext_vector_type(4)));
typedef unsigned u32x4 __attribute__((ext_vector_type(4)));
constexpr int BM = 256, BK = 64, HALF = 128, HTB = HALF * BK * 2  , STAGE_BYTES = 8 * HTB, NXCD = 8, WGM = 8;

__host__ __device__ __forceinline__ int lds_byte(int r, int c) { const int st = (r >> 4) * 2 + (c >> 5), rr = r & 15, cc = c & 31, ob = rr * 64 + cc * 2; return st * 1024 + (ob ^ (((ob >> 9) & 1) << 5)); }
__host__ __device__ __forceinline__ void stage_rc(int b, int& R, int& C) { const int st = b / 1024, sb = b % 1024, swz = sb ^ (((sb >> 9) & 1) << 5); R = (st >> 1) * 16 + swz / 64; C = (st & 1) * 32 + (swz % 64) / 2; }
__host__ __device__ __forceinline__ int perm32(int rho) { const int n = rho >> 4, i = rho & 15; return 8 * (i >> 2) + 4 * n + (i & 3); }

struct Unit { int pm, pn; };
struct Gemm { const bf16_t* A; const bf16_t* Bt; int M, N, K; };

struct StaticOrder {
    int nM, nN, nwg, G, c;
    __host__ __device__ void init(int M, int N, int G_, int c_) { nM = M / BM; nN = N / BM; nwg = nM * nN; G = G_; c = c_; }
    __host__ __device__ bool next(int i, Unit& u) const {
        const long L = (long)i * G + c; if (L >= nwg) return false;
        int wgid = (int)L; { const int q = nwg / NXCD, r = nwg % NXCD, xcd = wgid % NXCD, off = wgid / NXCD; wgid = (xcd < r ? xcd * (q + 1) : r * (q + 1) + (xcd - r) * q) + off; }
        const int nig = WGM * nN, gid = wgid / nig, fm = gid * WGM, gsz = (nM - fm) < WGM ? (nM - fm) : WGM;
        u.pm = fm + ((wgid % nig) % gsz); u.pn = (wgid % nig) / gsz; return true;
    }
    __device__ __forceinline__ void a_ready(const Unit&) const {}
    __device__ __forceinline__ void done(const Unit&) const {}
};

__device__ __forceinline__ unsigned cvt_pk_bf16(float lo, float hi) { unsigned r; asm volatile("v_cvt_pk_bf16_f32 %0, %1, %2" : "=v"(r) : "v"(lo), "v"(hi)); return r; }
typedef float f32x2 __attribute__((ext_vector_type(2)));
__device__ __forceinline__ f32x2 gelu_pk(f32x2 v) {
    const f32x2 av = __builtin_elementwise_abs(v), d = av * 0.2316418882f + 1.0f;
    f32x2 t; t.x = __builtin_amdgcn_rcpf(d.x); t.y = __builtin_amdgcn_rcpf(d.y);
    f32x2 q = t * 0.5307027145f + (-0.7265760135f); q = q * t + 0.7107068705f; q = q * t + (-0.142248368f); q = q * t + 0.127414796f; q = q * t;
    const f32x2 s = (v * v) * (-0.72134752044f);
    f32x2 e; e.x = __builtin_amdgcn_exp2f(s.x); e.y = __builtin_amdgcn_exp2f(s.y);
    const f32x2 m = v * (q * e), r = v - m;
    f32x2 o; o.x = v.x < 0.f ? m.x : r.x; o.y = v.y < 0.f ? m.y : r.y; return o;
}

template <int ACT  > struct EpiBf16 {
    static constexpr bool PERM = true, AFTER_DRAIN = false; static_assert(ACT == 0 || ACT == 1, "EpiBf16: ACT is 0 (none) or 1 (gelu_pk)");
    bf16_t* O; int ldc; const float* bias; int split_cols; size_t split_stride; float scale0;
    __device__ __forceinline__ void operator()(const f32x4 (&acc)[2][2][4][2], const Unit& u, int wr, int wc, int fr, int fq) const {
        const int row0 = u.pm * BM + wr * 64 + fr; int colt = u.pn * BM; bf16_t* base = O;
        float sc = 1.f; if (split_cols) { const int t = colt / split_cols; base += (size_t)t * split_stride; colt -= t * split_cols; if (t == 0) sc = scale0; }
        const int col0 = colt + wc * 32 + 8 * fq, bcol0 = u.pn * BM + wc * 32 + 8 * fq;
        f32x4 bv[2][2];
#pragma unroll
        for (int bj = 0; bj < 2; ++bj)
#pragma unroll
            for (int n = 0; n < 2; ++n) bv[bj][n] = bias ? *(const f32x4*)(bias + bcol0 + bj * HALF + 4 * n) : (f32x4){0.f, 0.f, 0.f, 0.f};
#pragma unroll
        for (int ai = 0; ai < 2; ++ai)
#pragma unroll
            for (int m = 0; m < 4; ++m) { bf16_t* rowp = base + (size_t)(row0 + ai * HALF + m * 16) * ldc + col0;
#pragma unroll
                for (int bj = 0; bj < 2; ++bj) { f32x4 v0 = acc[ai][bj][m][0] + bv[bj][0], v1 = acc[ai][bj][m][1] + bv[bj][1];
                    if (ACT == 1) { f32x2 a = gelu_pk((f32x2){v0[0], v0[1]}), b = gelu_pk((f32x2){v0[2], v0[3]}), c = gelu_pk((f32x2){v1[0], v1[1]}), d = gelu_pk((f32x2){v1[2], v1[3]});
                        v0 = (f32x4){a.x, a.y, b.x, b.y}; v1 = (f32x4){c.x, c.y, d.x, d.y}; }
                    v0 = v0 * sc; v1 = v1 * sc; u32x4 w; w.x = cvt_pk_bf16(v0[0], v0[1]); w.y = cvt_pk_bf16(v0[2], v0[3]); w.z = cvt_pk_bf16(v1[0], v1[1]); w.w = cvt_pk_bf16(v1[2], v1[3]);
                    *(u32x4*)(rowp + bj * HALF) = w; } }
    }
};


__device__ __forceinline__ float bf_lo(unsigned u) { return __builtin_bit_cast(float, u << 16); }
__device__ __forceinline__ float bf_hi(unsigned u) { return __builtin_bit_cast(float, u & 0xffff0000u); }
__device__ __forceinline__ float sigmoidf_(float x) { return __builtin_amdgcn_rcpf(1.0f + __expf(-x)); }

struct EpiIn {
    static constexpr bool PERM = true, AFTER_DRAIN = false;
    bf16_t* PA; bf16_t* SEC; size_t sec_stride; const float* rinv;
    __device__ __forceinline__ void operator()(const f32x4 (&acc)[2][2][4][2], const Unit& u, int wr, int wc, int fr, int fq) const {
        const int row0 = u.pm * BM + wr * 64 + fr;
        bf16_t* base; int ldc, colt;
        if (u.pn < 5) { base = PA; ldc = 1280; colt = u.pn * 256; }
        else { const int s = (u.pn - 5) >> 2; base = SEC + (size_t)s * sec_stride; ldc = 1024; colt = ((u.pn - 5) & 3) * 256; }
        const int col0 = colt + wc * 32 + 8 * fq;
#pragma unroll
        for (int ai = 0; ai < 2; ++ai)
#pragma unroll
            for (int m = 0; m < 4; ++m) { const int row = row0 + ai * HALF + m * 16; const float ri = rinv[row]; bf16_t* rowp = base + (size_t)row * ldc + col0;
#pragma unroll
                for (int bj = 0; bj < 2; ++bj) { const f32x4 v0 = acc[ai][bj][m][0] * ri, v1 = acc[ai][bj][m][1] * ri;
                    u32x4 w; w.x = cvt_pk_bf16(v0[0], v0[1]); w.y = cvt_pk_bf16(v0[2], v0[3]); w.z = cvt_pk_bf16(v1[0], v1[1]); w.w = cvt_pk_bf16(v1[2], v1[3]);
                    *(u32x4*)(rowp + bj * HALF) = w; } }
    }
};
struct EpiPlain {
    static constexpr bool PERM = true, AFTER_DRAIN = false;
    bf16_t* O; int ldc;
    __device__ __forceinline__ void operator()(const f32x4 (&acc)[2][2][4][2], const Unit& u, int wr, int wc, int fr, int fq) const {
        const int row0 = u.pm * BM + wr * 64 + fr, col0 = u.pn * BM + wc * 32 + 8 * fq;
#pragma unroll
        for (int ai = 0; ai < 2; ++ai)
#pragma unroll
            for (int m = 0; m < 4; ++m) { bf16_t* rowp = O + (size_t)(row0 + ai * HALF + m * 16) * ldc + col0;
#pragma unroll
                for (int bj = 0; bj < 2; ++bj) { const f32x4 v0 = acc[ai][bj][m][0], v1 = acc[ai][bj][m][1];
                    u32x4 w; w.x = cvt_pk_bf16(v0[0], v0[1]); w.y = cvt_pk_bf16(v0[2], v0[3]); w.z = cvt_pk_bf16(v1[0], v1[1]); w.w = cvt_pk_bf16(v1[2], v1[3]);
                    *(u32x4*)(rowp + bj * HALF) = w; } }
    }
};
template <int MODE> struct EpiGate {
    static constexpr bool PERM = true, AFTER_DRAIN = false;
    bf16_t* O; const bf16_t* G;
    __device__ __forceinline__ void operator()(const f32x4 (&acc)[2][2][4][2], const Unit& u, int wr, int wc, int fr, int fq) const {
        const int row0 = u.pm * BM + wr * 64 + fr, col0 = u.pn * BM + wc * 32 + 8 * fq;
#pragma unroll
        for (int ai = 0; ai < 2; ++ai)
#pragma unroll
            for (int m = 0; m < 4; ++m) { const size_t off = (size_t)(row0 + ai * HALF + m * 16) * 1024 + col0;
#pragma unroll
                for (int bj = 0; bj < 2; ++bj) { const u32x4 g = *(const u32x4*)(G + off + bj * HALF);
                    const f32x4 a0 = acc[ai][bj][m][0], a1 = acc[ai][bj][m][1];
                    float r[8];
                    r[0] = sigmoidf_(bf_lo(g.x)) * a0[0]; r[1] = sigmoidf_(bf_hi(g.x)) * a0[1]; r[2] = sigmoidf_(bf_lo(g.y)) * a0[2]; r[3] = sigmoidf_(bf_hi(g.y)) * a0[3];
                    r[4] = sigmoidf_(bf_lo(g.z)) * a1[0]; r[5] = sigmoidf_(bf_hi(g.z)) * a1[1]; r[6] = sigmoidf_(bf_lo(g.w)) * a1[2]; r[7] = sigmoidf_(bf_hi(g.w)) * a1[3];
                    if (MODE == 1) { const u32x4 p = *(const u32x4*)(O + off + bj * HALF);
                        r[0] += bf_lo(p.x); r[1] += bf_hi(p.x); r[2] += bf_lo(p.y); r[3] += bf_hi(p.y); r[4] += bf_lo(p.z); r[5] += bf_hi(p.z); r[6] += bf_lo(p.w); r[7] += bf_hi(p.w); }
                    u32x4 w; w.x = cvt_pk_bf16(r[0], r[1]); w.y = cvt_pk_bf16(r[2], r[3]); w.z = cvt_pk_bf16(r[4], r[5]); w.w = cvt_pk_bf16(r[6], r[7]);
                    *(u32x4*)(O + off + bj * HALF) = w; } }
    }
};
struct EpiRes {
    static constexpr bool PERM = false, AFTER_DRAIN = false;
    const float* X; float* OUT; bf16_t* XB; float* SSQ;
    __device__ __forceinline__ void operator()(const f32x4 (&acc)[2][2][4][2], const Unit& u, int wr, int wc, int fr, int fq) const {
        typedef unsigned u32x2v __attribute__((ext_vector_type(2)));
        const int row0 = u.pm * BM + wr * 64 + fr, col0 = u.pn * BM + wc * 32 + 4 * fq;
#pragma unroll
        for (int ai = 0; ai < 2; ++ai)
#pragma unroll
            for (int m = 0; m < 4; ++m) { const int row = row0 + ai * HALF + m * 16; const size_t off = (size_t)row * 1024 + col0; float s = 0.f;
#pragma unroll
                for (int bj = 0; bj < 2; ++bj)
#pragma unroll
                    for (int n = 0; n < 2; ++n) { const f32x4 xv = *(const f32x4*)(X + off + bj * HALF + n * 16); const f32x4 o = xv + acc[ai][bj][m][n];
                        *(f32x4*)(OUT + off + bj * HALF + n * 16) = o; s += (o[0] * o[0] + o[1] * o[1]) + (o[2] * o[2] + o[3] * o[3]);
                        u32x2v w; w.x = cvt_pk_bf16(o[0], o[1]); w.y = cvt_pk_bf16(o[2], o[3]); *(u32x2v*)(XB + off + bj * HALF + n * 16) = w; }
                s += __shfl_xor(s, 16); s += __shfl_xor(s, 32);
                if (fq == 0) SSQ[(size_t)row * 16 + u.pn * 4 + wc] = s; }
    }
};
struct EpiAcc {
    static constexpr bool PERM = false, AFTER_DRAIN = false;
    float* OUT;
    __device__ __forceinline__ void operator()(const f32x4 (&acc)[2][2][4][2], const Unit& u, int wr, int wc, int fr, int fq) const {
        const int row0 = u.pm * BM + wr * 64 + fr, col0 = u.pn * BM + wc * 32 + 4 * fq;
#pragma unroll
        for (int ai = 0; ai < 2; ++ai)
#pragma unroll
            for (int m = 0; m < 4; ++m) { const size_t off = (size_t)(row0 + ai * HALF + m * 16) * 1024 + col0;
#pragma unroll
                for (int bj = 0; bj < 2; ++bj)
#pragma unroll
                    for (int n = 0; n < 2; ++n) { float* p = OUT + off + bj * HALF + n * 16; *(f32x4*)p = *(const f32x4*)p + acc[ai][bj][m][n]; } }
    }
};
template <class Epi, class Sched, bool ALIGN_EPI = false, bool SP2 = false>
__device__ __forceinline__ void gemm_phase(PG8_LAS unsigned char* lds, const Gemm g, const Sched& S, const Epi& E) {
    const int tid = threadIdx.x, wid = __builtin_amdgcn_readfirstlane(tid >> 6), lane = tid & 63, wr = wid >> 2, wc = wid & 3, fr = lane & 15, fq = lane >> 4;
    const int K = g.K, nt = K / BK;
    unsigned voffA[2], voffB[2];
#pragma unroll
    for (int i = 0; i < 2; ++i) { int R, C; stage_rc(tid * 16 + i * 8192, R, C); const int Rb = Epi::PERM ? ((R & ~31) + perm32(R & 31)) : R;
        voffA[i] = (unsigned)(R * K + C) * 2u; voffB[i] = (unsigned)(Rb * K + C) * 2u; }
    const size_t kstep = (size_t)(BK * 2);
    const size_t hstep = (size_t)HALF * K * 2;
    const size_t tstep = 2 * hstep;
    const unsigned ldsw = (unsigned)wid * 1024u;
    const int aoff = lds_byte(wr * 64 + fr, fq * 8), boff = lds_byte(wc * 32 + fr, fq * 8);
#define PG8_SA(b, h) (((b) * 2 + (h)) * HTB)
#define PG8_SB(b, h) ((4 + (b) * 2 + (h)) * HTB)
#define PG8_STAGE(bufoff, gbase, voff) do { _Pragma("unroll") for (int _i = 0; _i < 2; ++_i) \
        __builtin_amdgcn_global_load_lds((const unsigned*)((const char*)(gbase) + (voff)[_i]), (PG8_LAS unsigned*)(lds + (bufoff) + ldsw + _i * 8192), 16, 0, 0); } while (0)
#define PG8_LDA(dst, b, h) do { _Pragma("unroll") for (int m = 0; m < 4; ++m) _Pragma("unroll") for (int k = 0; k < 2; ++k) dst[m][k] = *(const PG8_LAS bf16x8*)(lds + PG8_SA(b, h) + aoff + m * 2048 + k * 1024); } while (0)
#define PG8_LDB(dst, b, h) do { _Pragma("unroll") for (int n = 0; n < 2; ++n) _Pragma("unroll") for (int k = 0; k < 2; ++k) dst[n][k] = *(const PG8_LAS bf16x8*)(lds + PG8_SB(b, h) + boff + n * 2048 + k * 1024); } while (0)
#define PG8_MMA(ai, bj, At, Bt) do { __builtin_amdgcn_s_setprio(1); _Pragma("unroll") for (int m = 0; m < 4; ++m) _Pragma("unroll") for (int n = 0; n < 2; ++n) _Pragma("unroll") for (int k = 0; k < 2; ++k) \
        acc[ai][bj][m][n] = __builtin_amdgcn_mfma_f32_16x16x32_bf16(Bt[n][k], At[m][k], acc[ai][bj][m][n], 0, 0, 0); __builtin_amdgcn_s_setprio(0); } while (0)
#define PG8_WAIT_V(n) asm volatile("s_waitcnt vmcnt(" #n ")" ::: "memory")
#define PG8_WAIT_L(n) asm volatile("s_waitcnt lgkmcnt(" #n ")" ::: "memory")
#define PG8_BAR __builtin_amdgcn_s_barrier()
#define PG8_SCHED __builtin_amdgcn_sched_barrier(0)
    Unit cur, nxt; int ui = 0;
    if (!S.next(0, cur)) return;
    f32x4 acc[2][2][4][2];
#pragma unroll
    for (int a = 0; a < 2; ++a)
#pragma unroll
        for (int b = 0; b < 2; ++b)
#pragma unroll
            for (int m = 0; m < 4; ++m)
#pragma unroll
                for (int n = 0; n < 2; ++n) acc[a][b][m][n] = (f32x4){0.f, 0.f, 0.f, 0.f};
    bf16x8 At[4][2], B0[2][2], B1[2][2];
    const char* cA = (const char*)g.A + (size_t)cur.pm * tstep; const char* cB = (const char*)g.Bt + (size_t)cur.pn * tstep;
    S.a_ready(cur);
    if constexpr (SP2) {
        PG8_STAGE(PG8_SB(0, 0), cB, voffB); PG8_STAGE(PG8_SB(0, 1), cB + hstep, voffB); PG8_STAGE(PG8_SA(0, 0), cA, voffA); PG8_STAGE(PG8_SA(0, 1), cA + hstep, voffA);
        if (wr == 1) PG8_BAR;
        PG8_WAIT_V(2); PG8_BAR;
        PG8_STAGE(PG8_SB(1, 0), cB + kstep, voffB); PG8_STAGE(PG8_SA(1, 0), cA + kstep, voffA); PG8_STAGE(PG8_SB(1, 1), cB + hstep + kstep, voffB);
        PG8_WAIT_V(6); PG8_BAR;
    } else {
        PG8_STAGE(PG8_SB(0, 0), cB, voffB); PG8_STAGE(PG8_SA(0, 0), cA, voffA); PG8_STAGE(PG8_SB(0, 1), cB + hstep, voffB); PG8_STAGE(PG8_SA(0, 1), cA + hstep, voffA);
        if (wr == 1) PG8_BAR;
        PG8_WAIT_V(4); PG8_BAR;
        PG8_STAGE(PG8_SB(1, 0), cB + kstep, voffB); PG8_STAGE(PG8_SA(1, 0), cA + kstep, voffA); PG8_STAGE(PG8_SB(1, 1), cB + hstep + kstep, voffB);
        PG8_WAIT_V(6); PG8_BAR;
    }
    for (;;) {
        const bool has_next = S.next(ui + 1, nxt);
        const char* nA = has_next ? (const char*)g.A + (size_t)nxt.pm * tstep : cA; const char* nB = has_next ? (const char*)g.Bt + (size_t)nxt.pn * tstep : cB;
        for (int t = 0; t < nt; t += 2) {
            const bool last = (t == nt - 2);
            const char* a1 = cA + (size_t)(t + 1) * kstep;
            const char* a2 = last ? nA : cA + (size_t)(t + 2) * kstep; const char* b2 = last ? nB : cB + (size_t)(t + 2) * kstep;
            const char* a3 = a2 + kstep; const char* b3 = b2 + kstep;
            if (last && has_next) S.a_ready(nxt);
            if constexpr (SP2) {
            PG8_LDB(B0, 0, 0); PG8_LDB(B1, 0, 1); PG8_SCHED; PG8_LDA(At, 0, 0); PG8_STAGE(PG8_SA(1, 1), a1 + hstep, voffA);
            PG8_WAIT_V(8); PG8_WAIT_L(0); PG8_BAR; PG8_MMA(0, 0, At, B0); PG8_MMA(0, 1, At, B1); PG8_BAR; PG8_SCHED;
            PG8_LDA(At, 0, 1); PG8_STAGE(PG8_SB(0, 0), b2, voffB); PG8_STAGE(PG8_SB(0, 1), b2 + hstep, voffB); PG8_STAGE(PG8_SA(0, 0), a2, voffA);
            PG8_WAIT_V(8); PG8_WAIT_L(0); PG8_BAR; PG8_MMA(1, 0, At, B0); PG8_MMA(1, 1, At, B1); PG8_BAR; PG8_SCHED;
            PG8_LDB(B0, 1, 0); PG8_LDB(B1, 1, 1); PG8_SCHED; PG8_LDA(At, 1, 0); PG8_STAGE(PG8_SA(0, 1), a2 + hstep, voffA);
            PG8_WAIT_V(8); PG8_WAIT_L(0); PG8_BAR; PG8_MMA(0, 0, At, B0); PG8_MMA(0, 1, At, B1); PG8_BAR; PG8_SCHED;
            PG8_LDA(At, 1, 1); PG8_STAGE(PG8_SB(1, 0), b3, voffB); PG8_STAGE(PG8_SB(1, 1), b3 + hstep, voffB); PG8_STAGE(PG8_SA(1, 0), a3, voffA);
            PG8_WAIT_V(8); PG8_WAIT_L(0); PG8_BAR; PG8_MMA(1, 0, At, B0); PG8_MMA(1, 1, At, B1); PG8_BAR; PG8_SCHED;
            } else {
            PG8_LDB(B0, 0, 0); PG8_SCHED; PG8_LDA(At, 0, 0); PG8_STAGE(PG8_SA(1, 1), a1 + hstep, voffA);
            PG8_WAIT_L(8); PG8_BAR; PG8_WAIT_L(0); PG8_MMA(0, 0, At, B0); PG8_BAR; PG8_SCHED;
            PG8_LDB(B1, 0, 1); PG8_STAGE(PG8_SB(0, 0), b2, voffB);
            PG8_BAR; PG8_WAIT_L(0); PG8_MMA(0, 1, At, B1); PG8_BAR;
            PG8_LDA(At, 0, 1); PG8_STAGE(PG8_SA(0, 0), a2, voffA);
            PG8_BAR; PG8_WAIT_L(0); PG8_MMA(1, 0, At, B0); PG8_BAR; PG8_SCHED;
            PG8_STAGE(PG8_SB(0, 1), b2 + hstep, voffB);
            PG8_WAIT_V(6); PG8_BAR; PG8_MMA(1, 1, At, B1); PG8_BAR;
            PG8_LDB(B0, 1, 0); PG8_SCHED; PG8_LDA(At, 1, 0); PG8_STAGE(PG8_SA(0, 1), a2 + hstep, voffA);
            PG8_WAIT_L(8); PG8_BAR; PG8_WAIT_L(0); PG8_MMA(0, 0, At, B0); PG8_BAR; PG8_SCHED;
            PG8_LDB(B1, 1, 1); PG8_STAGE(PG8_SB(1, 0), b3, voffB);
            PG8_BAR; PG8_WAIT_L(0); PG8_MMA(0, 1, At, B1); PG8_BAR;
            PG8_LDA(At, 1, 1); PG8_STAGE(PG8_SA(1, 0), a3, voffA);
            PG8_BAR; PG8_WAIT_L(0); PG8_MMA(1, 0, At, B0); PG8_BAR; PG8_SCHED;
            PG8_STAGE(PG8_SB(1, 1), b3 + hstep, voffB);
            PG8_WAIT_V(6); PG8_BAR; PG8_MMA(1, 1, At, B1); PG8_BAR;
            }
        }
        if constexpr (ALIGN_EPI) { if (wr == 0) PG8_BAR; }
        if constexpr (!Epi::AFTER_DRAIN) { E(acc, cur, wr, wc, fr, fq); S.done(cur); }
        if (!has_next) break;
#pragma unroll
        for (int a = 0; a < 2; ++a)
#pragma unroll
            for (int b = 0; b < 2; ++b)
#pragma unroll
                for (int m = 0; m < 4; ++m)
#pragma unroll
                    for (int n = 0; n < 2; ++n) acc[a][b][m][n] = (f32x4){0.f, 0.f, 0.f, 0.f};
        cur = nxt; cA = nA; cB = nB; ++ui;
        if constexpr (ALIGN_EPI) { if (wr == 1) PG8_BAR; }
    }
    PG8_WAIT_V(0);
    if constexpr (!ALIGN_EPI) { if (wr == 0) PG8_BAR; }
    PG8_BAR;
    if constexpr (Epi::AFTER_DRAIN) { E.fused(acc, cur, wr, wc, fr, fq, lds, wid, lane); S.done(cur); }
#undef PG8_SA
#undef PG8_SB
#undef PG8_STAGE
#undef PG8_LDA
#undef PG8_LDB
#undef PG8_MMA
#undef PG8_WAIT_V
#undef PG8_WAIT_L
#undef PG8_BAR
#undef PG8_SCHED
}
}
#include <cmath>

constexpr int NWAVES = 8;
constexpr int NB = 8, SEQ = 4096, M = NB * SEQ, DM = 1024;
constexpr int IN_TOTAL = 5188, NIN = 5376;
constexpr int PA_LD = 1280;
constexpr int PA_Q = 0, PA_K = 512, PA_V = 640, PA_QI = 768, PA_KI = 1024, PA_WI = 1088;
constexpr int DFF = 2816, NUP = 2 * DFF;
constexpr float EPS = 1e-6f;
constexpr int TOPK = 256;

#ifndef MK_ONE_LAUNCH
#define MK_ONE_LAUNCH 0
#endif
constexpr int NPH = 16;

constexpr size_t MiB = 1u << 20;
constexpr size_t WS_CTL = 0, CTL_ZERO_BYTES = 1 * MiB;
constexpr size_t WS_WIN = 1 * MiB, WS_WOA = 12 * MiB, WS_WOB = 13 * MiB, WS_WOUT = 15 * MiB, WS_WUP = 17 * MiB, WS_WDN = 28 * MiB;
constexpr size_t WS_RINV1 = 34 * MiB, WS_SSQ2 = 35 * MiB;
constexpr size_t WS_XB = 40 * MiB;
constexpr size_t WS_ATTN = 40 * MiB;
constexpr size_t WS_PA = 104 * MiB;
constexpr size_t WS_RX = 184 * MiB, WS_RGATE = 248 * MiB, WS_GA = 312 * MiB, WS_GB = 376 * MiB;
constexpr size_t WS_MERGED = 104 * MiB;
constexpr size_t WS_X1B = 312 * MiB;
constexpr size_t WS_RNN = 440 * MiB;
constexpr size_t WS_H = 40 * MiB;
constexpr size_t WS_RAW = 216 * MiB;
constexpr size_t WS_END = 504 * MiB;
static_assert(WS_WIN + (size_t)NIN * 1024 * 2 <= WS_WOA && WS_WUP + (size_t)NUP * 1024 * 2 <= WS_WDN && WS_WDN + (size_t)1024 * DFF * 2 <= WS_RINV1, "weights map");
static_assert(WS_H + (size_t)M * DFF * 2 <= WS_RAW && WS_RAW + (size_t)(M / 4) * NUP * 2 <= WS_X1B, "ffn map");
constexpr int CW_BAR = 4096;

constexpr int RING_OFF = 0, RING_BYTES = 131072;
constexpr int PHASE_LDS = 159744;
constexpr int LDSCTL_OFF = PHASE_LDS, MISC_OFF = LDSCTL_OFF + 320;
constexpr int LDS_BYTES = 160256 + 256;
static_assert(MISC_OFF + 128 <= LDS_BYTES && LDS_BYTES <= 163840, "LDS map");
#define GAS __attribute__((address_space(1)))
#define LAS __attribute__((address_space(3)))
typedef unsigned short bf16;
typedef unsigned v4u __attribute__((ext_vector_type(4)));
typedef float f32x4 __attribute__((ext_vector_type(4)));
typedef short bf16x8 __attribute__((ext_vector_type(8)));
typedef GAS unsigned gu32;
typedef GAS unsigned long long gu64;
#define RLX_AGENT __ATOMIC_RELAXED, __HIP_MEMORY_SCOPE_AGENT
#define LDS_WAIT() asm volatile("s_waitcnt lgkmcnt(0)" ::: "memory")
#define VM_WAIT() asm volatile("s_waitcnt vmcnt(0)" ::: "memory")
__device__ __forceinline__ unsigned long long rt() { return __builtin_amdgcn_s_memrealtime(); }
__device__ __forceinline__ unsigned f2bf(float f) { unsigned u = __builtin_bit_cast(unsigned, f); return (u + 0x7fffu + ((u >> 16) & 1u)) >> 16; }
__device__ __forceinline__ unsigned pk2(float lo, float hi) { return f2bf(lo) | (f2bf(hi) << 16); }

#define XB_TMO      128
#define XB_XCNT(j)  (256  + 64 * (j))
#define XB_XSUB(j)  (1280 + 64 * (j))
#define XB_XGEN(j)  (2304 + 64 * (j))
#define XB_TOP      3328
#define XB_TOPGEN   3392
#define XCD_BAR_WORDS 3456
#define XB_SPIN_CAP (1u << 18)

__device__ __forceinline__ unsigned xb_ld(unsigned* p)              { return __hip_atomic_load(p, __ATOMIC_RELAXED, __HIP_MEMORY_SCOPE_AGENT); }
__device__ __forceinline__ unsigned xb_add(unsigned* p, unsigned v) { return __hip_atomic_fetch_add(p, v, __ATOMIC_RELAXED, __HIP_MEMORY_SCOPE_AGENT); }
__device__ __forceinline__ unsigned xb_xcc_id() { return (unsigned)__builtin_amdgcn_s_getreg((3 << 11) | 20) & 0xFu; }
#define XB_SPIN(cond, bar) do { unsigned _sp = 0; while (cond) { __builtin_amdgcn_s_sleep(1); \
    if ((++_sp & 255u) == 0u) { if (xb_ld(&(bar)[XB_TMO])) break; if (_sp > XB_SPIN_CAP) { atomicAdd(&(bar)[XB_TMO], 1u); break; } } } } while (0)

struct XcdBarrier {
    unsigned* bar; unsigned x;
    volatile LAS unsigned* st;
};

__device__ __forceinline__ XcdBarrier xcd_barrier_post(unsigned* bar, volatile LAS unsigned* st) {
    XcdBarrier b; b.bar = bar; b.x = xb_xcc_id(); b.st = st;
    if (threadIdx.x == 0) (void)xb_add(&bar[XB_XCNT(b.x)], 1u);
    return b;
}
__device__ __forceinline__ void xcd_barrier_complete(unsigned* bar, unsigned x, unsigned& nloc, unsigned& nx) {
    const unsigned G = gridDim.x * gridDim.y * gridDim.z;
    unsigned sum, cnt, mine, sp = 0u;
    for (;;) {
        sum = 0u; cnt = 0u; mine = 0u;
#pragma unroll
        for (unsigned j = 0; j < 16; ++j) { const unsigned c = xb_ld(&bar[XB_XCNT(j)]); sum += c; cnt += (c > 0u) ? 1u : 0u; mine = (j == x) ? c : mine; }
        if (sum == G) break;
        __builtin_amdgcn_s_sleep(1);
        if ((++sp & 255u) == 0u) { if (xb_ld(&bar[XB_TMO])) break; if (sp > XB_SPIN_CAP) { atomicAdd(&bar[XB_TMO], 1u); break; } }
    }
    nloc = mine > 0u ? mine : 1u; nx = cnt > 0u ? cnt : 1u;
}

__device__ __forceinline__ void xcd_barrier(const XcdBarrier& b) {
    asm volatile("s_waitcnt vmcnt(0)" ::: "memory");
    __syncthreads();
    if (threadIdx.x == 0) {
        unsigned* bar = b.bar;
        __builtin_amdgcn_s_waitcnt(0);
        unsigned nloc = b.st[0], nx = b.st[1];
        if (nloc == 0u) { xcd_barrier_complete(bar, b.x, nloc, nx); b.st[0] = nloc; b.st[1] = nx; }
        const unsigned old = xb_add(&bar[XB_XSUB(b.x)], 1u);
        const unsigned gen = old / nloc;
        if (old + 1u == (gen + 1u) * nloc) {
            __builtin_amdgcn_fence(__ATOMIC_RELEASE, "agent");
            asm volatile("s_waitcnt vmcnt(0)" ::: "memory");
            const unsigned og = xb_add(&bar[XB_TOP], 1u);
            const unsigned tg = og / nx;
            if (og + 1u == (tg + 1u) * nx) xb_add(&bar[XB_TOPGEN], 1u);
            else XB_SPIN(xb_ld(&bar[XB_TOPGEN]) == tg, bar);
            __builtin_amdgcn_fence(__ATOMIC_ACQUIRE, "agent");
            xb_add(&bar[XB_XGEN(b.x)], 1u);
            asm volatile("s_waitcnt vmcnt(0)" ::: "memory");
        } else {
            XB_SPIN(xb_ld(&bar[XB_XGEN(b.x)]) == gen, bar);
            __builtin_amdgcn_fence(__ATOMIC_ACQUIRE, "agent");
            asm volatile("s_waitcnt vmcnt(0)" ::: "memory");
        }
    }
    __syncthreads();
}

struct Frame {
    LAS unsigned char* lds;
    volatile LAS unsigned* MISC;
    gu32* ctl;
    int tid, lane, wave;
    int vcu, G;
    const float* in[21]; float* out; unsigned char* ws;
};
__device__ __forceinline__ float wave_sum(float v) {
#pragma unroll
    for (int o = 1; o < 64; o <<= 1) v += __shfl_xor(v, o);
    return v;
}
__device__ __forceinline__ int wave_sum_i(int v) {
#pragma unroll
    for (int o = 1; o < 64; o <<= 1) v += __shfl_xor(v, o);
    return v;
}
__device__ __forceinline__ float wave_max(float v) {
#pragma unroll
    for (int o = 1; o < 64; o <<= 1) v = fmaxf(v, __shfl_xor(v, o));
    return v;
}
__device__ __forceinline__ float bf2f(unsigned short h) { return __builtin_bit_cast(float, (unsigned)h << 16); }
__device__ __forceinline__ float bflo(unsigned u) { return __builtin_bit_cast(float, u << 16); }
__device__ __forceinline__ float bfhi(unsigned u) { return __builtin_bit_cast(float, u & 0xffff0000u); }
__device__ __forceinline__ float sigmoid_f(float x) { return 1.0f / (1.0f + __expf(-x)); }
__device__ __forceinline__ float gelu_tanh_f(float x) { const float u = 0.7978845608028654f * (x + 0.044715f * x * x * x); return 0.5f * x * (1.0f + tanhf(u)); }

enum { MAP_ID = 0, MAP_WIN = 1, MAP_WUP = 2 };
__device__ __forceinline__ int src_col(int kind, int n) {
    if (kind == MAP_WIN) return n < 1092 ? n : (n < 1280 ? -1 : n - 188);
    if (kind == MAP_WUP) { const int j = n >> 8, r = n & 255; return r < 128 ? j * 128 + r : DFF + j * 128 + (r - 128); }
    return n;
}
__device__ __forceinline__ void p0_transpose_item(const float* W, int K, int N, int NP, const float* gain, int kind, bf16* WT, LAS float* scr, int item, int lane) {
    const int nblk = NP / 32, kb = item / nblk, nb = item % nblk, k0 = 64 * kb, n0 = 32 * nb;
    const int sc = src_col(kind, n0 + (lane & 31));
#pragma unroll 8
    for (int i = 0; i < 32; ++i) { const int kk = 2 * i + (lane >> 5); float v = 0.f; if (sc >= 0) v = W[(size_t)(k0 + kk) * N + sc]; if (gain) v *= gain[k0 + kk]; scr[kk * 33 + (lane & 31)] = v; }
    LDS_WAIT(); asm volatile("" ::: "memory");
    const int c = lane & 7;
#pragma unroll
    for (int j = 0; j < 4; ++j) { const int n = (lane >> 3) + 8 * j; const LAS float* s = scr + (8 * c) * 33 + n;
        v4u o; o.x = pk2(s[0 * 33], s[1 * 33]); o.y = pk2(s[2 * 33], s[3 * 33]); o.z = pk2(s[4 * 33], s[5 * 33]); o.w = pk2(s[6 * 33], s[7 * 33]);
        *(GAS v4u*)(WT + (size_t)(n0 + n) * K + k0 + 8 * c) = o; }
    LDS_WAIT(); asm volatile("" ::: "memory");
}
__device__ __forceinline__ void p0_prologue(Frame& F) {
    LAS float* scr = (LAS float*)(F.lds + RING_OFF + F.wave * 16384);
    const int gw = F.vcu * NWAVES + F.wave, NGW = F.G * NWAVES;
    constexpr int I_IN = 16 * (NIN / 32), I_OA = 8 * 32, I_OB = 16 * 32, I_OUT = 16 * 32, I_UP = 16 * (NUP / 32), I_DN = (DFF / 64) * 32;
    constexpr int NITEMS = I_IN + I_OA + I_OB + I_OUT + I_UP + I_DN;
    unsigned char* ws = F.ws;
    for (int it = gw; it < NITEMS; it += NGW) {
        int r = it;
        if (r < I_IN) { p0_transpose_item(F.in[2], 1024, IN_TOTAL, NIN, F.in[1], MAP_WIN, (bf16*)(ws + WS_WIN), scr, r, F.lane); continue; } r -= I_IN;
        if (r < I_OA) { p0_transpose_item(F.in[13], 512, 1024, 1024, nullptr, MAP_ID, (bf16*)(ws + WS_WOA), scr, r, F.lane); continue; } r -= I_OA;
        if (r < I_OB) { p0_transpose_item(F.in[14], 1024, 1024, 1024, nullptr, MAP_ID, (bf16*)(ws + WS_WOB), scr, r, F.lane); continue; } r -= I_OB;
        if (r < I_OUT) { p0_transpose_item(F.in[15], 1024, 1024, 1024, nullptr, MAP_ID, (bf16*)(ws + WS_WOUT), scr, r, F.lane); continue; } r -= I_OUT;
        if (r < I_UP) { p0_transpose_item(F.in[17], 1024, NUP, NUP, F.in[16], MAP_WUP, (bf16*)(ws + WS_WUP), scr, r, F.lane); continue; } r -= I_UP;
        p0_transpose_item(F.in[20], DFF, 1024, 1024, nullptr, MAP_ID, (bf16*)(ws + WS_WDN), scr, r, F.lane);
    }
    const float* x = F.in[0]; bf16* xb = (bf16*)(ws + WS_XB); float* rinv1 = (float*)(ws + WS_RINV1);
    for (int m = gw; m < M; m += NGW) {
        const GAS f32x4* xr = (const GAS f32x4*)(x + (size_t)m * DM) + F.lane;
        f32x4 v[4]; float s = 0.f;
#pragma unroll
        for (int j = 0; j < 4; ++j) { v[j] = xr[64 * j]; s += (v[j].x * v[j].x + v[j].y * v[j].y) + (v[j].z * v[j].z + v[j].w * v[j].w); }
        s = wave_sum(s);
        GAS unsigned long long* o8 = (GAS unsigned long long*)(xb + (size_t)m * DM) + F.lane;
#pragma unroll
        for (int j = 0; j < 4; ++j) o8[64 * j] = (unsigned long long)pk2(v[j].x, v[j].y) | ((unsigned long long)pk2(v[j].z, v[j].w) << 32);
        if (F.lane == 0) rinv1[m] = 1.0f / sqrtf(s * (1.0f / DM) + EPS);
    }
}

__device__ __forceinline__ void p2_normalize(Frame& F) {
    const int gw = F.vcu * NWAVES + F.wave, NGW = F.G * NWAVES, lane = F.lane;
    bf16* PA = (bf16*)(F.ws + WS_PA);
    const float* gq = F.in[3]; const float* gk = F.in[4]; const float* gki = F.in[5];
    const int d0 = (lane & 7) * 8;
    float gqv[8], g2v[8];
#pragma unroll
    for (int i = 0; i < 8; ++i) { gqv[i] = gq[d0 + i]; g2v[i] = lane < 16 ? gk[d0 + i] : gki[d0 + i]; }
    int off2 = -1;
    if (lane < 16) off2 = PA_K + lane * 8; else if (lane < 48) off2 = PA_QI + (lane - 16) * 8; else if (lane < 56) off2 = PA_KI + (lane - 48) * 8; else if (lane == 56) off2 = PA_WI;
    for (int m = gw; m < M; m += NGW) {
        bf16* row = PA + (size_t)m * PA_LD;
        {
            v4u u = *(GAS v4u*)(row + lane * 8);
            float f[8] = {bflo(u.x), bfhi(u.x), bflo(u.y), bfhi(u.y), bflo(u.z), bfhi(u.z), bflo(u.w), bfhi(u.w)};
            float ss = 0.f;
#pragma unroll
            for (int i = 0; i < 8; ++i) ss += f[i] * f[i];
            ss += __shfl_xor(ss, 1); ss += __shfl_xor(ss, 2); ss += __shfl_xor(ss, 4);
            const float ri = 1.0f / sqrtf(ss * (1.0f / 64.0f) + EPS);
#pragma unroll
            for (int i = 0; i < 8; ++i) f[i] = f[i] * ri * gqv[i];
            v4u o; o.x = pk2(f[0], f[1]); o.y = pk2(f[2], f[3]); o.z = pk2(f[4], f[5]); o.w = pk2(f[6], f[7]);
            *(GAS v4u*)(row + lane * 8) = o;
        }
        {
            v4u u = {0u, 0u, 0u, 0u};
            if (off2 >= 0) u = *(GAS v4u*)(row + off2);
            float f[8] = {bflo(u.x), bfhi(u.x), bflo(u.y), bfhi(u.y), bflo(u.z), bfhi(u.z), bflo(u.w), bfhi(u.w)};
            float ss = 0.f;
#pragma unroll
            for (int i = 0; i < 8; ++i) ss += f[i] * f[i];
            ss += __shfl_xor(ss, 1); ss += __shfl_xor(ss, 2); ss += __shfl_xor(ss, 4);
            const float ri = 1.0f / sqrtf(ss * (1.0f / 64.0f) + EPS);
            if (lane < 16 || (lane >= 48 && lane < 56)) {
#pragma unroll
                for (int i = 0; i < 8; ++i) f[i] = f[i] * ri * g2v[i];
            } else if (lane < 48) {
#pragma unroll
                for (int i = 0; i < 8; ++i) f[i] *= 0.125f;
            } else {
#pragma unroll
                for (int i = 0; i < 8; ++i) f[i] *= 0.5f;
            }
            v4u o; o.x = pk2(f[0], f[1]); o.y = pk2(f[2], f[3]); o.z = pk2(f[4], f[5]); o.w = pk2(f[6], f[7]);
            if (off2 >= 0) *(GAS v4u*)(row + off2) = o;
        }
    }
}

__device__ __forceinline__ unsigned f2key(float f) { const unsigned u = __builtin_bit_cast(unsigned, f); return (u & 0x80000000u) ? ~u : (u | 0x80000000u); }
constexpr int ATT_WAVE_LDS = 19968;
__device__ __forceinline__ void p3_attention(Frame& F) {
    const int lane = F.lane;
    LAS unsigned* keys = (LAS unsigned*)(F.lds + F.wave * ATT_WAVE_LDS);
    LAS float* qf = (LAS float*)(keys + 4096);
    LAS unsigned short* sel = (LAS unsigned short*)(qf + 512);
    LAS float* pbuf = (LAS float*)keys;
    const bf16* PA = (const bf16*)(F.ws + WS_PA);
    bf16* ATT = (bf16*)(F.ws + WS_ATTN);
    const int gw = F.vcu * NWAVES + F.wave, NGW = F.G * NWAVES;
    const int ksub = lane >> 3, chunk = lane & 7;
    const unsigned long long lt_mask = (lane == 0) ? 0ull : (~0ull >> (64 - lane));
    const int nq_per = (M + NGW - 1) / NGW;
    for (int it = 0; it < nq_per; ++it) {
        int qidx;
        if (NGW == 2048) { const int b = it >> 1; const int t = (it & 1) ? (SEQ - 1 - gw) : gw; qidx = b * SEQ + t; }
        else { qidx = gw + it * NGW; if (qidx >= M) break; }
        const int b = qidx / SEQ, t = qidx % SEQ, n = t + 1;
        const bf16* qrow = PA + (size_t)qidx * PA_LD;
        const bf16* kbase = PA + (size_t)b * SEQ * PA_LD;
        float qi[4][8];
#pragma unroll
        for (int h = 0; h < 4; ++h) { const v4u u = *(const GAS v4u*)(qrow + PA_QI + h * 64 + chunk * 8);
            qi[h][0] = bflo(u.x); qi[h][1] = bfhi(u.x); qi[h][2] = bflo(u.y); qi[h][3] = bfhi(u.y); qi[h][4] = bflo(u.z); qi[h][5] = bfhi(u.z); qi[h][6] = bflo(u.w); qi[h][7] = bfhi(u.w); }
        float wi[4];
        { const unsigned long long w8 = *(const GAS unsigned long long*)(qrow + PA_WI); wi[0] = bflo((unsigned)w8); wi[1] = bfhi((unsigned)w8); wi[2] = bflo((unsigned)(w8 >> 32)); wi[3] = bfhi((unsigned)(w8 >> 32)); }
        { const v4u u = *(const GAS v4u*)(qrow + PA_Q + lane * 8); LAS float* d = qf + lane * 8;
            d[0] = bflo(u.x); d[1] = bfhi(u.x); d[2] = bflo(u.y); d[3] = bfhi(u.y); d[4] = bflo(u.z); d[5] = bfhi(u.z); d[6] = bflo(u.w); d[7] = bfhi(u.w); }
        for (int s0 = 0; s0 < n; s0 += 8) {
            const int s = s0 + ksub; const int sc = s < n ? s : t;
            const v4u u = *(const GAS v4u*)(kbase + (size_t)sc * PA_LD + PA_KI + chunk * 8);
            const float kf[8] = {bflo(u.x), bfhi(u.x), bflo(u.y), bfhi(u.y), bflo(u.z), bfhi(u.z), bflo(u.w), bfhi(u.w)};
            float a[4];
#pragma unroll
            for (int h = 0; h < 4; ++h) { float x = 0.f;
#pragma unroll
                for (int e = 0; e < 8; ++e) x += kf[e] * qi[h][e];
                x += __shfl_xor(x, 1); x += __shfl_xor(x, 2); x += __shfl_xor(x, 4); a[h] = x; }
            float score = wi[0] * fmaxf(a[0], 0.f) + wi[1] * fmaxf(a[1], 0.f) + wi[2] * fmaxf(a[2], 0.f) + wi[3] * fmaxf(a[3], 0.f);
            score += 0.0f;
            if (chunk == 0 && s < n) keys[s] = f2key(score);
        }
        int nsel;
        if (n > TOPK) {
            unsigned prefix = 0u;
            for (int bit = 31; bit >= 0; --bit) {
                const unsigned cand = prefix | (1u << bit);
                int cnt = 0;
                for (int s = lane; s < n; s += 64) cnt += (keys[s] >= cand) ? 1 : 0;
                cnt = wave_sum_i(cnt);
                if (cnt >= TOPK) prefix = cand;
            }
            const unsigned tau = prefix;
            int cgt = 0;
            for (int s = lane; s < n; s += 64) cgt += (keys[s] > tau) ? 1 : 0;
            cgt = wave_sum_i(cgt);
            const int need = TOPK - cgt;
            int base = 0, eqseen = 0;
            for (int s0 = 0; s0 < n; s0 += 64) {
                const int s = s0 + lane; const bool in = s < n; const unsigned k = in ? keys[s] : 0u;
                const bool gt = in && k > tau, eq = in && k == tau;
                const unsigned long long beq = __ballot(eq);
                const int rank_eq = eqseen + __popcll(beq & lt_mask);
                const bool take = gt || (eq && rank_eq < need);
                const unsigned long long bs = __ballot(take);
                if (take) sel[base + __popcll(bs & lt_mask)] = (unsigned short)s;
                base += __popcll(bs); eqseen += __popcll(beq);
            }
            nsel = TOPK;
        } else {
            for (int j = lane; j < n; j += 64) sel[j] = (unsigned short)j;
            nsel = n;
        }
#pragma unroll 1
        for (int jj = 0; jj < 4; ++jj) {
            const int j = lane + 64 * jj; const bool ok = j < nsel; const int s = ok ? (int)sel[j] : 0;
            const bf16* kr = kbase + (size_t)s * PA_LD + PA_K;
            float acc8[8];
#pragma unroll
            for (int h = 0; h < 8; ++h) acc8[h] = 0.f;
#pragma unroll
            for (int g = 0; g < 2; ++g)
#pragma unroll 1
                for (int c = 0; c < 8; ++c) {
                    asm volatile("" ::: "memory");
                    const v4u u = *(const GAS v4u*)(kr + g * 64 + c * 8);
                    const float kf[8] = {bflo(u.x), bfhi(u.x), bflo(u.y), bfhi(u.y), bflo(u.z), bfhi(u.z), bflo(u.w), bfhi(u.w)};
#pragma unroll
                    for (int r = 0; r < 4; ++r) { const LAS float* qp = qf + (g * 4 + r) * 64 + c * 8; float x = acc8[g * 4 + r];
#pragma unroll
                        for (int e = 0; e < 8; ++e) x += kf[e] * qp[e];
                        acc8[g * 4 + r] = x; }
                }
#pragma unroll
            for (int h = 0; h < 8; ++h) pbuf[h * 256 + j] = ok ? acc8[h] * 0.125f : -INFINITY;
        }
#pragma unroll 1
        for (int h = 0; h < 8; ++h) {
            float l4[4];
#pragma unroll
            for (int jj = 0; jj < 4; ++jj) l4[jj] = pbuf[h * 256 + lane + 64 * jj];
            float mx = fmaxf(fmaxf(l4[0], l4[1]), fmaxf(l4[2], l4[3]));
            mx = wave_max(mx);
            float e[4], sum = 0.f;
#pragma unroll
            for (int jj = 0; jj < 4; ++jj) { e[jj] = __expf(l4[jj] - mx); sum += e[jj]; }
            sum = wave_sum(sum);
            const float inv = 1.0f / sum;
#pragma unroll
            for (int jj = 0; jj < 4; ++jj) pbuf[h * 256 + lane + 64 * jj] = e[jj] * inv;
        }
        float o[8];
#pragma unroll
        for (int h = 0; h < 8; ++h) o[h] = 0.f;
        for (int j = 0; j < nsel; ++j) {
            const int s = (int)sel[j];
            const bf16* vr = kbase + (size_t)s * PA_LD + PA_V;
            const float v0 = bf2f(vr[lane]), v1 = bf2f(vr[64 + lane]);
#pragma unroll
            for (int h = 0; h < 4; ++h) { o[h] += pbuf[h * 256 + j] * v0; o[4 + h] += pbuf[(4 + h) * 256 + j] * v1; }
        }
        bf16* orow = ATT + (size_t)qidx * 512;
#pragma unroll
        for (int h = 0; h < 8; ++h) orow[h * 64 + lane] = (bf16)f2bf(o[h]);
    }
}

__device__ __forceinline__ void p4_rglru(Frame& F) {
    const int tid = F.tid, lane = F.lane;
    LAS float* wa = (LAS float*)(F.lds);
    LAS float* wx = wa + 4096;
    LAS float* xc = wx + 4096;
    LAS float* at = xc + 4096;
    LAS float* bt = at + 4096;
    const bf16* RX = (const bf16*)(F.ws + WS_RX); const bf16* RG = (const bf16*)(F.ws + WS_RGATE); bf16* RNN = (bf16*)(F.ws + WS_RNN);
    const float* conv_w = F.in[6]; const float* conv_b = F.in[7]; const float* rg_wa = F.in[8]; const float* rg_ba = F.in[9]; const float* rg_wx = F.in[10]; const float* rg_bx = F.in[11]; const float* lam = F.in[12];
    for (int task = F.vcu; task < NB * 16; task += F.G) {
        const int b = task >> 4, nb = task & 15, c0 = nb * 64;
        __syncthreads();
        for (int i = tid; i < 4096; i += NWAVES * 64) { wa[i] = rg_wa[(size_t)nb * 4096 + i]; wx[i] = rg_wx[(size_t)nb * 4096 + i]; }
        const int e = lane, tg = F.wave;
        const int c = c0 + e;
        const float cw0 = conv_w[c], cw1 = conv_w[1024 + c], cw2 = conv_w[2048 + c], cw3 = conv_w[3072 + c], cb = conv_b[c];
        const float ba = rg_ba[c], bx = rg_bx[c];
        const float lsl = -log1pf(__expf(-lam[c]));
        float hstate = 0.f;
        __syncthreads();
        for (int ch = 0; ch < SEQ / 64; ++ch) {
            const int t0 = ch * 64 + tg * 8;
            float xv[11];
#pragma unroll
            for (int i = 0; i < 11; ++i) { const int t = t0 - 3 + i; xv[i] = t >= 0 ? bf2f(RX[((size_t)b * SEQ + t) * 1024 + c]) : 0.f; }
#pragma unroll
            for (int i = 0; i < 8; ++i) xc[(tg * 8 + i) * 64 + e] = cb + cw0 * xv[i] + cw1 * xv[i + 1] + cw2 * xv[i + 2] + cw3 * xv[i + 3];
            __syncthreads();
            float ra[8], ia[8];
#pragma unroll
            for (int i = 0; i < 8; ++i) { ra[i] = ba; ia[i] = bx; }
            for (int d = 0; d < 64; ++d) { const float wav = wa[d * 64 + e], wxv = wx[d * 64 + e];
#pragma unroll
                for (int i = 0; i < 8; ++i) { const float xd = xc[(tg * 8 + i) * 64 + d]; ra[i] += xd * wav; ia[i] += xd * wxv; } }
#pragma unroll
            for (int i = 0; i < 8; ++i) { const float r = sigmoid_f(ra[i]), ig = sigmoid_f(ia[i]);
                const float la = 8.0f * r * lsl; const float a = __expf(la); const float bb = sqrtf(-expm1f(2.0f * la)) * (ig * xc[(tg * 8 + i) * 64 + e]);
                at[(tg * 8 + i) * 64 + e] = a; bt[(tg * 8 + i) * 64 + e] = bb; }
            __syncthreads();
            if (F.wave == 0) {
#pragma unroll 8
                for (int k = 0; k < 64; ++k) { hstate = at[k * 64 + e] * hstate + bt[k * 64 + e]; at[k * 64 + e] = hstate; }
            }
            __syncthreads();
#pragma unroll
            for (int i = 0; i < 8; ++i) { const size_t off = ((size_t)b * SEQ + t0 + i) * 1024 + c; const float g = bf2f(RG[off]); RNN[off] = (bf16)f2bf(at[(tg * 8 + i) * 64 + e] * gelu_tanh_f(g)); }
        }
    }
}

__device__ __forceinline__ void p_convact(Frame& F, int quarter) {
    const bf16* RAW = (const bf16*)(F.ws + WS_RAW); bf16* H = (bf16*)(F.ws + WS_H); const float* SSQ = (const float*)(F.ws + WS_SSQ2);
    const float* fw = F.in[18]; const float* fb = F.in[19];
    const int MQ = M / 4, row_base = quarter * MQ;
    const long nitems = (long)MQ * (DFF / 8);
    const long gt = (long)F.vcu * (NWAVES * 64) + F.tid, NGT = (long)F.G * NWAVES * 64;
    for (long it = gt; it < nitems; it += NGT) {
        const int rl = (int)(it / (DFF / 8)), c8 = (int)(it % (DFF / 8)) * 8;
        const int row = row_base + rl, tl = row % SEQ;
        const int rawcol = (c8 >> 7) * 256 + (c8 & 127);
        float yg[8], yv[8];
#pragma unroll
        for (int i = 0; i < 8; ++i) { yg[i] = fb[c8 + i]; yv[i] = fb[DFF + c8 + i]; }
#pragma unroll
        for (int j = 0; j < 3; ++j) {
            const int dt = j - 2;
            if (tl + dt < 0) continue;
            const int r2 = rl + dt, rg = row + dt;
            float ss = 0.f;
#pragma unroll
            for (int q = 0; q < 4; ++q) { const f32x4 p = *(const GAS f32x4*)(SSQ + (size_t)rg * 16 + q * 4); ss += (p.x + p.y) + (p.z + p.w); }
            const float ri = 1.0f / sqrtf(ss * (1.0f / DM) + EPS);
            const v4u ug = *(const GAS v4u*)(RAW + (size_t)r2 * NUP + rawcol), uv = *(const GAS v4u*)(RAW + (size_t)r2 * NUP + rawcol + 128);
            const float g8[8] = {bflo(ug.x), bfhi(ug.x), bflo(ug.y), bfhi(ug.y), bflo(ug.z), bfhi(ug.z), bflo(ug.w), bfhi(ug.w)};
            const float v8[8] = {bflo(uv.x), bfhi(uv.x), bflo(uv.y), bfhi(uv.y), bflo(uv.z), bfhi(uv.z), bflo(uv.w), bfhi(uv.w)};
#pragma unroll
            for (int i = 0; i < 8; ++i) { yg[i] += fw[j * NUP + c8 + i] * (g8[i] * ri); yv[i] += fw[j * NUP + DFF + c8 + i] * (v8[i] * ri); }
        }
        float hh[8];
#pragma unroll
        for (int i = 0; i < 8; ++i) hh[i] = yg[i] * sigmoid_f(yg[i]) * yv[i];
        v4u o; o.x = pk2(hh[0], hh[1]); o.y = pk2(hh[2], hh[3]); o.z = pk2(hh[4], hh[5]); o.w = pk2(hh[6], hh[7]);
        *(GAS v4u*)(H + (size_t)row * DFF + c8) = o;
    }
}

struct Args { const float* in[21]; float* out; unsigned char* ws; int ph_lo, ph_hi; };
static_assert(sizeof(Args) == 23 * 8 + 8, "Args has no padding");
__global__ void __launch_bounds__(NWAVES * 64, 2) mk_fwd(Args args) {
    extern __shared__ __attribute__((aligned(16))) unsigned char lds[];
    Frame F;
    F.lds = (LAS unsigned char*)lds;
    F.MISC = (volatile LAS unsigned*)(F.lds + MISC_OFF);
    F.tid = threadIdx.x; F.lane = F.tid & 63; F.wave = __builtin_amdgcn_readfirstlane(F.tid >> 6);
    F.G = gridDim.x; { const int bx = blockIdx.x; F.vcu = (F.G % 8 == 0) ? (bx % 8) * (F.G / 8) + bx / 8 : bx; }
    F.ws = args.ws; F.out = args.out; F.ctl = (gu32*)(args.ws + WS_CTL);
#pragma unroll
    for (int i = 0; i < 21; ++i) F.in[i] = args.in[i];
    for (int u = F.tid; u < (LDS_BYTES - LDSCTL_OFF) / 4; u += NWAVES * 64) ((LAS unsigned*)(F.lds + LDSCTL_OFF))[u] = 0u;
    __syncthreads();
    XcdBarrier bar; bar.bar = (unsigned*)(F.ctl + CW_BAR); bar.x = 0; bar.st = nullptr;
    if (MK_ONE_LAUNCH) bar = xcd_barrier_post((unsigned*)(F.ctl + CW_BAR), F.MISC + 8);
#define GRID_BAR() do { if (MK_ONE_LAUNCH) xcd_barrier(bar); } while (0)
    const int lo = args.ph_lo, hi = args.ph_hi;
#ifndef PHASE_MASK
#define PHASE_MASK 0xFFFF
#endif
#define IN(k) ((((PHASE_MASK) >> (k)) & 1) && lo <= (k) && (k) < hi)
#define BOTH(k) (IN(k) && IN((k) + 1))
    unsigned char* ws = args.ws;
    typedef pg8::bf16_t pbf;

    if (IN(0)) { p0_prologue(F); if (BOTH(0)) GRID_BAR(); }

    if (IN(1)) {
        pg8::Gemm g{(const pbf*)(ws + WS_XB), (const pbf*)(ws + WS_WIN), M, NIN, 1024}; pg8::StaticOrder S; S.init(M, NIN, F.G, (int)blockIdx.x);
        pg8::EpiIn E{(pbf*)(ws + WS_PA), (pbf*)(ws + WS_RX), (size_t)(WS_RGATE - WS_RX) / 2, (const float*)(ws + WS_RINV1)};
        pg8::gemm_phase<pg8::EpiIn, pg8::StaticOrder, true, true>(F.lds + RING_OFF, g, S, E);
        if (BOTH(1)) GRID_BAR();
    }
    if (IN(2)) { p2_normalize(F); if (BOTH(2)) GRID_BAR(); }
    if (IN(3)) { p3_attention(F); }
    if (IN(4)) { p4_rglru(F); if (BOTH(4)) GRID_BAR(); }
    if (IN(5)) {
        { pg8::Gemm g{(const pbf*)(ws + WS_ATTN), (const pbf*)(ws + WS_WOA), M, 1024, 512}; pg8::StaticOrder S; S.init(M, 1024, F.G, (int)blockIdx.x);
          pg8::EpiGate<0> E{(pbf*)(ws + WS_MERGED), (const pbf*)(ws + WS_GA)};
          pg8::gemm_phase<pg8::EpiGate<0>, pg8::StaticOrder, true, true>(F.lds + RING_OFF, g, S, E); }
        VM_WAIT(); __syncthreads();
        { pg8::Gemm g{(const pbf*)(ws + WS_RNN), (const pbf*)(ws + WS_WOB), M, 1024, 1024}; pg8::StaticOrder S; S.init(M, 1024, F.G, (int)blockIdx.x);
          pg8::EpiGate<1> E{(pbf*)(ws + WS_MERGED), (const pbf*)(ws + WS_GB)};
          pg8::gemm_phase<pg8::EpiGate<1>, pg8::StaticOrder, true, true>(F.lds + RING_OFF, g, S, E); }
        if (BOTH(5)) GRID_BAR();
    }
    if (IN(6)) {
        pg8::Gemm g{(const pbf*)(ws + WS_MERGED), (const pbf*)(ws + WS_WOUT), M, 1024, 1024}; pg8::StaticOrder S; S.init(M, 1024, F.G, (int)blockIdx.x);
        pg8::EpiRes E{F.in[0], F.out, (pbf*)(ws + WS_X1B), (float*)(ws + WS_SSQ2)};
        pg8::gemm_phase<pg8::EpiRes, pg8::StaticOrder, true, true>(F.lds + RING_OFF, g, S, E);
        if (BOTH(6)) GRID_BAR();
    }
#pragma unroll 1
    for (int q = 0; q < 4; ++q) {
        if (IN(7 + 2 * q)) {
            pg8::Gemm g{(const pbf*)(ws + WS_X1B) + (size_t)q * (M / 4) * 1024, (const pbf*)(ws + WS_WUP), M / 4, NUP, 1024}; pg8::StaticOrder S; S.init(M / 4, NUP, F.G, (int)blockIdx.x);
            pg8::EpiPlain E{(pbf*)(ws + WS_RAW), NUP};
            pg8::gemm_phase<pg8::EpiPlain, pg8::StaticOrder, true, true>(F.lds + RING_OFF, g, S, E);
            if (BOTH(7 + 2 * q)) GRID_BAR();
        }
        if (IN(8 + 2 * q)) { p_convact(F, q); if (BOTH(8 + 2 * q)) GRID_BAR(); }
    }
    if (IN(15)) {
        pg8::Gemm g{(const pbf*)(ws + WS_H), (const pbf*)(ws + WS_WDN), M, 1024, DFF}; pg8::StaticOrder S; S.init(M, 1024, F.G, (int)blockIdx.x);
        pg8::EpiAcc E{F.out};
        pg8::gemm_phase<pg8::EpiAcc, pg8::StaticOrder, true, true>(F.lds + RING_OFF, g, S, E);
    }
#undef IN
#undef BOTH
}

extern "C" void kernel_launch(void* const* d_in, const int* in_sizes, int n_in, void* d_out, int out_size, void* d_ws, size_t ws_size, hipStream_t stream) {
    static int grid = 0;
    if (grid == 0) {
        if (n_in != 21 || out_size != M * DM || ws_size < WS_END) { fprintf(stderr, "kernel_launch: unexpected shapes: n_in %d out %d ws %zu (need %zu)\n", n_in, out_size, ws_size, (size_t)WS_END); grid = -1; return; }
        int dev = 0, cus = 0;
        if (hipGetDevice(&dev) != hipSuccess || hipDeviceGetAttribute(&cus, hipDeviceAttributeMultiprocessorCount, dev) != hipSuccess) { grid = -1; return; }
        if (hipFuncSetAttribute((const void*)mk_fwd, hipFuncAttributeMaxDynamicSharedMemorySize, LDS_BYTES) != hipSuccess) { fprintf(stderr, "kernel_launch: hipFuncSetAttribute failed\n"); grid = -1; return; }
        (void)hipGetLastError();
        grid = cus;
    }
    if (grid < 0) return;
    if (hipMemsetAsync((char*)d_ws + WS_CTL, 0, CTL_ZERO_BYTES, stream) != hipSuccess) return;
    Args a{};
    for (int i = 0; i < 21; ++i) a.in[i] = (const float*)d_in[i];
    a.out = (float*)d_out; a.ws = (unsigned char*)d_ws;
#if MK_ONE_LAUNCH
    a.ph_lo = 0; a.ph_hi = NPH;
    hipLaunchKernelGGL(mk_fwd, dim3(grid), dim3(NWAVES * 64), LDS_BYTES, stream, a);
#else
    for (int p = 0; p < NPH; ++p) { a.ph_lo = p; a.ph_hi = p + 1; hipLaunchKernelGGL(mk_fwd, dim3(grid), dim3(NWAVES * 64), LDS_BYTES, stream, a); }
#endif
}
```

```cpp
#define STAG_IN 0
#define STAG_UP 0
#define STAG_N 0
#define PG8_KROT 0
#include <hip/hip_runtime.h>
#include <cstdio>
#include <cstdint>
#ifndef PG8_KROT
#define PG8_KROT 1
#endif
#ifndef PG8_WGM
#define PG8_WGM 8
#endif
namespace pg8 {
#define PG8_LAS __attribute__((address_space(3)))
typedef unsigned short bf16_t;
typedef short bf16x8 __attribute__((ext_vector_type(8)));
typedef float f32x4 __attribute__((ext_vector_type(4)));
typedef unsigned u32x4 __attribute__((ext_vector_type(4)));
constexpr int BM = 256, BK = 64, HALF = 128, HTB = HALF * BK * 2  , STAGE_BYTES = 8 * HTB, NXCD = 8, WGM = PG8_WGM;

__host__ __device__ __forceinline__ int lds_byte(int r, int c) { const int st = (r >> 4) * 2 + (c >> 5), rr = r & 15, cc = c & 31, ob = rr * 64 + cc * 2; return st * 1024 + (ob ^ (((ob >> 9) & 1) << 5)); }
__host__ __device__ __forceinline__ void stage_rc(int b, int& R, int& C) { const int st = b / 1024, sb = b % 1024, swz = sb ^ (((sb >> 9) & 1) << 5); R = (st >> 1) * 16 + swz / 64; C = (st & 1) * 32 + (swz % 64) / 2; }
__host__ __device__ __forceinline__ int perm32(int rho) { const int n = rho >> 4, i = rho & 15; return 8 * (i >> 2) + 4 * n + (i & 3); }

struct Unit { int pm, pn; };
struct Gemm { const bf16_t* A; const bf16_t* Bt; int M, N, K; };

struct StaticOrder {
    int nM, nN, nwg, G, c;
    __host__ __device__ void init(int M, int N, int G_, int c_) { nM = M / BM; nN = N / BM; nwg = nM * nN; G = G_; c = c_; }
    __host__ __device__ __forceinline__ bool next(int i, Unit& u) const {
        const long L = (long)i * G + c; if (L >= nwg) return false;
        int wgid = (int)L; { const int q = nwg / NXCD, r = nwg % NXCD, xcd = wgid % NXCD, off = wgid / NXCD; wgid = (xcd < r ? xcd * (q + 1) : r * (q + 1) + (xcd - r) * q) + off; }
        const int nig = WGM * nN, gid = wgid / nig, fm = gid * WGM, gsz = (nM - fm) < WGM ? (nM - fm) : WGM;
        u.pm = fm + ((wgid % nig) % gsz); u.pn = (wgid % nig) / gsz; return true;
    }
    __device__ __forceinline__ void a_ready(const Unit&) const {}
    __device__ __forceinline__ void done(const Unit&) const {}
};

__device__ __forceinline__ unsigned cvt_pk_bf16(float lo, float hi) { unsigned r; asm volatile("v_cvt_pk_bf16_f32 %0, %1, %2" : "=v"(r) : "v"(lo), "v"(hi)); return r; }
typedef float f32x2 __attribute__((ext_vector_type(2)));
__device__ __forceinline__ f32x2 gelu_pk(f32x2 v) {
    const f32x2 av = __builtin_elementwise_abs(v), d = av * 0.2316418882f + 1.0f;
    f32x2 t; t.x = __builtin_amdgcn_rcpf(d.x); t.y = __builtin_amdgcn_rcpf(d.y);
    f32x2 q = t * 0.5307027145f + (-0.7265760135f); q = q * t + 0.7107068705f; q = q * t + (-0.142248368f); q = q * t + 0.127414796f; q = q * t;
    const f32x2 s = (v * v) * (-0.72134752044f);
    f32x2 e; e.x = __builtin_amdgcn_exp2f(s.x); e.y = __builtin_amdgcn_exp2f(s.y);
    const f32x2 m = v * (q * e), r = v - m;
    f32x2 o; o.x = v.x < 0.f ? m.x : r.x; o.y = v.y < 0.f ? m.y : r.y; return o;
}

template <int ACT  > struct EpiBf16 {
    static constexpr int MIDK = 0; static constexpr bool PERM = true, AFTER_DRAIN = false; static_assert(ACT == 0 || ACT == 1, "EpiBf16: ACT is 0 (none) or 1 (gelu_pk)");
    bf16_t* O; int ldc; const float* bias; int split_cols; size_t split_stride; float scale0;
    __device__ __forceinline__ void operator()(const f32x4 (&acc)[2][2][4][2], const Unit& u, int wr, int wc, int fr, int fq) const {
        const int row0 = u.pm * BM + wr * 64 + fr; int colt = u.pn * BM; bf16_t* base = O;
        float sc = 1.f; if (split_cols) { const int t = colt / split_cols; base += (size_t)t * split_stride; colt -= t * split_cols; if (t == 0) sc = scale0; }
        const int col0 = colt + wc * 32 + 8 * fq, bcol0 = u.pn * BM + wc * 32 + 8 * fq;
        f32x4 bv[2][2];
#pragma unroll
        for (int bj = 0; bj < 2; ++bj)
#pragma unroll
            for (int n = 0; n < 2; ++n) bv[bj][n] = bias ? *(const f32x4*)(bias + bcol0 + bj * HALF + 4 * n) : (f32x4){0.f, 0.f, 0.f, 0.f};
#pragma unroll
        for (int ai = 0; ai < 2; ++ai)
#pragma unroll
            for (int m = 0; m < 4; ++m) { bf16_t* rowp = base + (size_t)(row0 + ai * HALF + m * 16) * ldc + col0;
#pragma unroll
                for (int bj = 0; bj < 2; ++bj) { f32x4 v0 = acc[ai][bj][m][0] + bv[bj][0], v1 = acc[ai][bj][m][1] + bv[bj][1];
                    if (ACT == 1) { f32x2 a = gelu_pk((f32x2){v0[0], v0[1]}), b = gelu_pk((f32x2){v0[2], v0[3]}), c = gelu_pk((f32x2){v1[0], v1[1]}), d = gelu_pk((f32x2){v1[2], v1[3]});
                        v0 = (f32x4){a.x, a.y, b.x, b.y}; v1 = (f32x4){c.x, c.y, d.x, d.y}; }
                    v0 = v0 * sc; v1 = v1 * sc; u32x4 w; w.x = cvt_pk_bf16(v0[0], v0[1]); w.y = cvt_pk_bf16(v0[2], v0[3]); w.z = cvt_pk_bf16(v1[0], v1[1]); w.w = cvt_pk_bf16(v1[2], v1[3]);
                    *(u32x4*)(rowp + bj * HALF) = w; } }
    }
};

#ifndef UP_PRE
#define UP_PRE 1
#endif
#ifndef GATE_GELU
#define GATE_GELU 0
#endif
#ifndef GATES_U8
#define GATES_U8 1
#endif
#ifndef MERGE_DEPTH
#define MERGE_DEPTH 3
#endif
#ifndef EPIDUP_IN
#define EPIDUP_IN 0
#endif
#ifndef EPIDUP_MERGE
#define EPIDUP_MERGE 0
#endif
#ifndef EPIDUP_RES
#define EPIDUP_RES 0
#endif
#ifndef EPIDUP_ACC
#define EPIDUP_ACC 0
#endif
#ifndef EPIDUP_UP
#define EPIDUP_UP 0
#endif

__device__ __forceinline__ float bf_lo(unsigned u) { return __builtin_bit_cast(float, u << 16); }
__device__ __forceinline__ float bf_hi(unsigned u) { return __builtin_bit_cast(float, u & 0xffff0000u); }
__device__ __forceinline__ float sigmoidf_(float x) { return __builtin_amdgcn_rcpf(1.0f + __expf(-x)); }

struct EpiIn {
    static constexpr bool PRE = false;
    static constexpr int dup = EPIDUP_IN;
    static constexpr int MIDK = 0; static constexpr bool PERM = true, AFTER_DRAIN = false;
    bf16_t* PA; bf16_t* SEC; size_t sec_stride; const float* rinv; unsigned char* KV; bf16_t* KI; float* WI; const float* gains;
    __device__ __forceinline__ void operator()(const f32x4 (&acc)[2][2][4][2], const Unit& u, int wr, int wc, int fr, int fq) const {
        typedef unsigned u32x2v __attribute__((ext_vector_type(2)));
        asm volatile("" : "+v"(fr), "+v"(fq));
        const int row0 = u.pm * BM + wr * 64 + fr;
        if (u.pn >= 5) {
            const int s = (u.pn - 5) >> 2; bf16_t* base = SEC + (size_t)s * sec_stride; const int col0 = ((u.pn - 5) & 3) * 256 + wc * 32 + 8 * fq;
            if (GATES_U8 && s >= 2) {
                unsigned char* b8 = (unsigned char*)base;
#pragma unroll
                for (int ai = 0; ai < 2; ++ai)
#pragma unroll
                    for (int m = 0; m < 4; ++m) { const int row = row0 + ai * HALF + m * 16; unsigned char* rowp = b8 + (size_t)row * 1024 + col0;
#pragma unroll
                        for (int bj = 0; bj < 2; ++bj) { u32x2v w; w.x = 0u; w.y = 0u;
#pragma unroll
                            for (int i = 0; i < 4; ++i) { w.x = __builtin_amdgcn_cvt_pk_u8_f32(255.0f * sigmoidf_(acc[ai][bj][m][0][i]), i, w.x); w.y = __builtin_amdgcn_cvt_pk_u8_f32(255.0f * sigmoidf_(acc[ai][bj][m][1][i]), i, w.y); }
                            *(u32x2v*)(rowp + bj * HALF) = w; } }
                return;
            }
            const bool gel = GATE_GELU && s == 1;
#pragma unroll
            for (int ai = 0; ai < 2; ++ai)
#pragma unroll
                for (int m = 0; m < 4; ++m) { const int row = row0 + ai * HALF + m * 16; bf16_t* rowp = base + (size_t)row * 1024 + col0;
#pragma unroll
                    for (int bj = 0; bj < 2; ++bj) { f32x4 v0 = acc[ai][bj][m][0], v1 = acc[ai][bj][m][1];
                        if (gel) {
#pragma unroll
                            for (int i = 0; i < 4; ++i) { const float g0 = v0[i], g1 = v1[i]; v0[i] = g0 * sigmoidf_(1.5957691216057308f * (g0 + 0.044715f * g0 * g0 * g0)); v1[i] = g1 * sigmoidf_(1.5957691216057308f * (g1 + 0.044715f * g1 * g1 * g1)); } }
                        u32x4 w; w.x = cvt_pk_bf16(v0[0], v0[1]); w.y = cvt_pk_bf16(v0[2], v0[3]); w.z = cvt_pk_bf16(v1[0], v1[1]); w.w = cvt_pk_bf16(v1[2], v1[3]);
                        *(u32x4*)(rowp + bj * HALF) = w; } }
            return;
        }
        const int H = 4 * u.pn + wc;
        if (H >= 18) return;
        const bool donorm = (H < 10) || (H == 16);
        const float* gp = gains + (H < 8 ? 0 : (H < 10 ? 64 : 128));
        f32x4 g[2][2];
#pragma unroll
        for (int bj = 0; bj < 2; ++bj)
#pragma unroll
            for (int n = 0; n < 2; ++n) g[bj][n] = donorm ? *(const f32x4*)(gp + 32 * bj + 8 * fq + 4 * n) : (f32x4){1.f, 1.f, 1.f, 1.f};
        const float post = (H >= 12 && H < 16) ? 0.125f : (H == 17 ? 0.5f : 1.0f);
#pragma unroll
        for (int ai = 0; ai < 2; ++ai)
#pragma unroll
            for (int m = 0; m < 4; ++m) { const int row = row0 + ai * HALF + m * 16;
                f32x4 v[2][2]; float ss = 0.f;
#pragma unroll
                for (int bj = 0; bj < 2; ++bj)
#pragma unroll
                    for (int n = 0; n < 2; ++n) { v[bj][n] = acc[ai][bj][m][n]; ss += (v[bj][n][0] * v[bj][n][0] + v[bj][n][1] * v[bj][n][1]) + (v[bj][n][2] * v[bj][n][2] + v[bj][n][3] * v[bj][n][3]); }
                ss += __shfl_xor(ss, 16); ss += __shfl_xor(ss, 32);
                const float sc = donorm ? 1.0f / sqrtf(ss * (1.0f / 64.0f) + 1e-6f) : post;
#pragma unroll
                for (int bj = 0; bj < 2; ++bj)
#pragma unroll
                    for (int n = 0; n < 2; ++n) v[bj][n] = v[bj][n] * sc * g[bj][n];
                if (H < 8 || (H >= 12 && H < 16)) {
                    bf16_t* rowp = PA + (size_t)row * 1280 + 64 * H + 8 * fq;
#pragma unroll
                    for (int bj = 0; bj < 2; ++bj) { u32x4 w; w.x = cvt_pk_bf16(v[bj][0][0], v[bj][0][1]); w.y = cvt_pk_bf16(v[bj][0][2], v[bj][0][3]); w.z = cvt_pk_bf16(v[bj][1][0], v[bj][1][1]); w.w = cvt_pk_bf16(v[bj][1][2], v[bj][1][3]);
                        *(u32x4*)(rowp + 32 * bj) = w; }
                } else if (H < 12) {
                    unsigned char* rowp = KV + (size_t)row * 256 + 64 * (H - 8) + 8 * fq;
#pragma unroll
                    for (int bj = 0; bj < 2; ++bj) { int w0 = __builtin_amdgcn_cvt_pk_fp8_f32(v[bj][0][0], v[bj][0][1], 0, false); w0 = __builtin_amdgcn_cvt_pk_fp8_f32(v[bj][0][2], v[bj][0][3], w0, true);
                        int w1 = __builtin_amdgcn_cvt_pk_fp8_f32(v[bj][1][0], v[bj][1][1], 0, false); w1 = __builtin_amdgcn_cvt_pk_fp8_f32(v[bj][1][2], v[bj][1][3], w1, true);
                        u32x2v w; w.x = (unsigned)w0; w.y = (unsigned)w1; *(u32x2v*)(rowp + 32 * bj) = w; }
                } else if (H == 16) {
                    bf16_t* rowp = KI + (size_t)row * 64 + 8 * fq;
#pragma unroll
                    for (int bj = 0; bj < 2; ++bj) { u32x4 w; w.x = cvt_pk_bf16(v[bj][0][0], v[bj][0][1]); w.y = cvt_pk_bf16(v[bj][0][2], v[bj][0][3]); w.z = cvt_pk_bf16(v[bj][1][0], v[bj][1][1]); w.w = cvt_pk_bf16(v[bj][1][2], v[bj][1][3]);
                        *(u32x4*)(rowp + 32 * bj) = w; }
                } else {
                    if (fq == 0) *(f32x4*)(WI + (size_t)row * 4) = v[0][0];
                }
            }
    }
};
struct EpiPlain {
    static constexpr bool PRE = false;
    static constexpr int dup = 0;
    static constexpr int MIDK = 0; static constexpr bool PERM = true, AFTER_DRAIN = false;
    bf16_t* O; int ldc;
    __device__ __forceinline__ void operator()(const f32x4 (&acc)[2][2][4][2], const Unit& u, int wr, int wc, int fr, int fq) const {
        const int row0 = u.pm * BM + wr * 64 + fr, col0 = u.pn * BM + wc * 32 + 8 * fq;
#pragma unroll
        for (int ai = 0; ai < 2; ++ai)
#pragma unroll
            for (int m = 0; m < 4; ++m) { bf16_t* rowp = O + (size_t)(row0 + ai * HALF + m * 16) * ldc + col0;
#pragma unroll
                for (int bj = 0; bj < 2; ++bj) { const f32x4 v0 = acc[ai][bj][m][0], v1 = acc[ai][bj][m][1];
                    u32x4 w; w.x = cvt_pk_bf16(v0[0], v0[1]); w.y = cvt_pk_bf16(v0[2], v0[3]); w.z = cvt_pk_bf16(v1[0], v1[1]); w.w = cvt_pk_bf16(v1[2], v1[3]);
                    *(u32x4*)(rowp + bj * HALF) = w; } }
    }
};
template <int MODE> struct EpiGate {
    static constexpr bool PRE = false;
    static constexpr int dup = 0;
    static constexpr int MIDK = 0; static constexpr bool PERM = true, AFTER_DRAIN = false;
    bf16_t* O; const bf16_t* G;
    __device__ __forceinline__ void operator()(const f32x4 (&acc)[2][2][4][2], const Unit& u, int wr, int wc, int fr, int fq) const {
        const int row0 = u.pm * BM + wr * 64 + fr, col0 = u.pn * BM + wc * 32 + 8 * fq;
#pragma unroll
        for (int ai = 0; ai < 2; ++ai)
#pragma unroll
            for (int m = 0; m < 4; ++m) { const size_t off = (size_t)(row0 + ai * HALF + m * 16) * 1024 + col0;
#pragma unroll
                for (int bj = 0; bj < 2; ++bj) { const u32x4 g = *(const u32x4*)(G + off + bj * HALF);
                    const f32x4 a0 = acc[ai][bj][m][0], a1 = acc[ai][bj][m][1];
                    float r[8];
                    r[0] = sigmoidf_(bf_lo(g.x)) * a0[0]; r[1] = sigmoidf_(bf_hi(g.x)) * a0[1]; r[2] = sigmoidf_(bf_lo(g.y)) * a0[2]; r[3] = sigmoidf_(bf_hi(g.y)) * a0[3];
                    r[4] = sigmoidf_(bf_lo(g.z)) * a1[0]; r[5] = sigmoidf_(bf_hi(g.z)) * a1[1]; r[6] = sigmoidf_(bf_lo(g.w)) * a1[2]; r[7] = sigmoidf_(bf_hi(g.w)) * a1[3];
                    if (MODE == 1) { const u32x4 p = *(const u32x4*)(O + off + bj * HALF);
                        r[0] += bf_lo(p.x); r[1] += bf_hi(p.x); r[2] += bf_lo(p.y); r[3] += bf_hi(p.y); r[4] += bf_lo(p.z); r[5] += bf_hi(p.z); r[6] += bf_lo(p.w); r[7] += bf_hi(p.w); }
                    u32x4 w; w.x = cvt_pk_bf16(r[0], r[1]); w.y = cvt_pk_bf16(r[2], r[3]); w.z = cvt_pk_bf16(r[4], r[5]); w.w = cvt_pk_bf16(r[6], r[7]);
                    *(u32x4*)(O + off + bj * HALF) = w; } }
    }
};
struct EpiMerge {
    static constexpr bool PRE = false;
    static constexpr int dup = EPIDUP_MERGE;
    static constexpr int MIDK = 8; static constexpr bool PERM = true, AFTER_DRAIN = false;
    bf16_t* O; const unsigned char* GA; const unsigned char* GB;
    static __device__ __forceinline__ float ub(unsigned w, int i) { return (float)((w >> (8 * i)) & 0xFFu); }
    __device__ __forceinline__ void mid(f32x4 (&acc)[2][2][4][2], const Unit& u, int wr, int wc, int fr, int fq) const {
        typedef unsigned u32x2v __attribute__((ext_vector_type(2)));
        asm volatile("" : "+v"(fr), "+v"(fq));
        const int row0 = u.pm * BM + wr * 64 + fr, col0 = u.pn * BM + wc * 32 + 8 * fq;
        u32x2v ra[MERGE_DEPTH + 1][2], rb[MERGE_DEPTH + 1][2];
#pragma unroll
        for (int g = 0; g < MERGE_DEPTH; ++g) { const size_t off = (size_t)(row0 + (g >> 2) * HALF + (g & 3) * 16) * 1024 + col0;
#pragma unroll
            for (int bj = 0; bj < 2; ++bj) { ra[g][bj] = *(const u32x2v*)(GA + off + bj * HALF); rb[g][bj] = *(const u32x2v*)(GB + off + bj * HALF); } }
#pragma unroll
        for (int g = 0; g < 8; ++g) { const int ai = g >> 2, m = g & 3, sl = g % (MERGE_DEPTH + 1);
            asm volatile("" ::: "memory");
            if (g + MERGE_DEPTH < 8) { const int g2 = g + MERGE_DEPTH, s2 = g2 % (MERGE_DEPTH + 1); const size_t off = (size_t)(row0 + (g2 >> 2) * HALF + (g2 & 3) * 16) * 1024 + col0;
#pragma unroll
                for (int bj = 0; bj < 2; ++bj) { ra[s2][bj] = *(const u32x2v*)(GA + off + bj * HALF); rb[s2][bj] = *(const u32x2v*)(GB + off + bj * HALF); } }
            asm volatile("" ::: "memory");
#pragma unroll
            for (int bj = 0; bj < 2; ++bj) { const u32x2v a = ra[sl][bj], b = rb[sl][bj];
#pragma unroll
                for (int i = 0; i < 4; ++i) { acc[ai][bj][m][0][i] *= ub(a.x, i) * __builtin_amdgcn_rcpf(fmaxf(ub(b.x, i), 1.0f)); acc[ai][bj][m][1][i] *= ub(a.y, i) * __builtin_amdgcn_rcpf(fmaxf(ub(b.y, i), 1.0f)); } } }
    }
    __device__ __forceinline__ void operator()(const f32x4 (&acc)[2][2][4][2], const Unit& u, int wr, int wc, int fr, int fq) const {
        typedef unsigned u32x2v __attribute__((ext_vector_type(2)));
        const int row0 = u.pm * BM + wr * 64 + fr, col0 = u.pn * BM + wc * 32 + 8 * fq;
#pragma unroll
        for (int ai = 0; ai < 2; ++ai)
#pragma unroll
            for (int m = 0; m < 4; ++m) { const size_t off = (size_t)(row0 + ai * HALF + m * 16) * 1024 + col0;
#pragma unroll
                for (int bj = 0; bj < 2; ++bj) { const u32x2v g = *(const u32x2v*)(GB + off + bj * HALF);
                    const f32x4 a0 = acc[ai][bj][m][0], a1 = acc[ai][bj][m][1];
                    float r[8];
#pragma unroll
                    for (int i = 0; i < 4; ++i) { r[i] = fmaxf(ub(g.x, i), 1.0f) * (1.0f / 255.0f) * a0[i]; r[4 + i] = fmaxf(ub(g.y, i), 1.0f) * (1.0f / 255.0f) * a1[i]; }
                    u32x4 w; w.x = cvt_pk_bf16(r[0], r[1]); w.y = cvt_pk_bf16(r[2], r[3]); w.z = cvt_pk_bf16(r[4], r[5]); w.w = cvt_pk_bf16(r[6], r[7]);
                    *(u32x4*)(O + off + bj * HALF) = w; } }
    }
};
struct EpiRes {
    static constexpr bool PRE = false;
    static constexpr int dup = EPIDUP_RES;
    static constexpr int MIDK = 0; static constexpr bool PERM = true, AFTER_DRAIN = false;
    const bf16_t* X; const float* RMS; bf16_t* XB; float* SSQ;
    __device__ __forceinline__ void operator()(const f32x4 (&acc)[2][2][4][2], const Unit& u, int wr, int wc, int fr, int fq) const {
        const int row0 = u.pm * BM + wr * 64 + fr, col0 = u.pn * BM + wc * 32 + 8 * fq;
#pragma unroll
        for (int ai = 0; ai < 2; ++ai)
#pragma unroll
            for (int m = 0; m < 4; ++m) { const int row = row0 + ai * HALF + m * 16; const size_t off = (size_t)row * 1024 + col0; float s = 0.f; const float rm = RMS[row];
#pragma unroll
                for (int bj = 0; bj < 2; ++bj) { const u32x4 xr = *(const u32x4*)(X + off + bj * HALF);
                    const f32x4 x0 = (f32x4){bf_lo(xr.x), bf_hi(xr.x), bf_lo(xr.y), bf_hi(xr.y)}, x1 = (f32x4){bf_lo(xr.z), bf_hi(xr.z), bf_lo(xr.w), bf_hi(xr.w)};
                    const f32x4 o0 = x0 * rm + acc[ai][bj][m][0], o1 = x1 * rm + acc[ai][bj][m][1];
                    s += (o0[0] * o0[0] + o0[1] * o0[1]) + (o0[2] * o0[2] + o0[3] * o0[3]); s += (o1[0] * o1[0] + o1[1] * o1[1]) + (o1[2] * o1[2] + o1[3] * o1[3]);
                    u32x4 w; w.x = cvt_pk_bf16(o0[0], o0[1]); w.y = cvt_pk_bf16(o0[2], o0[3]); w.z = cvt_pk_bf16(o1[0], o1[1]); w.w = cvt_pk_bf16(o1[2], o1[3]); *(u32x4*)(XB + off + bj * HALF) = w; }
                s += __shfl_xor(s, 16); s += __shfl_xor(s, 32);
                if (fq == 0) SSQ[(size_t)row * 16 + u.pn * 4 + wc] = s; }
    }
};
struct EpiAcc {
    static constexpr bool PRE = false;
    static constexpr int dup = EPIDUP_ACC;
    static constexpr int MIDK = 0; static constexpr bool PERM = true, AFTER_DRAIN = false;
    const bf16_t* XB; float* OUT;
    __device__ __forceinline__ void operator()(const f32x4 (&acc)[2][2][4][2], const Unit& u, int wr, int wc, int fr, int fq) const {
        const int row0 = u.pm * BM + wr * 64 + fr, col0 = u.pn * BM + wc * 32 + 8 * fq;
#pragma unroll
        for (int ai = 0; ai < 2; ++ai)
#pragma unroll
            for (int m = 0; m < 4; ++m) { const size_t off = (size_t)(row0 + ai * HALF + m * 16) * 1024 + col0;
#pragma unroll
                for (int bj = 0; bj < 2; ++bj) { const u32x4 xb = *(const u32x4*)(XB + off + bj * HALF);
                    const f32x4 x0 = (f32x4){bf_lo(xb.x), bf_hi(xb.x), bf_lo(xb.y), bf_hi(xb.y)}, x1 = (f32x4){bf_lo(xb.z), bf_hi(xb.z), bf_lo(xb.w), bf_hi(xb.w)};
                    *(f32x4*)(OUT + off + bj * HALF) = x0 + acc[ai][bj][m][0]; *(f32x4*)(OUT + off + bj * HALF + 4) = x1 + acc[ai][bj][m][1]; } }
    }
};
struct EpiUp {
    static constexpr bool PRE = false;
    static constexpr int dup = 0;
    static constexpr int MIDK = 0; static constexpr bool PERM = true, AFTER_DRAIN = false;
    bf16_t* H; bf16_t* HALO; bf16_t* SCR; const float* SSQ; const float* fw; const float* fb; int dff;
    __device__ __forceinline__ void operator()(const f32x4 (&acc)[2][2][4][2], const Unit& u, int wr, int wc, int fr, int fq) const {
        const int nup = 2 * dff;
        {
            const int col0 = wc * 32 + 8 * fq;
#pragma unroll
            for (int ai = 0; ai < 2; ++ai)
#pragma unroll
                for (int m = 0; m < 4; ++m) { asm volatile("" ::: "memory"); const int rl = ai * HALF + wr * 64 + m * 16 + fr; const int row = u.pm * BM + rl; float ss = 0.f;
#pragma unroll
                    for (int q = 0; q < 4; ++q) { const f32x4 p = *(const f32x4*)(SSQ + (size_t)row * 16 + q * 4); ss += (p[0] + p[1]) + (p[2] + p[3]); }
                    const float ri = 1.0f / sqrtf(ss * (1.0f / 1024.0f) + 1e-6f);
#pragma unroll
                    for (int bj = 0; bj < 2; ++bj) { const f32x4 v0 = acc[ai][bj][m][0] * ri, v1 = acc[ai][bj][m][1] * ri;
                        u32x4 w; w.x = cvt_pk_bf16(v0[0], v0[1]); w.y = cvt_pk_bf16(v0[2], v0[3]); w.z = cvt_pk_bf16(v1[0], v1[1]); w.w = cvt_pk_bf16(v1[2], v1[3]);
                        *(u32x4*)(SCR + rl * 256 + bj * HALF + col0) = w; } }
        }
        asm volatile("s_waitcnt vmcnt(0) lgkmcnt(0)" ::: "memory"); __builtin_amdgcn_s_barrier(); asm volatile("" ::: "memory");
        {
            int tid = threadIdx.x; asm volatile("" : "+v"(tid));
            const int cg8 = (tid & 15) * 8, rg = tid >> 4, r0 = rg * 8;
            const int ch = u.pn * 128 + cg8;
            float wgt[3][2][8], bia[2][8];
#pragma unroll
            for (int gv = 0; gv < 2; ++gv) {
#pragma unroll
                for (int h4 = 0; h4 < 2; ++h4) { const f32x4 b4 = *(const f32x4*)(fb + gv * dff + ch + 4 * h4);
#pragma unroll
                    for (int i = 0; i < 4; ++i) bia[gv][4 * h4 + i] = b4[i];
#pragma unroll
                    for (int j = 0; j < 3; ++j) { const f32x4 w4 = *(const f32x4*)(fw + (size_t)j * nup + gv * dff + ch + 4 * h4);
#pragma unroll
                        for (int i = 0; i < 4; ++i) wgt[j][gv][4 * h4 + i] = w4[i]; } }
            }
            float p2[2][8], p1[2][8];
#pragma unroll
            for (int gv = 0; gv < 2; ++gv)
#pragma unroll
                for (int i = 0; i < 8; ++i) { p2[gv][i] = 0.f; p1[gv][i] = 0.f; }
            if (rg > 0) {
#pragma unroll
                for (int gv = 0; gv < 2; ++gv) { const u32x4 a = __builtin_nontemporal_load((const u32x4*)(SCR + (r0 - 2) * 256 + gv * HALF + cg8)), b = __builtin_nontemporal_load((const u32x4*)(SCR + (r0 - 1) * 256 + gv * HALF + cg8));
                    p2[gv][0] = bf_lo(a.x); p2[gv][1] = bf_hi(a.x); p2[gv][2] = bf_lo(a.y); p2[gv][3] = bf_hi(a.y); p2[gv][4] = bf_lo(a.z); p2[gv][5] = bf_hi(a.z); p2[gv][6] = bf_lo(a.w); p2[gv][7] = bf_hi(a.w);
                    p1[gv][0] = bf_lo(b.x); p1[gv][1] = bf_hi(b.x); p1[gv][2] = bf_lo(b.y); p1[gv][3] = bf_hi(b.y); p1[gv][4] = bf_lo(b.z); p1[gv][5] = bf_hi(b.z); p1[gv][6] = bf_lo(b.w); p1[gv][7] = bf_hi(b.w); }
            }
#pragma unroll
            for (int k = 0; k < 8; ++k) {
                const int rl = r0 + k;
                u32x4 raw[2]; float c[2][8];
#pragma unroll
                for (int gv = 0; gv < 2; ++gv) { raw[gv] = __builtin_nontemporal_load((const u32x4*)(SCR + rl * 256 + gv * HALF + cg8));
                    c[gv][0] = bf_lo(raw[gv].x); c[gv][1] = bf_hi(raw[gv].x); c[gv][2] = bf_lo(raw[gv].y); c[gv][3] = bf_hi(raw[gv].y); c[gv][4] = bf_lo(raw[gv].z); c[gv][5] = bf_hi(raw[gv].z); c[gv][6] = bf_lo(raw[gv].w); c[gv][7] = bf_hi(raw[gv].w); }
                if (rl < 2 || rl >= 254) {
                    bf16_t* hp = HALO + ((size_t)u.pm * 4 + (rl < 2 ? rl : rl - 252)) * nup + u.pn * BM + cg8;
                    *(u32x4*)hp = raw[0]; *(u32x4*)(hp + HALF) = raw[1]; }
                float hh[8];
#pragma unroll
                for (int i = 0; i < 8; ++i) {
                    const float yg = bia[0][i] + wgt[0][0][i] * p2[0][i] + wgt[1][0][i] * p1[0][i] + wgt[2][0][i] * c[0][i];
                    const float yv = bia[1][i] + wgt[0][1][i] * p2[1][i] + wgt[1][1][i] * p1[1][i] + wgt[2][1][i] * c[1][i];
                    hh[i] = yg * sigmoidf_(yg) * yv;
                    p2[0][i] = p1[0][i]; p1[0][i] = c[0][i]; p2[1][i] = p1[1][i]; p1[1][i] = c[1][i];
                }
                if (rl >= 2) { u32x4 w; w.x = cvt_pk_bf16(hh[0], hh[1]); w.y = cvt_pk_bf16(hh[2], hh[3]); w.z = cvt_pk_bf16(hh[4], hh[5]); w.w = cvt_pk_bf16(hh[6], hh[7]);
                    *(u32x4*)(H + (size_t)(u.pm * BM + rl) * dff + ch) = w; }
            }
        }
    }
};
__device__ __forceinline__ float dpp_shr1(float oldv, float src) { return __builtin_bit_cast(float, __builtin_amdgcn_update_dpp(__builtin_bit_cast(int, oldv), __builtin_bit_cast(int, src), 0x111, 0xf, 0xf, false)); }
__device__ __forceinline__ float dpp_shr2(float oldv, float src) { return __builtin_bit_cast(float, __builtin_amdgcn_update_dpp(__builtin_bit_cast(int, oldv), __builtin_bit_cast(int, src), 0x112, 0xf, 0xf, false)); }
__device__ __forceinline__ float dpp_shl15(float src) { return __builtin_bit_cast(float, __builtin_amdgcn_update_dpp(0, __builtin_bit_cast(int, src), 0x10F, 0xf, 0xf, false)); }
__device__ __forceinline__ float dpp_shl14(float src) { return __builtin_bit_cast(float, __builtin_amdgcn_update_dpp(0, __builtin_bit_cast(int, src), 0x10E, 0xf, 0xf, false)); }
struct EpiUpR {
    static constexpr bool PRE = UP_PRE;
    static constexpr int dup = EPIDUP_UP;
    static constexpr int MIDK = 0; static constexpr bool PERM = true, AFTER_DRAIN = false;
    bf16_t* H; bf16_t* HALO; const float* SSQ; const float* fw; const float* fb; PG8_LAS unsigned char* xl; int dff;
    __device__ __forceinline__ void pre(const Unit& u) const {
        int tid = threadIdx.x; asm volatile("" : "+v"(tid));
        const int w = __builtin_amdgcn_readfirstlane(tid >> 6);
        if (w < 4) {
            const int nup = 2 * dff;
            const int e = tid * 4, kgv = e >> 7, k = kgv >> 1, gv = kgv & 1, c = e & 127;
            const float* src = (k < 3 ? fw + (size_t)k * nup : fb) + gv * dff + u.pn * 128 + c;
            __builtin_amdgcn_global_load_lds((const unsigned*)src, (PG8_LAS unsigned*)(xl + 8192 + w * 1024), 16, 0, 0);
            const float* sp = SSQ + (size_t)(u.pm * BM + tid) * 16;
#pragma unroll
            for (int q = 0; q < 4; ++q) __builtin_amdgcn_global_load_lds((const unsigned*)(sp + q * 4), (PG8_LAS unsigned*)(xl + 13312 + q * 4096 + w * 1024), 16, 0, 0);
        }
    }
    __device__ __forceinline__ void operator()(f32x4 (&acc)[2][2][4][2], const Unit& u, int wr, int wc, int fr, int fq) const {
        typedef unsigned u32x2v __attribute__((ext_vector_type(2)));
        asm volatile("" : "+v"(fr), "+v"(fq));
        const int nup = 2 * dff;
        const int colt = wc * 32 + 8 * fq;
        const int ch0 = u.pn * 128 + colt;
        const int row0 = u.pm * BM + wr * 64 + fr;
        PG8_LAS float* slab = (PG8_LAS float*)xl;
        PG8_LAS float* wl = (PG8_LAS float*)(xl + 8192);
        PG8_LAS float* rl = (PG8_LAS float*)(xl + 12288);
        if (PRE) {
            asm volatile("s_waitcnt vmcnt(16)" ::: "memory"); __builtin_amdgcn_s_barrier(); asm volatile("" ::: "memory");
            int tid = threadIdx.x; asm volatile("" : "+v"(tid));
            if (tid < 256) { const PG8_LAS f32x4* sq = (const PG8_LAS f32x4*)(xl + 13312);
                const f32x4 ps = (sq[tid] + sq[256 + tid]) + (sq[512 + tid] + sq[768 + tid]);
                rl[tid] = __builtin_amdgcn_rsqf(((ps[0] + ps[1]) + (ps[2] + ps[3])) * (1.0f / 1024.0f) + 1e-6f); }
        } else {
            int tid = threadIdx.x; asm volatile("" : "+v"(tid));
            if (tid < 256) { const int e = tid * 4, kgv = e >> 7, k = kgv >> 1, gv = kgv & 1, c = e & 127;
                const float* src = (k < 3 ? fw + (size_t)k * nup : fb) + gv * dff + u.pn * 128 + c;
                *(PG8_LAS f32x4*)(wl + e) = *(const f32x4*)src;
                const int row = u.pm * BM + tid; const f32x4 p0 = *(const f32x4*)(SSQ + (size_t)row * 16), p1 = *(const f32x4*)(SSQ + (size_t)row * 16 + 4), p2 = *(const f32x4*)(SSQ + (size_t)row * 16 + 8), p3 = *(const f32x4*)(SSQ + (size_t)row * 16 + 12);
                const f32x4 ps = (p0 + p1) + (p2 + p3);
                rl[tid] = __builtin_amdgcn_rsqf(((ps[0] + ps[1]) + (ps[2] + ps[3])) * (1.0f / 1024.0f) + 1e-6f); }
        }
        asm volatile("s_waitcnt lgkmcnt(0)" ::: "memory"); __builtin_amdgcn_s_barrier(); asm volatile("" ::: "memory");
#pragma unroll
        for (int ai = 0; ai < 2; ++ai)
#pragma unroll
            for (int m = 0; m < 4; ++m) { const float ri = rl[wr * 64 + fr + ai * HALF + m * 16];
#pragma unroll
                for (int bj = 0; bj < 2; ++bj)
#pragma unroll
                    for (int n = 0; n < 2; ++n) acc[ai][bj][m][n] = acc[ai][bj][m][n] * ri; }
        if (fr >= 14) {
#pragma unroll
            for (int ai = 0; ai < 2; ++ai)
#pragma unroll
                for (int bj = 0; bj < 2; ++bj)
#pragma unroll
                    for (int n = 0; n < 2; ++n) *(PG8_LAS f32x4*)(slab + ((2 * ai + wr) * 2 + (fr - 14)) * 256 + bj * HALF + colt + 4 * n) = acc[ai][bj][3][n];
            if (wr == 1) {
#pragma unroll
                for (int bj = 0; bj < 2; ++bj) { const f32x4 v0 = acc[1][bj][3][0], v1 = acc[1][bj][3][1];
                    u32x4 w; w.x = cvt_pk_bf16(v0[0], v0[1]); w.y = cvt_pk_bf16(v0[2], v0[3]); w.z = cvt_pk_bf16(v1[0], v1[1]); w.w = cvt_pk_bf16(v1[2], v1[3]);
                    *(u32x4*)(HALO + ((size_t)u.pm * 4 + 2 + (fr - 14)) * nup + u.pn * BM + bj * HALF + colt) = w; }
            }
        }
        if (fr < 2 && wr == 0) {
#pragma unroll
            for (int bj = 0; bj < 2; ++bj) { const f32x4 v0 = acc[0][bj][0][0], v1 = acc[0][bj][0][1];
                u32x4 w; w.x = cvt_pk_bf16(v0[0], v0[1]); w.y = cvt_pk_bf16(v0[2], v0[3]); w.z = cvt_pk_bf16(v1[0], v1[1]); w.w = cvt_pk_bf16(v1[2], v1[3]);
                *(u32x4*)(HALO + ((size_t)u.pm * 4 + fr) * nup + u.pn * BM + bj * HALF + colt) = w; }
        }
        asm volatile("s_waitcnt lgkmcnt(0)" ::: "memory"); __builtin_amdgcn_s_barrier(); asm volatile("" ::: "memory");
        int fr3 = fr; asm volatile("" : "+v"(fr3));
        const int row3 = u.pm * BM + wr * 64 + fr3;
#pragma unroll
        for (int ai = 0; ai < 2; ++ai) {
            const int blk = 2 * ai + wr;
#pragma unroll
            for (int m = 3; m >= 0; --m) {
                f32x4 hv[2];
#pragma unroll
                for (int n = 0; n < 2; ++n) {
                    asm volatile("" ::: "memory");
                    const PG8_LAS float* wp = wl + colt + 4 * n;
                    f32x4 yg, yv;
#pragma unroll
                    for (int gv = 0; gv < 2; ++gv) {
                        const f32x4 w0 = *(const PG8_LAS f32x4*)(wp + gv * 128), w1 = *(const PG8_LAS f32x4*)(wp + 256 + gv * 128), w2 = *(const PG8_LAS f32x4*)(wp + 512 + gv * 128), bb = *(const PG8_LAS f32x4*)(wp + 768 + gv * 128);
                        const f32x4 cc = acc[ai][gv][m][n];
                        f32x4 o1 = (f32x4){0.f, 0.f, 0.f, 0.f}, o2 = o1;
                        if (m > 0) { const f32x4 pp = acc[ai][gv][m - 1][n];
#pragma unroll
                            for (int i = 0; i < 4; ++i) { o1[i] = dpp_shl15(pp[i]); o2[i] = dpp_shl14(pp[i]); } }
                        else if (blk > 0) { const PG8_LAS float* sp = slab + ((blk - 1) * 2) * 256 + gv * HALF + colt + 4 * n; const int r2 = (fr3 == 0) ? 0 : 256;
                            o1 = *(const PG8_LAS f32x4*)(sp + 256); o2 = *(const PG8_LAS f32x4*)(sp + r2); }
                        f32x4 y;
#pragma unroll
                        for (int i = 0; i < 4; ++i) { const float x1 = dpp_shr1(o1[i], cc[i]), x2 = dpp_shr2(o2[i], cc[i]); y[i] = bb[i] + w0[i] * x2 + w1[i] * x1 + w2[i] * cc[i]; }
                        if (gv == 0) yg = y; else yv = y;
                        __builtin_amdgcn_sched_barrier(0);
                    }
#pragma unroll
                    for (int i = 0; i < 4; ++i) hv[n][i] = yg[i] * sigmoidf_(yg[i]) * yv[i];
                }
                if (!(blk == 0 && m == 0 && fr3 < 2)) { u32x4 w; w.x = cvt_pk_bf16(hv[0][0], hv[0][1]); w.y = cvt_pk_bf16(hv[0][2], hv[0][3]); w.z = cvt_pk_bf16(hv[1][0], hv[1][1]); w.w = cvt_pk_bf16(hv[1][2], hv[1][3]);
                    *(u32x4*)(H + (size_t)(row3 + ai * HALF + m * 16) * dff + ch0) = w; }
            }
        }
    }
};
template <class Epi, class Sched, bool ALIGN_EPI = false, bool SP2 = false>
__device__ __forceinline__ void gemm_phase(PG8_LAS unsigned char* lds, const Gemm g, const Sched& S, const Epi& E) {
    const int tid = threadIdx.x, wid = __builtin_amdgcn_readfirstlane(tid >> 6), lane = tid & 63, wr = wid >> 2, wc = wid & 3, fr = lane & 15, fq = lane >> 4;
    const int K = g.K, nt = K / BK;
    auto krot = [&](const Unit& u) -> int { return (Epi::MIDK > 0 || !PG8_KROT) ? 0 : 2 * ((u.pm + 2 * u.pn) % (nt >> 1)); };
    unsigned voffA[2], voffB[2];
#pragma unroll
    for (int i = 0; i < 2; ++i) { int R, C; stage_rc(tid * 16 + i * 8192, R, C); const int Rb = Epi::PERM ? ((R & ~31) + perm32(R & 31)) : R;
        voffA[i] = (unsigned)(R * K + C) * 2u; voffB[i] = (unsigned)(Rb * K + C) * 2u; }
    const size_t kstep = (size_t)(BK * 2);
    const size_t hstep = (size_t)HALF * K * 2;
    const size_t tstep = 2 * hstep;
    const unsigned ldsw = (unsigned)wid * 1024u;
    const int aoff = lds_byte(wr * 64 + fr, fq * 8), boff = lds_byte(wc * 32 + fr, fq * 8);
#define PG8_SA(b, h) (((b) * 2 + (h)) * HTB)
#define PG8_SB(b, h) ((4 + (b) * 2 + (h)) * HTB)
#define PG8_STAGE(bufoff, gbase, voff) do { _Pragma("unroll") for (int _i = 0; _i < 2; ++_i) \
        __builtin_amdgcn_global_load_lds((const unsigned*)((const char*)(gbase) + (voff)[_i]), (PG8_LAS unsigned*)(lds + (bufoff) + ldsw + _i * 8192), 16, 0, 0); } while (0)
#define PG8_LDA(dst, b, h) do { _Pragma("unroll") for (int m = 0; m < 4; ++m) _Pragma("unroll") for (int k = 0; k < 2; ++k) dst[m][k] = *(const PG8_LAS bf16x8*)(lds + PG8_SA(b, h) + aoff + m * 2048 + k * 1024); } while (0)
#define PG8_LDB(dst, b, h) do { _Pragma("unroll") for (int n = 0; n < 2; ++n) _Pragma("unroll") for (int k = 0; k < 2; ++k) dst[n][k] = *(const PG8_LAS bf16x8*)(lds + PG8_SB(b, h) + boff + n * 2048 + k * 1024); } while (0)
#define PG8_MMA(ai, bj, At, Bt) do { __builtin_amdgcn_s_setprio(1); _Pragma("unroll") for (int m = 0; m < 4; ++m) _Pragma("unroll") for (int n = 0; n < 2; ++n) _Pragma("unroll") for (int k = 0; k < 2; ++k) \
        acc[ai][bj][m][n] = __builtin_amdgcn_mfma_f32_16x16x32_bf16(Bt[n][k], At[m][k], acc[ai][bj][m][n], 0, 0, 0); __builtin_amdgcn_s_setprio(0); } while (0)
#define PG8_WAIT_V(n) asm volatile("s_waitcnt vmcnt(" #n ")" ::: "memory")
#define PG8_WAIT_L(n) asm volatile("s_waitcnt lgkmcnt(" #n ")" ::: "memory")
#define PG8_BAR __builtin_amdgcn_s_barrier()
#define PG8_SCHED __builtin_amdgcn_sched_barrier(0)
    Unit cur, nxt; int ui = 0;
    if (!S.next(0, cur)) return;
    f32x4 acc[2][2][4][2];
#pragma unroll
    for (int a = 0; a < 2; ++a)
#pragma unroll
        for (int b = 0; b < 2; ++b)
#pragma unroll
            for (int m = 0; m < 4; ++m)
#pragma unroll
                for (int n = 0; n < 2; ++n) acc[a][b][m][n] = (f32x4){0.f, 0.f, 0.f, 0.f};
    bf16x8 At[4][2], B0[2][2], B1[2][2];
    const char* cA = (const char*)g.A + (size_t)cur.pm * tstep; const char* cB = (const char*)g.Bt + (size_t)cur.pn * tstep;
    S.a_ready(cur);
    int rc = krot(cur);
    { const char* cA0 = cA; const char* cB0 = cB; cA = cA0 + (size_t)rc * kstep; cB = cB0 + (size_t)rc * kstep;
    if constexpr (SP2) {
        PG8_STAGE(PG8_SB(0, 0), cB, voffB); PG8_STAGE(PG8_SB(0, 1), cB + hstep, voffB); PG8_STAGE(PG8_SA(0, 0), cA, voffA); PG8_STAGE(PG8_SA(0, 1), cA + hstep, voffA);
        if (wr == 1) PG8_BAR;
        PG8_WAIT_V(2); PG8_BAR;
        PG8_STAGE(PG8_SB(1, 0), cB + kstep, voffB); PG8_STAGE(PG8_SA(1, 0), cA + kstep, voffA); PG8_STAGE(PG8_SB(1, 1), cB + hstep + kstep, voffB);
        PG8_WAIT_V(6); PG8_BAR;
    } else {
        PG8_STAGE(PG8_SB(0, 0), cB, voffB); PG8_STAGE(PG8_SA(0, 0), cA, voffA); PG8_STAGE(PG8_SB(0, 1), cB + hstep, voffB); PG8_STAGE(PG8_SA(0, 1), cA + hstep, voffA);
        if (wr == 1) PG8_BAR;
        PG8_WAIT_V(4); PG8_BAR;
        PG8_STAGE(PG8_SB(1, 0), cB + kstep, voffB); PG8_STAGE(PG8_SA(1, 0), cA + kstep, voffA); PG8_STAGE(PG8_SB(1, 1), cB + hstep + kstep, voffB);
        PG8_WAIT_V(6); PG8_BAR;
    }
      cA = cA0; cB = cB0; }
    for (;;) {
        const bool has_next = S.next(ui + 1, nxt);
        const char* nA = has_next ? (const char*)g.A + (size_t)nxt.pm * tstep : cA; const char* nB = has_next ? (const char*)g.Bt + (size_t)nxt.pn * tstep : cB;
        const int rn = has_next ? krot(nxt) : rc;
        for (int t = 0; t < nt; t += 2) {
            const bool last = (t == nt - 2);
            int kt = t + rc; kt = kt >= nt ? kt - nt : kt; int kt2 = kt + 2; kt2 = kt2 >= nt ? kt2 - nt : kt2;
            const char* a1 = cA + (size_t)(kt + 1) * kstep;
            const char* a2 = last ? nA + (size_t)rn * kstep : cA + (size_t)kt2 * kstep; const char* b2 = last ? nB + (size_t)rn * kstep : cB + (size_t)kt2 * kstep;
            const char* a3 = a2 + kstep; const char* b3 = b2 + kstep;
            if (last && has_next) S.a_ready(nxt);
            if constexpr (Epi::PRE) { if (last) E.pre(cur); }
            if constexpr (Epi::MIDK > 0) { if (t == Epi::MIDK) E.mid(acc, cur, wr, wc, fr, fq); }
            if constexpr (SP2) {
            PG8_LDB(B0, 0, 0); PG8_LDB(B1, 0, 1); PG8_SCHED; PG8_LDA(At, 0, 0); PG8_STAGE(PG8_SA(1, 1), a1 + hstep, voffA);
            PG8_WAIT_V(8); PG8_WAIT_L(0); PG8_BAR; PG8_MMA(0, 0, At, B0); PG8_MMA(0, 1, At, B1); PG8_BAR; PG8_SCHED;
            PG8_LDA(At, 0, 1); PG8_STAGE(PG8_SB(0, 0), b2, voffB); PG8_STAGE(PG8_SB(0, 1), b2 + hstep, voffB); PG8_STAGE(PG8_SA(0, 0), a2, voffA);
            PG8_WAIT_V(8); PG8_WAIT_L(0); PG8_BAR; PG8_MMA(1, 0, At, B0); PG8_MMA(1, 1, At, B1); PG8_BAR; PG8_SCHED;
            PG8_LDB(B0, 1, 0); PG8_LDB(B1, 1, 1); PG8_SCHED; PG8_LDA(At, 1, 0); PG8_STAGE(PG8_SA(0, 1), a2 + hstep, voffA);
            PG8_WAIT_V(8); PG8_WAIT_L(0); PG8_BAR; PG8_MMA(0, 0, At, B0); PG8_MMA(0, 1, At, B1); PG8_BAR; PG8_SCHED;
            PG8_LDA(At, 1, 1); PG8_STAGE(PG8_SB(1, 0), b3, voffB); PG8_STAGE(PG8_SB(1, 1), b3 + hstep, voffB); PG8_STAGE(PG8_SA(1, 0), a3, voffA);
            PG8_WAIT_V(8); PG8_WAIT_L(0); PG8_BAR; PG8_MMA(1, 0, At, B0); PG8_MMA(1, 1, At, B1); PG8_BAR; PG8_SCHED;
            } else {
            PG8_LDB(B0, 0, 0); PG8_SCHED; PG8_LDA(At, 0, 0); PG8_STAGE(PG8_SA(1, 1), a1 + hstep, voffA);
            PG8_WAIT_L(8); PG8_BAR; PG8_WAIT_L(0); PG8_MMA(0, 0, At, B0); PG8_BAR; PG8_SCHED;
            PG8_LDB(B1, 0, 1); PG8_STAGE(PG8_SB(0, 0), b2, voffB);
            PG8_BAR; PG8_WAIT_L(0); PG8_MMA(0, 1, At, B1); PG8_BAR;
            PG8_LDA(At, 0, 1); PG8_STAGE(PG8_SA(0, 0), a2, voffA);
            PG8_BAR; PG8_WAIT_L(0); PG8_MMA(1, 0, At, B0); PG8_BAR; PG8_SCHED;
            PG8_STAGE(PG8_SB(0, 1), b2 + hstep, voffB);
            PG8_WAIT_V(6); PG8_BAR; PG8_MMA(1, 1, At, B1); PG8_BAR;
            PG8_LDB(B0, 1, 0); PG8_SCHED; PG8_LDA(At, 1, 0); PG8_STAGE(PG8_SA(0, 1), a2 + hstep, voffA);
            PG8_WAIT_L(8); PG8_BAR; PG8_WAIT_L(0); PG8_MMA(0, 0, At, B0); PG8_BAR; PG8_SCHED;
            PG8_LDB(B1, 1, 1); PG8_STAGE(PG8_SB(1, 0), b3, voffB);
            PG8_BAR; PG8_WAIT_L(0); PG8_MMA(0, 1, At, B1); PG8_BAR;
            PG8_LDA(At, 1, 1); PG8_STAGE(PG8_SA(1, 0), a3, voffA);
            PG8_BAR; PG8_WAIT_L(0); PG8_MMA(1, 0, At, B0); PG8_BAR; PG8_SCHED;
            PG8_STAGE(PG8_SB(1, 1), b3 + hstep, voffB);
            PG8_WAIT_V(6); PG8_BAR; PG8_MMA(1, 1, At, B1); PG8_BAR;
            }
        }
        if constexpr (ALIGN_EPI) { if (wr == 0) PG8_BAR; }
#ifdef EPI_DUP
        if constexpr (!Epi::AFTER_DRAIN) { if (E.dup) { E(acc, cur, wr, wc, fr, fq); asm volatile("" ::: "memory"); } }
#endif
        if constexpr (!Epi::AFTER_DRAIN) { E(acc, cur, wr, wc, fr, fq); S.done(cur); }
        if (!has_next) break;
#pragma unroll
        for (int a = 0; a < 2; ++a)
#pragma unroll
            for (int b = 0; b < 2; ++b)
#pragma unroll
                for (int m = 0; m < 4; ++m)
#pragma unroll
                    for (int n = 0; n < 2; ++n) acc[a][b][m][n] = (f32x4){0.f, 0.f, 0.f, 0.f};
        cur = nxt; cA = nA; cB = nB; rc = rn; ++ui;
        if constexpr (ALIGN_EPI) { if (wr == 1) PG8_BAR; }
    }
    PG8_WAIT_V(0);
    if constexpr (!ALIGN_EPI) { if (wr == 0) PG8_BAR; }
    PG8_BAR;
    if constexpr (Epi::AFTER_DRAIN) { E.fused(acc, cur, wr, wc, fr, fq, lds, wid, lane); S.done(cur); }
#undef PG8_SA
#undef PG8_SB
#undef PG8_STAGE
#undef PG8_LDA
#undef PG8_LDB
#undef PG8_MMA
#undef PG8_WAIT_V
#undef PG8_WAIT_L
#undef PG8_BAR
#undef PG8_SCHED
}
}
#include <cmath>

constexpr int NWAVES = 8;
constexpr int NB = 8, SEQ = 4096, M = NB * SEQ, DM = 1024;
constexpr int IN_TOTAL = 5188, NIN = 5376;
constexpr int PA_LD = 1280;
constexpr int PA_Q = 0, PA_K = 512, PA_V = 640, PA_QI = 768, PA_KI = 1024, PA_WI = 1088;
constexpr int DFF = 2816, NUP = 2 * DFF;
constexpr float EPS = 1e-6f;
constexpr int TOPK = 256;

#ifndef MK_ONE_LAUNCH
#define MK_ONE_LAUNCH 1
#endif
constexpr int NPH = 11;

constexpr size_t MiB = 1u << 20;
constexpr size_t WS_CTL = 0, CTL_ZERO_BYTES = 64 * 1024;
constexpr size_t WS_WIN = 1 * MiB, WS_WOA = 12 * MiB, WS_WOB = 13 * MiB, WS_WOUT = 15 * MiB, WS_WUP = 17 * MiB, WS_WDN = 28 * MiB;
constexpr size_t WS_RINV1 = 34 * MiB, WS_SSQ2 = 35 * MiB;
constexpr size_t WS_XB = 40 * MiB;
constexpr size_t WS_ATTN = 40 * MiB;
constexpr size_t OUT_KV = 16 * MiB;
constexpr size_t OUT_ARN = 32 * MiB;
constexpr size_t WS_KI = 35 * MiB;
constexpr size_t WS_WI = 34 * MiB + 256 * 1024;
constexpr size_t WS_GAINS = 34 * MiB + 128 * 1024;
constexpr size_t WS_PA = 104 * MiB;
constexpr size_t WS_RX = 184 * MiB, WS_RGATE = 248 * MiB, WS_GA = 312 * MiB, WS_GB = 376 * MiB;
constexpr size_t WS_MERGED = 104 * MiB;
constexpr size_t WS_X1B = 312 * MiB;
constexpr size_t WS_RNN = 440 * MiB;
constexpr size_t WS_H = 40 * MiB;
constexpr size_t WS_HALO = 216 * MiB;
constexpr size_t WS_SCR = 224 * MiB;
constexpr size_t WS_END = 504 * MiB;
static_assert(WS_WIN + (size_t)NIN * 1024 * 2 <= WS_WOA && WS_WUP + (size_t)NUP * 1024 * 2 <= WS_WDN && WS_WDN + (size_t)1024 * DFF * 2 <= WS_RINV1, "weights map");
static_assert(WS_H + (size_t)M * DFF * 2 <= WS_HALO && WS_HALO + (size_t)128 * 4 * NUP * 2 <= WS_SCR && WS_SCR + (size_t)256 * 65536 * 2 <= WS_X1B, "ffn map");
constexpr int CW_BAR = 4096, CW_QUEUE = 64;

constexpr int RING_OFF = 0, RING_BYTES = 131072, XSLAB_OFF = 131072;
constexpr int PHASE_LDS = 163072;
constexpr int LDSCTL_OFF = PHASE_LDS, MISC_OFF = LDSCTL_OFF + 320;
constexpr int LDS_BYTES = 163840;
static_assert(MISC_OFF + 128 <= LDS_BYTES && LDS_BYTES <= 163840, "LDS map");
#define GAS __attribute__((address_space(1)))
#define LAS __attribute__((address_space(3)))
typedef unsigned short bf16;
typedef unsigned v4u __attribute__((ext_vector_type(4)));
typedef float f32x4 __attribute__((ext_vector_type(4)));
typedef short bf16x8 __attribute__((ext_vector_type(8)));
typedef GAS unsigned gu32;
typedef GAS unsigned long long gu64;
#define RLX_AGENT __ATOMIC_RELAXED, __HIP_MEMORY_SCOPE_AGENT
#define LDS_WAIT() asm volatile("s_waitcnt lgkmcnt(0)" ::: "memory")
#define VM_WAIT() asm volatile("s_waitcnt vmcnt(0)" ::: "memory")
__device__ __forceinline__ unsigned long long rt() { return __builtin_amdgcn_s_memrealtime(); }
__device__ __forceinline__ unsigned f2bf(float f) { unsigned u = __builtin_bit_cast(unsigned, f); return (u + 0x7fffu + ((u >> 16) & 1u)) >> 16; }
__device__ __forceinline__ unsigned pk2(float lo, float hi) { return f2bf(lo) | (f2bf(hi) << 16); }

#define XB_TMO      128
#define XB_XCNT(j)  (256  + 64 * (j))
#define XB_XSUB(j)  (1280 + 64 * (j))
#define XB_XGEN(j)  (2304 + 64 * (j))
#define XB_TOP      3328
#define XB_TOPGEN   3392
#define XCD_BAR_WORDS 3456
#define XB_SPIN_CAP (1u << 18)

__device__ __forceinline__ unsigned xb_ld(unsigned* p)              { return __hip_atomic_load(p, __ATOMIC_RELAXED, __HIP_MEMORY_SCOPE_AGENT); }
__device__ __forceinline__ unsigned xb_add(unsigned* p, unsigned v) { return __hip_atomic_fetch_add(p, v, __ATOMIC_RELAXED, __HIP_MEMORY_SCOPE_AGENT); }
__device__ __forceinline__ unsigned xb_xcc_id() { return (unsigned)__builtin_amdgcn_s_getreg((3 << 11) | 20) & 0xFu; }
#define XB_SPIN(cond, bar) do { unsigned _sp = 0; while (cond) { __builtin_amdgcn_s_sleep(1); \
    if ((++_sp & 255u) == 0u) { if (xb_ld(&(bar)[XB_TMO])) break; if (_sp > XB_SPIN_CAP) { atomicAdd(&(bar)[XB_TMO], 1u); break; } } } } while (0)

struct XcdBarrier {
    unsigned* bar; unsigned x;
    volatile LAS unsigned* st;
};

__device__ __forceinline__ XcdBarrier xcd_barrier_post(unsigned* bar, volatile LAS unsigned* st) {
    XcdBarrier b; b.bar = bar; b.x = xb_xcc_id(); b.st = st;
    if (threadIdx.x == 0) (void)xb_add(&bar[XB_XCNT(b.x)], 1u);
    return b;
}
__device__ __forceinline__ void xcd_barrier_complete(unsigned* bar, unsigned x, unsigned& nloc, unsigned& nx) {
    const unsigned G = gridDim.x * gridDim.y * gridDim.z;
    unsigned sum, cnt, mine, sp = 0u;
    for (;;) {
        sum = 0u; cnt = 0u; mine = 0u;
#pragma unroll
        for (unsigned j = 0; j < 16; ++j) { const unsigned c = xb_ld(&bar[XB_XCNT(j)]); sum += c; cnt += (c > 0u) ? 1u : 0u; mine = (j == x) ? c : mine; }
        if (sum == G) break;
        __builtin_amdgcn_s_sleep(1);
        if ((++sp & 255u) == 0u) { if (xb_ld(&bar[XB_TMO])) break; if (sp > XB_SPIN_CAP) { atomicAdd(&bar[XB_TMO], 1u); break; } }
    }
    nloc = mine > 0u ? mine : 1u; nx = cnt > 0u ? cnt : 1u;
}

__device__ __forceinline__ void xcd_barrier(const XcdBarrier& b) {
    asm volatile("s_waitcnt vmcnt(0)" ::: "memory");
    __syncthreads();
    if (threadIdx.x == 0) {
        unsigned* bar = b.bar;
        __builtin_amdgcn_s_waitcnt(0);
        unsigned nloc = b.st[0], nx = b.st[1];
        if (nloc == 0u) { xcd_barrier_complete(bar, b.x, nloc, nx); b.st[0] = nloc; b.st[1] = nx; }
        const unsigned old = xb_add(&bar[XB_XSUB(b.x)], 1u);
        const unsigned gen = old / nloc;
        if (old + 1u == (gen + 1u) * nloc) {
            __builtin_amdgcn_fence(__ATOMIC_RELEASE, "agent");
            asm volatile("s_waitcnt vmcnt(0)" ::: "memory");
            const unsigned og = xb_add(&bar[XB_TOP], 1u);
            const unsigned tg = og / nx;
            if (og + 1u == (tg + 1u) * nx) xb_add(&bar[XB_TOPGEN], 1u);
            else XB_SPIN(xb_ld(&bar[XB_TOPGEN]) == tg, bar);
            __builtin_amdgcn_fence(__ATOMIC_ACQUIRE, "agent");
            xb_add(&bar[XB_XGEN(b.x)], 1u);
            asm volatile("s_waitcnt vmcnt(0)" ::: "memory");
        } else {
            XB_SPIN(xb_ld(&bar[XB_XGEN(b.x)]) == gen, bar);
            __builtin_amdgcn_fence(__ATOMIC_ACQUIRE, "agent");
            asm volatile("s_waitcnt vmcnt(0)" ::: "memory");
        }
    }
    __syncthreads();
}

struct Frame {
    LAS unsigned char* lds;
    volatile LAS unsigned* MISC;
    gu32* ctl;
    int tid, lane, wave;
    int vcu, G;
    const float* in[21]; float* out; unsigned char* ws;
};
__device__ __forceinline__ float wave_sum(float v) {
#pragma unroll
    for (int o = 1; o < 64; o <<= 1) v += __shfl_xor(v, o);
    return v;
}
__device__ __forceinline__ int wave_sum_i(int v) {
#pragma unroll
    for (int o = 1; o < 64; o <<= 1) v += __shfl_xor(v, o);
    return v;
}
__device__ __forceinline__ float wave_max(float v) {
#pragma unroll
    for (int o = 1; o < 64; o <<= 1) v = fmaxf(v, __shfl_xor(v, o));
    return v;
}
__device__ __forceinline__ float bf2f(unsigned short h) { return __builtin_bit_cast(float, (unsigned)h << 16); }
__device__ __forceinline__ float bflo(unsigned u) { return __builtin_bit_cast(float, u << 16); }
__device__ __forceinline__ float bfhi(unsigned u) { return __builtin_bit_cast(float, u & 0xffff0000u); }
__device__ __forceinline__ float sigmoid_f(float x) { return 1.0f / (1.0f + __expf(-x)); }
__device__ __forceinline__ float gelu_tanh_f(float x) { const float u = 0.7978845608028654f * (x + 0.044715f * x * x * x); return 0.5f * x * (1.0f + tanhf(u)); }

enum { MAP_ID = 0, MAP_WIN = 1, MAP_WUP = 2 };
__device__ __forceinline__ int src_col(int kind, int n) {
    if (kind == MAP_WIN) {
        if (n >= 1280) return n - 188;
        const int pn = n >> 8, bj = (n >> 7) & 1, wc = (n >> 5) & 3, x = n & 31, H = 4 * pn + wc, d = 32 * bj + x;
        if (H < 17) return H * 64 + d;
        return (H == 17 && d < 4) ? 1088 + d : -1;
    }
    if (kind == MAP_WUP) { const int j = n >> 8, r = n & 255; return r < 128 ? j * 128 + r : DFF + j * 128 + (r - 128); }
    return n;
}
__device__ __forceinline__ void p0_transpose_item(const float* W, int K, int N, int NP, const float* gain, int kind, bf16* WT, int ldk, LAS float* scr, int item, int lane) {
    const int nblk = NP / 32, kb = item / nblk, nb = item % nblk, k0 = 64 * kb, n0 = 32 * nb;
    const int sc = src_col(kind, n0 + (lane & 31));
    float wv[32];
#pragma unroll
    for (int i = 0; i < 32; ++i) { const int kk = 2 * i + (lane >> 5); wv[i] = (sc >= 0) ? W[(size_t)(k0 + kk) * N + sc] : 0.f; }
#pragma unroll
    for (int i = 0; i < 32; ++i) { const int kk = 2 * i + (lane >> 5); float v = wv[i]; if (gain) v *= gain[k0 + kk]; scr[kk * 33 + (lane & 31)] = v; }
    LDS_WAIT(); asm volatile("" ::: "memory");
    const int c = lane & 7;
#pragma unroll
    for (int j = 0; j < 4; ++j) { const int n = (lane >> 3) + 8 * j; const LAS float* s = scr + (8 * c) * 33 + n;
        v4u o; o.x = pk2(s[0 * 33], s[1 * 33]); o.y = pk2(s[2 * 33], s[3 * 33]); o.z = pk2(s[4 * 33], s[5 * 33]); o.w = pk2(s[6 * 33], s[7 * 33]);
        *(GAS v4u*)(WT + (size_t)(n0 + n) * ldk + k0 + 8 * c) = o; }
    LDS_WAIT(); asm volatile("" ::: "memory");
}
__device__ __forceinline__ void p0_transposes(Frame& F, int first, int last, int wi, int nw) {
    LAS float* scr = (LAS float*)(F.lds + RING_OFF + F.wave * 16384);
    constexpr int I_IN = 16 * (NIN / 32), I_OA = 8 * 32, I_OB = 16 * 32, I_OUT = 16 * 32, I_UP = 16 * (NUP / 32);
    unsigned char* ws = F.ws;
    for (int it = first + wi; it < last; it += nw) {
        int r = it;
        if (r < I_IN) { p0_transpose_item(F.in[2], 1024, IN_TOTAL, NIN, F.in[1], MAP_WIN, (bf16*)(ws + WS_WIN), 1024, scr, r, F.lane); continue; } r -= I_IN;
        if (r < I_OA) { p0_transpose_item(F.in[13], 512, 1024, 1024, nullptr, MAP_ID, (bf16*)(ws + WS_WOA), 1536, scr, r, F.lane); continue; } r -= I_OA;
        if (r < I_OB) { p0_transpose_item(F.in[14], 1024, 1024, 1024, nullptr, MAP_ID, (bf16*)(ws + WS_WOA) + 512, 1536, scr, r, F.lane); continue; } r -= I_OB;
        if (r < I_OUT) { p0_transpose_item(F.in[15], 1024, 1024, 1024, nullptr, MAP_ID, (bf16*)(ws + WS_WOUT), 1024, scr, r, F.lane); continue; } r -= I_OUT;
        if (r < I_UP) { p0_transpose_item(F.in[17], 1024, NUP, NUP, F.in[16], MAP_WUP, (bf16*)(ws + WS_WUP), 1024, scr, r, F.lane); continue; } r -= I_UP;
        p0_transpose_item(F.in[20], DFF, 1024, 1024, nullptr, MAP_ID, (bf16*)(ws + WS_WDN), DFF, scr, r, F.lane);
    }
}
constexpr int P0_I_IN = 16 * (NIN / 32), P0_NITEMS = P0_I_IN + 8 * 32 + 16 * 32 + 16 * 32 + 16 * (NUP / 32) + (DFF / 64) * 32;
__device__ __forceinline__ bool p0_defer(int G) { return G == 256; }
__device__ __forceinline__ void p0_prologue(Frame& F) {
    const int gw = F.vcu * NWAVES + F.wave, NGW = F.G * NWAVES;
    unsigned char* ws = F.ws;
    p0_transposes(F, 0, p0_defer(F.G) ? P0_I_IN : P0_NITEMS, gw, NGW);
    if (F.vcu == 1 && F.wave == 0) {
        const float mq = wave_max(fabsf(F.in[3][F.lane])), mk = wave_max(fabsf(F.in[4][F.lane]));
        if (F.lane == 0) ((float*)(ws + WS_GAINS))[192] = 8.0f * mq * mk * 1.15f;
    }
    if (F.vcu == 0 && F.tid < 192) { float* gd = (float*)(ws + WS_GAINS); const int j = F.tid >> 6, d = F.tid & 63; const float v0 = F.in[3][d], v1 = F.in[4][d], v2 = F.in[5][d]; gd[F.tid] = j == 0 ? v0 : (j == 1 ? v1 : v2); }
    const float* x = F.in[0]; bf16* xb = (bf16*)(ws + WS_XB); float* rinv1 = (float*)(ws + WS_RINV1);
    for (int m0 = gw; m0 < M; m0 += 4 * NGW) {
        f32x4 v[4][4];
#pragma unroll
        for (int q = 0; q < 4; ++q) { const int m = m0 + q * NGW; const GAS f32x4* xr = (const GAS f32x4*)(x + (size_t)(m < M ? m : m0) * DM) + F.lane;
#pragma unroll
            for (int j = 0; j < 4; ++j) v[q][j] = xr[64 * j]; }
#pragma unroll
        for (int q = 0; q < 4; ++q) { const int m = m0 + q * NGW; if (m >= M) break;
            float s = 0.f;
#pragma unroll
            for (int j = 0; j < 4; ++j) s += (v[q][j].x * v[q][j].x + v[q][j].y * v[q][j].y) + (v[q][j].z * v[q][j].z + v[q][j].w * v[q][j].w);
            s = wave_sum(s);
            const float ri = 1.0f / sqrtf(s * (1.0f / DM) + EPS);
            GAS unsigned long long* o8 = (GAS unsigned long long*)(xb + (size_t)m * DM) + F.lane;
#pragma unroll
            for (int j = 0; j < 4; ++j) o8[64 * j] = (unsigned long long)pk2(v[q][j].x * ri, v[q][j].y * ri) | ((unsigned long long)pk2(v[q][j].z * ri, v[q][j].w * ri) << 32);
            if (F.lane == 0) rinv1[m] = sqrtf(s * (1.0f / DM) + EPS); }
    }
}

typedef float f32x16 __attribute__((ext_vector_type(16)));
typedef short v4i16_t __attribute__((ext_vector_type(4)));
__device__ __forceinline__ unsigned f2key(float f) { unsigned u = __builtin_bit_cast(unsigned, f); u = (u == 0x80000000u) ? 0u : u; return (u & 0x80000000u) ? ~u : (u | 0x80000000u); }
__device__ __forceinline__ unsigned lds_add_rtn(LAS unsigned* p, unsigned v) { return __hip_atomic_fetch_add(p, v, __ATOMIC_RELAXED, __HIP_MEMORY_SCOPE_WORKGROUP); }
__device__ __forceinline__ void lds_add(LAS unsigned* p, unsigned v) { (void)__hip_atomic_fetch_add(p, v, __ATOMIC_RELAXED, __HIP_MEMORY_SCOPE_WORKGROUP); }

__device__ __forceinline__ void slow_select(Frame& F, int qidx, LAS unsigned* keys, unsigned short* dst) {
    const int lane = F.lane, ksub = lane >> 3, chunk = lane & 7;
    const unsigned long long lt_mask = (lane == 0) ? 0ull : (~0ull >> (64 - lane));
    const bf16* PA = (const bf16*)(F.ws + WS_PA); const bf16* KI = (const bf16*)(F.ws + WS_KI); const float* WI = (const float*)(F.ws + WS_WI);
    const int b = qidx / SEQ, t = qidx % SEQ, n = t + 1;
    const bf16* qrow = PA + (size_t)qidx * PA_LD; const bf16* kbase = KI + (size_t)b * SEQ * 64;
    float qi[4][8];
#pragma unroll
    for (int h = 0; h < 4; ++h) { const v4u u = *(const GAS v4u*)(qrow + PA_QI + h * 64 + chunk * 8);
        qi[h][0] = bflo(u.x); qi[h][1] = bfhi(u.x); qi[h][2] = bflo(u.y); qi[h][3] = bfhi(u.y); qi[h][4] = bflo(u.z); qi[h][5] = bfhi(u.z); qi[h][6] = bflo(u.w); qi[h][7] = bfhi(u.w); }
    const f32x4 wv = *(const GAS f32x4*)(WI + (size_t)qidx * 4);
    for (int s0 = 0; s0 < n; s0 += 8) {
        const int s = s0 + ksub; const int sc = s < n ? s : t;
        const v4u u = *(const GAS v4u*)(kbase + (size_t)sc * 64 + chunk * 8);
        const float kf[8] = {bflo(u.x), bfhi(u.x), bflo(u.y), bfhi(u.y), bflo(u.z), bfhi(u.z), bflo(u.w), bfhi(u.w)};
        float a[4];
#pragma unroll
        for (int h = 0; h < 4; ++h) { float x = 0.f;
#pragma unroll
            for (int e = 0; e < 8; ++e) x += kf[e] * qi[h][e];
            x += __shfl_xor(x, 1); x += __shfl_xor(x, 2); x += __shfl_xor(x, 4); a[h] = x; }
        const float score = wv.x * fmaxf(a[0], 0.f) + wv.y * fmaxf(a[1], 0.f) + wv.z * fmaxf(a[2], 0.f) + wv.w * fmaxf(a[3], 0.f);
        if (chunk == 0 && s < n) keys[s] = f2key(score);
    }
    if (n > TOPK) {
        unsigned prefix = 0u;
        for (int bit = 31; bit >= 0; --bit) {
            const unsigned cand = prefix | (1u << bit);
            int cnt = 0;
            for (int s = lane; s < n; s += 64) cnt += (keys[s] >= cand) ? 1 : 0;
            cnt = wave_sum_i(cnt);
            if (cnt >= TOPK) prefix = cand;
        }
        const unsigned tau = prefix;
        int cgt = 0;
        for (int s = lane; s < n; s += 64) cgt += (keys[s] > tau) ? 1 : 0;
        cgt = wave_sum_i(cgt);
        const int need = TOPK - cgt;
        int base = 0, eqseen = 0;
        for (int s0 = 0; s0 < n; s0 += 64) {
            const int s = s0 + lane; const bool in = s < n; const unsigned k = in ? keys[s] : 0u;
            const bool gt = in && k > tau, eq = in && k == tau;
            const unsigned long long beq = __ballot(eq);
            const int rank_eq = eqseen + __popcll(beq & lt_mask);
            const bool take = gt || (eq && rank_eq < need);
            const unsigned long long bs = __ballot(take);
            if (take) dst[base + __popcll(bs & lt_mask)] = (unsigned short)s;
            base += __popcll(bs); eqseen += __popcll(beq);
        }
    } else {
        for (int j = lane; j < TOPK; j += 64) dst[j] = (unsigned short)(j < n ? j : t);
    }
}

constexpr int TK_ROW = 4112, TK_CROW = 4112, TK_CAP = 512;
constexpr int TK_SEL_OFF = 32 * 4112, TK_SM_OFF = PHASE_LDS - 1664;
static_assert(TK_SM_OFF + 1024 <= PHASE_LDS, "top-k LDS map");
__device__ __forceinline__ int crow16(int r, int hi) { return (r & 3) + 8 * (r >> 2) + 4 * hi; }

__device__ __forceinline__ float relu_asm(float x) { const int i = __builtin_bit_cast(int, x); return __builtin_bit_cast(float, i > 0 ? i : 0); }
__device__ __forceinline__ unsigned key_of(float sc) { const unsigned u = __builtin_bit_cast(unsigned, sc); return u ^ (((unsigned)((int)u >> 31)) | 0x80000000u); }
constexpr int TK_TRASH_OFF = TK_SM_OFF + 1024;
static_assert(TK_TRASH_OFF + 640 <= PHASE_LDS, "top-k LDS map");
constexpr int TK2_CAP = 768, TK2_KROW = TK2_CAP * 4 + 16, TK2_IROW = TK2_CAP * 2 + 8, TK2_IDX_OFF = 32 * TK2_KROW, TK2_TARGET = 470;
static_assert(TK2_IDX_OFF + 32 * TK2_IROW <= TK_SM_OFF, "top-k LDS map");
#ifndef TK_PIPE
#define TK_PIPE 1
#endif
#ifndef TK_SPLIT_HEADS
#define TK_SPLIT_HEADS 1
#endif
#ifndef TK_SKEW
#define TK_SKEW 0
#endif
#ifndef TK_EXECSTORE
#define TK_EXECSTORE 0
#endif
#ifndef TK_FAST
#define TK_FAST 1
#endif
template <int CTRL> __device__ __forceinline__ unsigned dpp_mov0(unsigned x) { return (unsigned)__builtin_amdgcn_update_dpp(0, (int)x, CTRL, 0xF, 0xF, false); }
__device__ __forceinline__ unsigned wave_sum_dpp(unsigned x) {
    x += dpp_mov0<0xB1>(x); x += dpp_mov0<0x4E>(x); x += dpp_mov0<0x124>(x); x += dpp_mov0<0x128>(x);
    return (unsigned)__builtin_amdgcn_readlane((int)x, 0) + (unsigned)__builtin_amdgcn_readlane((int)x, 16) + (unsigned)__builtin_amdgcn_readlane((int)x, 32) + (unsigned)__builtin_amdgcn_readlane((int)x, 48);
}
__device__ __forceinline__ unsigned wave_max_dpp(unsigned x) {
    unsigned y;
    y = dpp_mov0<0xB1>(x); x = x > y ? x : y; y = dpp_mov0<0x4E>(x); x = x > y ? x : y; y = dpp_mov0<0x124>(x); x = x > y ? x : y; y = dpp_mov0<0x128>(x); x = x > y ? x : y;
    const unsigned a = (unsigned)__builtin_amdgcn_readlane((int)x, 0), b = (unsigned)__builtin_amdgcn_readlane((int)x, 16), c = (unsigned)__builtin_amdgcn_readlane((int)x, 32), d = (unsigned)__builtin_amdgcn_readlane((int)x, 48);
    const unsigned ab = a > b ? a : b, cd = c > d ? c : d; return ab > cd ? ab : cd;
}
__device__ __forceinline__ unsigned wave_excl_scan_dpp(unsigned c, int lane) {
    unsigned x = c;
    x += dpp_mov0<0x111>(x); x += dpp_mov0<0x112>(x); x += dpp_mov0<0x114>(x); x += dpp_mov0<0x118>(x);
    const unsigned t0 = (unsigned)__builtin_amdgcn_readlane((int)x, 15), t1 = (unsigned)__builtin_amdgcn_readlane((int)x, 31), t2 = (unsigned)__builtin_amdgcn_readlane((int)x, 47);
    const int row = lane >> 4;
    return x - c + (row >= 1 ? t0 : 0u) + (row >= 2 ? t1 : 0u) + (row >= 3 ? t2 : 0u);
}
__device__ __forceinline__ void tk_keys(unsigned (&keyv)[16], const pg8::bf16x8 (&a0)[4], const pg8::bf16x8 (&qf)[4][4], f32x4 wv) {
    const f32x16 z16 = (f32x16){0.f, 0.f, 0.f, 0.f, 0.f, 0.f, 0.f, 0.f, 0.f, 0.f, 0.f, 0.f, 0.f, 0.f, 0.f, 0.f};
    f32x16 accA, accB;
    float part[16];
    accA = __builtin_amdgcn_mfma_f32_32x32x16_bf16(a0[0], qf[0][0], z16, 0, 0, 0); accB = __builtin_amdgcn_mfma_f32_32x32x16_bf16(a0[0], qf[1][0], z16, 0, 0, 0);
#pragma unroll
    for (int ks = 1; ks < 4; ++ks) { accA = __builtin_amdgcn_mfma_f32_32x32x16_bf16(a0[ks], qf[0][ks], accA, 0, 0, 0); accB = __builtin_amdgcn_mfma_f32_32x32x16_bf16(a0[ks], qf[1][ks], accB, 0, 0, 0); }
#pragma unroll
    for (int r = 0; r < 16; ++r) { const float sc = __builtin_fmaf(wv.x, relu_asm(accA[r]), 0.0f); part[r] = __builtin_fmaf(wv.y, relu_asm(accB[r]), sc); }
    if (TK_SPLIT_HEADS) __builtin_amdgcn_sched_barrier(0);
    accA = __builtin_amdgcn_mfma_f32_32x32x16_bf16(a0[0], qf[2][0], z16, 0, 0, 0); accB = __builtin_amdgcn_mfma_f32_32x32x16_bf16(a0[0], qf[3][0], z16, 0, 0, 0);
#pragma unroll
    for (int ks = 1; ks < 4; ++ks) { accA = __builtin_amdgcn_mfma_f32_32x32x16_bf16(a0[ks], qf[2][ks], accA, 0, 0, 0); accB = __builtin_amdgcn_mfma_f32_32x32x16_bf16(a0[ks], qf[3][ks], accB, 0, 0, 0); }
#pragma unroll
    for (int r = 0; r < 16; ++r) { float sc = __builtin_fmaf(wv.z, relu_asm(accA[r]), part[r]); sc = __builtin_fmaf(wv.w, relu_asm(accB[r]), sc); keyv[r] = key_of(sc); }
}
template <int PASS, bool DIAG>
__device__ __forceinline__ void tk_consume(LAS unsigned char* L, const unsigned (&keyv)[16], int kt, int r32, int hi, int lane, unsigned bstar, LAS unsigned* hrow, LAS unsigned* sm, LAS unsigned short* selr) {
    if (PASS == 1) {
#pragma unroll
        for (int r = 0; r < 16; ++r) {
            const unsigned k = keyv[r];
            LAS unsigned* wp = (LAS unsigned*)((LAS unsigned char*)hrow + ((k >> 20) & 0xFFCu));
            const unsigned val = 1u << ((k >> 17) & 16u);
            if (DIAG) { if (crow16(r, hi) <= r32) lds_add(wp, val); } else lds_add(wp, val);
        }
    } else if (PASS == 3) {
        unsigned c = 0u; const unsigned thr = bstar << 20;
#pragma unroll
        for (int r = 0; r < 16; ++r) { const bool v = !DIAG || crow16(r, hi) <= r32; c += (v && keyv[r] >= thr) ? 1u : 0u; }
        unsigned pos = lds_add_rtn(sm + 128 + r32, c);
        LAS unsigned short* const trash16 = (LAS unsigned short*)(L + TK_TRASH_OFF) + lane;
        LAS unsigned* const trash32 = (LAS unsigned*)(L + TK_TRASH_OFF + 128) + lane;
        LAS unsigned* const keyr = (LAS unsigned*)(L + r32 * TK2_KROW);
        LAS unsigned short* const idxr = (LAS unsigned short*)(L + TK2_IDX_OFF + r32 * TK2_IROW);
#pragma unroll
        for (int r = 0; r < 16; ++r) { const unsigned s = (unsigned)(32 * kt + crow16(r, hi)); const bool v = !DIAG || crow16(r, hi) <= r32;
            const bool p = v && keyv[r] >= thr; const bool st = p && pos < (unsigned)TK2_CAP;
#if TK_EXECSTORE
            if (st) { keyr[pos] = keyv[r]; idxr[pos] = (unsigned short)s; } pos += p ? 1u : 0u; }
#else
            LAS unsigned* pk = st ? keyr + pos : trash32; *pk = keyv[r];
            LAS unsigned short* pi = st ? idxr + pos : trash16; *pi = (unsigned short)s; pos += p ? 1u : 0u; }
#endif
    } else {
        unsigned csel = 0u, ccand = 0u;
#pragma unroll
        for (int r = 0; r < 16; ++r) { const unsigned bin = keyv[r] >> 21; const bool v = !DIAG || crow16(r, hi) <= r32; csel += (v && bin > bstar) ? 1u : 0u; ccand += (v && bin == bstar) ? 1u : 0u; }
        unsigned psel = lds_add_rtn(sm + 96 + r32, csel);
        unsigned pcand = lds_add_rtn(sm + 128 + r32, ccand);
        LAS unsigned short* const trash16 = (LAS unsigned short*)(L + TK_TRASH_OFF) + lane;
        LAS unsigned long long* const trash64 = (LAS unsigned long long*)(L + TK_TRASH_OFF + 128) + lane;
        LAS unsigned long long* const candr = (LAS unsigned long long*)(L + r32 * TK_CROW);
#pragma unroll
        for (int r = 0; r < 16; ++r) { const unsigned bin = keyv[r] >> 21; const unsigned s = (unsigned)(32 * kt + crow16(r, hi)); const bool v = !DIAG || crow16(r, hi) <= r32;
            const bool isS = v && bin > bstar, isC = v && bin == bstar;
            LAS unsigned short* ps = (isS && psel < 256u) ? selr + psel : trash16; *ps = (unsigned short)s; psel += isS ? 1u : 0u;
            LAS unsigned long long* pc = (isC && pcand < (unsigned)TK_CAP) ? candr + pcand : trash64; *pc = ((unsigned long long)keyv[r] << 32) | s; pcand += isC ? 1u : 0u; }
    }
}
template <int PASS>
__device__ __forceinline__ void tk_pass(LAS unsigned char* L, const bf16* KIb, int ntiles, int wave, int r32, int hi, int lane, const pg8::bf16x8 (&qf)[4][4], f32x4 wv, unsigned bstar) {
    typedef pg8::bf16x8 bx8;
    const bf16* kp0 = KIb + (size_t)r32 * 64 + hi * 8;
    LAS unsigned* hrow = (LAS unsigned*)(L + r32 * TK_ROW);
    LAS unsigned* sm = (LAS unsigned*)(L + TK_SM_OFF);
    LAS unsigned short* selr = (LAS unsigned short*)(L + TK_SEL_OFF) + r32 * 256;
    bx8 a0[4], a1[4];
    if (TK_SKEW > 0 && wave >= 4) __builtin_amdgcn_s_sleep(TK_SKEW);
    int kt = wave;
    { const int k0 = kt < ntiles ? kt : 0;
#pragma unroll
      for (int ks = 0; ks < 4; ++ks) a0[ks] = *(const GAS bx8*)(kp0 + (size_t)k0 * 32 * 64 + ks * 16); }
    for (; kt < ntiles; kt += 8) {
        const int ktn = (kt + 8 < ntiles) ? kt + 8 : kt;
#pragma unroll
        for (int ks = 0; ks < 4; ++ks) a1[ks] = *(const GAS bx8*)(kp0 + (size_t)ktn * 32 * 64 + ks * 16);
        unsigned keyv[16];
        tk_keys(keyv, a0, qf, wv);
        if (kt == ntiles - 1) tk_consume<PASS, true>(L, keyv, kt, r32, hi, lane, bstar, hrow, sm, selr);
        else tk_consume<PASS, false>(L, keyv, kt, r32, hi, lane, bstar, hrow, sm, selr);
#pragma unroll
        for (int ks = 0; ks < 4; ++ks) a0[ks] = a1[ks];
    }
}

__device__ __forceinline__ void tk_mfma2(f32x16& accA, f32x16& accB, const pg8::bf16x8 (&a)[4], const pg8::bf16x8 (&qf)[4][4], int h0) {
    const f32x16 z16 = (f32x16){0.f, 0.f, 0.f, 0.f, 0.f, 0.f, 0.f, 0.f, 0.f, 0.f, 0.f, 0.f, 0.f, 0.f, 0.f, 0.f};
    accA = __builtin_amdgcn_mfma_f32_32x32x16_bf16(a[0], qf[h0][0], z16, 0, 0, 0); accB = __builtin_amdgcn_mfma_f32_32x32x16_bf16(a[0], qf[h0 + 1][0], z16, 0, 0, 0);
#pragma unroll
    for (int ks = 1; ks < 4; ++ks) { accA = __builtin_amdgcn_mfma_f32_32x32x16_bf16(a[ks], qf[h0][ks], accA, 0, 0, 0); accB = __builtin_amdgcn_mfma_f32_32x32x16_bf16(a[ks], qf[h0 + 1][ks], accB, 0, 0, 0); }
}
__device__ __forceinline__ void tk_pass_collect(LAS unsigned char* L, const bf16* KIb, int ntiles, int wave, int r32, int hi, int lane, const pg8::bf16x8 (&qf)[4][4], f32x4 wv, unsigned bstar) {
    typedef pg8::bf16x8 bx8;
    const bf16* kp0 = KIb + (size_t)r32 * 64 + hi * 8;
    LAS unsigned* hrow = (LAS unsigned*)(L + r32 * TK_ROW);
    LAS unsigned* sm = (LAS unsigned*)(L + TK_SM_OFF);
    LAS unsigned short* selr = (LAS unsigned short*)(L + TK_SEL_OFF) + r32 * 256;
    int kt = wave;
    if (kt >= ntiles) return;
    bx8 an[4], a2[4];
#pragma unroll
    for (int ks = 0; ks < 4; ++ks) an[ks] = *(const GAS bx8*)(kp0 + (size_t)kt * 32 * 64 + ks * 16);
    { const int k1 = kt + 8 < ntiles ? kt + 8 : kt;
#pragma unroll
      for (int ks = 0; ks < 4; ++ks) a2[ks] = *(const GAS bx8*)(kp0 + (size_t)k1 * 32 * 64 + ks * 16); }
    unsigned keyv[16];
    tk_keys(keyv, an, qf, wv);
#pragma unroll
    for (int ks = 0; ks < 4; ++ks) an[ks] = a2[ks];
    while (kt + 8 < ntiles) {
        f32x16 accA, accB;
        tk_mfma2(accA, accB, an, qf, 0);
        { const int k2 = kt + 16 < ntiles ? kt + 16 : kt + 8;
#pragma unroll
          for (int ks = 0; ks < 4; ++ks) a2[ks] = *(const GAS bx8*)(kp0 + (size_t)k2 * 32 * 64 + ks * 16); }
        __builtin_amdgcn_sched_barrier(0);
        tk_consume<3, false>(L, keyv, kt, r32, hi, lane, bstar, hrow, sm, selr);
        __builtin_amdgcn_sched_barrier(0);
        float part[16];
#pragma unroll
        for (int r = 0; r < 16; ++r) { const float sc = __builtin_fmaf(wv.x, relu_asm(accA[r]), 0.0f); part[r] = __builtin_fmaf(wv.y, relu_asm(accB[r]), sc); }
        __builtin_amdgcn_sched_barrier(0);
        tk_mfma2(accA, accB, an, qf, 2);
#pragma unroll
        for (int r = 0; r < 16; ++r) { float sc = __builtin_fmaf(wv.z, relu_asm(accA[r]), part[r]); sc = __builtin_fmaf(wv.w, relu_asm(accB[r]), sc); keyv[r] = key_of(sc); }
#pragma unroll
        for (int ks = 0; ks < 4; ++ks) an[ks] = a2[ks];
        kt += 8;
    }
    if (kt == ntiles - 1) tk_consume<3, true>(L, keyv, kt, r32, hi, lane, bstar, hrow, sm, selr);
    else tk_consume<3, false>(L, keyv, kt, r32, hi, lane, bstar, hrow, sm, selr);
}
template <int NJ>
__device__ __forceinline__ void tk2_select(LAS unsigned char* L, LAS unsigned* sm, int r, int m, int lane5, bool dry) {
        const LAS unsigned* keyr = (const LAS unsigned*)(L + r * TK2_KROW);
        const LAS unsigned short* idxr = (const LAS unsigned short*)(L + TK2_IDX_OFF + r * TK2_IROW);
        unsigned kr[NJ], ir[NJ];
#pragma unroll
        for (int j = 0; j < NJ; ++j) { const int i = lane5 + 64 * j; const unsigned kv = keyr[i]; ir[j] = (unsigned)idxr[i]; kr[j] = i < m ? kv : 0u; }
        unsigned tau = 0u, X = 0xFFFFu, gt_thr = 0u; bool eq_en = true;
        if (m > 256) {
            unsigned mx = kr[0];
#pragma unroll
            for (int j = 1; j < NJ; ++j) mx = mx > kr[j] ? mx : kr[j];
            mx = wave_max_dpp(mx);
            const unsigned lo0 = (unsigned)__builtin_amdgcn_readfirstlane((int)sm[r]) << 20;
            const unsigned dmax = mx - lo0; unsigned prefix = 0u, exact_ge = 0u;
            if (dmax != 0u) {
                for (int bit = 31 - __builtin_clz(dmax); bit >= 0; --bit) {
                    const unsigned d = prefix | (1u << bit);
                    if (d > dmax) continue;
                    const unsigned cand = lo0 + d;
                    unsigned c = 0u;
#pragma unroll
                    for (int j = 0; j < NJ; ++j) c += kr[j] >= cand ? 1u : 0u;
                    const unsigned cnt = wave_sum_dpp(c);
                    if (cnt == 256u) { exact_ge = cand; break; }
                    if (cnt > 256u) prefix = d;
                }
            }
            tau = lo0 + prefix;
            if (exact_ge != 0u) { gt_thr = exact_ge - 1u; eq_en = false; }
            else {
                gt_thr = tau;
                unsigned c2 = 0u;
#pragma unroll
                for (int j = 0; j < NJ; ++j) { const bool in = lane5 + 64 * j < m; c2 += (kr[j] > tau ? 1u : 0u) + ((kr[j] == tau) & in ? 0x10000u : 0u); }
                const unsigned t2 = wave_sum_dpp(c2);
                const int need_eq = 256 - (int)(t2 & 0xFFFFu), ceq = (int)(t2 >> 16);
                if (need_eq < ceq) {
                    unsigned xp = 0u;
                    for (int bit = 11; bit >= 0; --bit) {
                        const unsigned cand = xp | (1u << bit);
                        unsigned c = 0u;
#pragma unroll
                        for (int j = 0; j < NJ; ++j) { const bool in = lane5 + 64 * j < m; c += ((kr[j] == tau) & (ir[j] < cand) & in) ? 1u : 0u; }
                        if ((int)wave_sum_dpp(c) < need_eq) xp = cand;
                    }
                    X = xp;
                }
            }
        }
        LAS unsigned short* lst = (LAS unsigned short*)(L + (dry ? TK_TRASH_OFF + 128 : r * TK2_KROW));
        LAS unsigned short* const trash16 = (LAS unsigned short*)(L + TK_TRASH_OFF) + lane5;
        unsigned tk = 0u, nt = 0u;
#pragma unroll
        for (int j = 0; j < NJ; ++j) {
            const bool in = lane5 + 64 * j < m;
            const bool take = in & ((kr[j] > gt_thr) | (eq_en & (kr[j] == tau) & (ir[j] <= X)));
            tk |= take ? (1u << j) : 0u; nt += take ? 1u : 0u;
        }
        unsigned pos = wave_excl_scan_dpp(nt, lane5);
#pragma unroll
        for (int j = 0; j < NJ; ++j) {
            const bool take = (tk >> j) & 1u;
            LAS unsigned short* pw = (take & (pos < 256u)) ? lst + pos : trash16; *pw = (unsigned short)ir[j]; pos += take ? 1u : 0u;
        }
    }
__device__ __forceinline__ void p3_topk(Frame& F, int qrep) {
    typedef pg8::bf16x8 bx8;
    LAS unsigned char* L = F.lds;
    LAS unsigned* sm = (LAS unsigned*)(L + TK_SM_OFF);
    const int tid = F.tid, wave = F.wave;
    const bf16* PA = (const bf16*)(F.ws + WS_PA); const bf16* KI = (const bf16*)(F.ws + WS_KI); const float* WI = (const float*)(F.ws + WS_WI);
    unsigned short* SELG = (unsigned short*)F.out;
    constexpr int NUNITS = NB * 120;
#if TKPROBE == 21
    unsigned probe_steps = 0u;
#endif
    for (;;) {
        __syncthreads();
        if (tid == 0) sm[161] = __hip_atomic_fetch_add(F.ctl + CW_QUEUE + 64 * qrep, 1u, RLX_AGENT);
        __syncthreads();
        const int u = __builtin_amdgcn_readfirstlane((int)sm[161]);
#if TKPROBE == 21
        if (u >= NUNITS) { if (F.lane == 0) (void)__hip_atomic_fetch_add(F.ctl + CW_QUEUE + 32, probe_steps, RLX_AGENT); }
#endif
        if (u >= NUNITS) break;
        const int qb = 127 - (u >> 3), b = u & 7, q0 = qb * 32, ntiles = qb + 1;
        int lane_p = F.lane; asm volatile("" : "+v"(lane_p));
        const int r32 = lane_p & 31, hi = lane_p >> 5;
        const int t = q0 + r32;
        const bf16* KIb = KI + (size_t)b * SEQ * 64;
        bx8 qf[4][4];
        { const bf16* qrow = PA + (size_t)(b * SEQ + t) * PA_LD + PA_QI + hi * 8;
#pragma unroll
          for (int h = 0; h < 4; ++h)
#pragma unroll
              for (int ks = 0; ks < 4; ++ks) qf[h][ks] = *(const GAS bx8*)(qrow + h * 64 + ks * 16); }
        const f32x4 wv = *(const GAS f32x4*)(WI + (size_t)(b * SEQ + t) * 4);
#ifndef TKPROBE
#define TKPROBE 0
#endif
#if TK_FAST
        {
            const int ns = ntiles > 24 ? (ntiles - 1) >> 3 : 0;
            bx8 sa0[4];
            { const int j0 = wave < ns ? wave : 0;
              const bf16* kp0 = KIb + (size_t)r32 * 64 + hi * 8;
#pragma unroll
              for (int ks = 0; ks < 4; ++ks) sa0[ks] = *(const GAS bx8*)(kp0 + (size_t)(8 * j0 + 7) * 32 * 64 + ks * 16); }
            for (int rp11 = 0; rp11 < (TKPROBE == 11 ? 2 : 1); ++rp11) {
            if (ns > 0) {
                for (int i = tid; i < (32 * 4112) / 16; i += NWAVES * 64) *(LAS v4u*)(L + i * 16) = (v4u){0u, 0u, 0u, 0u};
            }
            if (tid < 32) sm[tid] = 0u;
            if ((tid >= 128 && tid < 160) || tid == 162) sm[tid] = 0u;
            __syncthreads();
            if (ns > 0) {
                LAS unsigned char* hrow8 = L + r32 * TK_ROW;
                if (wave < ns) { unsigned keyv[16]; tk_keys(keyv, sa0, qf, wv);
#pragma unroll
                    for (int r = 0; r < 16; ++r) { const unsigned k = keyv[r]; lds_add((LAS unsigned*)(hrow8 + ((k >> 20) & 0xFFCu)), 1u << ((k >> 17) & 24u)); } }
                __builtin_amdgcn_sched_barrier(0);
                if (wave + 8 < ns) { unsigned keyv[16]; bx8 sa1[4];
                    { const bf16* kp1 = KIb + (size_t)r32 * 64 + hi * 8 + (size_t)(8 * (wave + 8) + 7) * 32 * 64;
#pragma unroll
                      for (int ks = 0; ks < 4; ++ks) sa1[ks] = *(const GAS bx8*)(kp1 + ks * 16); }
                    tk_keys(keyv, sa1, qf, wv);
#pragma unroll
                    for (int r = 0; r < 16; ++r) { const unsigned k = keyv[r]; lds_add((LAS unsigned*)(hrow8 + ((k >> 20) & 0xFFCu)), 1u << ((k >> 17) & 24u)); } }
                __syncthreads();
                int lane = F.lane; asm volatile("" : "+v"(lane));
#pragma unroll 1
                for (int qq = 0; qq < 4; ++qq) {
                    const int r = wave * 4 + qq;
                    unsigned T = (unsigned)ceilf((float)(TK2_TARGET * 32 * ns) / (float)(q0 + r + 1)); T = T < 1u ? 1u : T;
                    const LAS unsigned char* hr = L + r * TK_ROW + (1008 - 16 * lane) * 4;
                    v4u w[4];
#pragma unroll
                    for (int i = 0; i < 4; ++i) w[i] = *(const LAS v4u*)(hr + i * 16);
                    unsigned tot = 0u;
#pragma unroll
                    for (int i = 0; i < 4; ++i) { tot = __builtin_amdgcn_sad_u8(w[i].x, 0u, tot); tot = __builtin_amdgcn_sad_u8(w[i].y, 0u, tot); tot = __builtin_amdgcn_sad_u8(w[i].z, 0u, tot); tot = __builtin_amdgcn_sad_u8(w[i].w, 0u, tot); }
                    unsigned incl = tot;
#pragma unroll
                    for (int o = 1; o < 64; o <<= 1) { const unsigned v = __shfl_up(incl, o); if (lane >= o) incl += v; }
                    const unsigned excl = incl - tot;
                    unsigned c = excl, fcw = 0u, xw = 0u; int fw = -1;
#pragma unroll
                    for (int wi = 15; wi >= 0; --wi) {
                        const unsigned x = (wi & 3) == 0 ? w[wi >> 2].x : ((wi & 3) == 1 ? w[wi >> 2].y : ((wi & 3) == 2 ? w[wi >> 2].z : w[wi >> 2].w));
                        const unsigned sx = __builtin_amdgcn_sad_u8(x, 0u, 0u);
                        if (fw < 0 && c + sx >= T) { fw = wi; fcw = c; xw = x; }
                        c += sx;
                    }
                    c = fcw; int fb = -1;
#pragma unroll
                    for (int by = 3; by >= 0; --by) { const unsigned cnt = (xw >> (8 * by)) & 0xFFu; if (fb < 0 && c + cnt >= T) fb = by; c += cnt; }
                    if (excl < T && incl >= T) sm[r] = (unsigned)(4 * (1008 - 16 * lane + fw) + (fb < 0 ? 0 : fb));
                }
                __syncthreads();
            }
            }
            for (int rp12 = 0; rp12 < (TKPROBE == 12 ? 2 : 1); ++rp12) {
            if (rp12) { if (tid >= 128 && tid < 160) sm[tid] = 0u; __syncthreads(); }
            if (TK_PIPE) tk_pass_collect(L, KIb, ntiles, wave, r32, hi, lane_p, qf, wv, sm[r32]); else tk_pass<3>(L, KIb, ntiles, wave, r32, hi, lane_p, qf, wv, sm[r32]);
            __syncthreads();
            }
            {
                int lane5 = F.lane; asm volatile("" : "+v"(lane5));
#pragma unroll 1
                for (int qq5 = 0; qq5 < (TKPROBE == 13 ? 8 : 4); ++qq5) {
                    const int qq = qq5 & 3;
                    const int r = wave * 4 + qq;
                    const int m = (int)sm[128 + r];
                    if (m < 256 || m > TK2_CAP) { if (lane5 == 0) (void)__hip_atomic_fetch_or(sm + 162, 1u, __ATOMIC_RELAXED, __HIP_MEMORY_SCOPE_WORKGROUP); continue; }
                    const bool dry = TKPROBE == 13 && qq5 < 4;
                    if (m <= 576) tk2_select<9>(L, sm, r, m, lane5, dry); else tk2_select<12>(L, sm, r, m, lane5, dry);
}
            }
            __syncthreads();
            if (sm[162] == 0u) {
                int tid6 = F.tid; asm volatile("" : "+v"(tid6)); const int r = tid6 >> 4, c16 = (tid6 & 15) * 16;
                const LAS unsigned short* src = (const LAS unsigned short*)(L + r * TK2_KROW) + c16;
                const v4u v0 = *(const LAS v4u*)src, v1 = *(const LAS v4u*)(src + 8);
                unsigned short* dst = SELG + (size_t)(b * SEQ + q0 + r) * 256 + c16;
                *(GAS v4u*)dst = v0; *(GAS v4u*)(dst + 8) = v1;
                continue;
            }
#if TKPROBE == 9
            if (tid == 0) (void)__hip_atomic_fetch_add(F.ctl + CW_QUEUE + 32, 1u, RLX_AGENT);
#endif
        }
#endif

        for (int rep1 = 0; rep1 < (TKPROBE == 1 ? 2 : 1); ++rep1) {
        __syncthreads();
        for (int i = tid; i < (32 * 4112) / 16; i += NWAVES * 64) *(LAS v4u*)(L + i * 16) = (v4u){0u, 0u, 0u, 0u};
        if (tid >= 96 && tid < 161) sm[tid] = 0u;
        __syncthreads();
        tk_pass<1>(L, KIb, ntiles, wave, r32, hi, lane_p, qf, wv, 0u);
        __syncthreads();
        }
        int lane = F.lane; asm volatile("" : "+v"(lane));
#pragma unroll 1
        for (int qq3 = 0; qq3 < (TKPROBE == 2 ? 8 : 4); ++qq3) {
            const int qq = qq3 & 3; const int r = wave * 4 + qq;
            const LAS unsigned char* hr = L + r * TK_ROW + (1008 - 16 * lane) * 4;
            v4u w[4];
#pragma unroll
            for (int i = 0; i < 4; ++i) w[i] = *(const LAS v4u*)(hr + i * 16);
            unsigned tot = 0u;
#pragma unroll
            for (int i = 0; i < 4; ++i) { tot += (w[i].x & 0xffffu) + (w[i].x >> 16); tot += (w[i].y & 0xffffu) + (w[i].y >> 16); tot += (w[i].z & 0xffffu) + (w[i].z >> 16); tot += (w[i].w & 0xffffu) + (w[i].w >> 16); }
            unsigned incl = tot;
#pragma unroll
            for (int o = 1; o < 64; o <<= 1) { const unsigned v = __shfl_up(incl, o); if (lane >= o) incl += v; }
            const unsigned excl = incl - tot;
            unsigned c = excl; int fb = -1; unsigned fc = 0u, fm = 0u;
#pragma unroll
            for (int wi = 15; wi >= 0; --wi) {
                const unsigned x = (wi & 3) == 0 ? w[wi >> 2].x : ((wi & 3) == 1 ? w[wi >> 2].y : ((wi & 3) == 2 ? w[wi >> 2].z : w[wi >> 2].w));
                const int bin0 = 2 * (1008 - 16 * lane + wi);
                unsigned cnt = x >> 16;
                if (fb < 0 && c + cnt >= 256u) { fb = bin0 + 1; fc = c; fm = cnt; }
                c += cnt; cnt = x & 0xffffu;
                if (fb < 0 && c + cnt >= 256u) { fb = bin0; fc = c; fm = cnt; }
                c += cnt;
            }
            if (excl < 256u && incl >= 256u) { sm[r] = (unsigned)fb; sm[32 + r] = fc; sm[64 + r] = fm; if (fm > (unsigned)TK_CAP) (void)__hip_atomic_fetch_or(sm + 160, 1u << r, __ATOMIC_RELAXED, __HIP_MEMORY_SCOPE_WORKGROUP); }
        }
        __syncthreads();
        for (int rep2 = 0; rep2 < (TKPROBE == 3 ? 2 : 1); ++rep2) {
        if (rep2) { if (tid >= 96 && tid < 160) sm[tid] = 0u; __syncthreads(); }
        tk_pass<2>(L, KIb, ntiles, wave, r32, hi, lane_p, qf, wv, sm[r32]);
        __syncthreads();
        }
        int lane5 = F.lane; asm volatile("" : "+v"(lane5));
        const unsigned long long lt_mask = (lane5 == 0) ? 0ull : (~0ull >> (64 - lane5));
#pragma unroll 1
        for (int qq5 = 0; qq5 < (TKPROBE == 4 ? 8 : 4); ++qq5) {
            const int qq = qq5 & 3; const int r = wave * 4 + qq;
            const unsigned m0 = sm[128 + r]; const int m = (int)(m0 < (unsigned)TK_CAP ? m0 : (unsigned)TK_CAP);
            const int cab = (int)sm[32 + r], need2 = 256 - cab; const unsigned bst = sm[r];
            if (m0 > (unsigned)TK_CAP) continue;
            const LAS unsigned long long* cd = (const LAS unsigned long long*)(L + r * TK_CROW);
            LAS unsigned short* selr = (LAS unsigned short*)(L + TK_SEL_OFF) + r * 256;
            unsigned kr[8], ir[8];
#pragma unroll
            for (int j = 0; j < 8; ++j) { const int i = lane5 + 64 * j; const unsigned long long e = i < m ? cd[i] : 0ull; kr[j] = (unsigned)(e >> 32); ir[j] = (unsigned)e & 0xFFFFu; }
            unsigned tau = 0u, X = 0xFFFFu, exact_ge = 0u;
            if (need2 < m) {
                unsigned prefix = bst << 21;
                for (int bit = 20; bit >= 0; --bit) {
                    const unsigned cand = prefix | (1u << bit);
                    int cnt = 0;
#pragma unroll
                    for (int j = 0; j < 8; ++j) cnt += __popcll(__ballot(kr[j] >= cand));
                    if (cnt == need2) { exact_ge = cand; break; }
                    if (cnt > need2) prefix = cand;
                }
                tau = prefix;
                int cgt = 0, ceq = 0;
#pragma unroll
                for (int j = 0; j < 8; ++j) { cgt += __popcll(__ballot(kr[j] > tau)); ceq += __popcll(__ballot(kr[j] == tau && lane5 + 64 * j < m)); }
                const int need_eq = need2 - cgt;
                if (exact_ge == 0u && need_eq < ceq) {
                    unsigned xp = 0u;
                    for (int bit = 11; bit >= 0; --bit) {
                        const unsigned cand = xp | (1u << bit);
                        int cnt = 0;
#pragma unroll
                        for (int j = 0; j < 8; ++j) cnt += __popcll(__ballot(kr[j] == tau && ir[j] < cand && lane5 + 64 * j < m));
                        if (cnt < need_eq) xp = cand;
                    }
                    X = xp;
                }
            }
            int base = cab;
#pragma unroll
            for (int j = 0; j < 8; ++j) {
                const bool in = lane5 + 64 * j < m;
                const bool take = in && (need2 >= m || (exact_ge != 0u ? kr[j] >= exact_ge : (kr[j] > tau || (kr[j] == tau && ir[j] <= X))));
                const unsigned long long bs = __ballot(take);
                const int pos = base + __popcll(bs & lt_mask);
                if (take && pos < 256) selr[pos] = (unsigned short)ir[j];
                base += __popcll(bs);
            }
        }
        __syncthreads();
        { int tid6 = F.tid; asm volatile("" : "+v"(tid6)); const int r = tid6 >> 4, c16 = (tid6 & 15) * 16;
          const LAS unsigned short* src = (const LAS unsigned short*)(L + TK_SEL_OFF) + r * 256 + c16;
          const v4u v0 = *(const LAS v4u*)src, v1 = *(const LAS v4u*)(src + 8);
          unsigned short* dst = SELG + (size_t)(b * SEQ + q0 + r) * 256 + c16;
          *(GAS v4u*)dst = v0; *(GAS v4u*)(dst + 8) = v1; }
        const unsigned slowmask = sm[160];
        if (slowmask) {
            asm volatile("s_waitcnt vmcnt(0)" ::: "memory"); __syncthreads();
            for (int r = wave; r < 32; r += 8) if ((slowmask >> r) & 1u) slow_select(F, b * SEQ + q0 + r, (LAS unsigned*)(L + wave * 16384), SELG + (size_t)(b * SEQ + q0 + r) * 256);
        }
    }
}

constexpr int AT_WAVE_LDS = 17408;
static_assert(8 * AT_WAVE_LDS <= PHASE_LDS, "attention LDS map");
typedef float f32x2_t __attribute__((ext_vector_type(2)));
template <bool HI> __device__ __forceinline__ unsigned fp8x2_to_bf16x2(int w) { const f32x2_t f = __builtin_amdgcn_cvt_pk_f32_fp8(w, HI);
    return pg8::cvt_pk_bf16(f.x, f.y); }
__device__ __forceinline__ void p4_attn(Frame& F) {
    typedef pg8::bf16x8 bx8;
    const int lane = F.lane, n16 = lane & 15, kg = lane >> 4;
    LAS unsigned char* wl = F.lds + F.wave * AT_WAVE_LDS;
    LAS unsigned short* sl = (LAS unsigned short*)(wl + 16384);
    const bf16* PA = (const bf16*)(F.ws + WS_PA); const unsigned char* KV = (const unsigned char*)F.out + OUT_KV; bf16* ATT = (bf16*)((unsigned char*)F.out + OUT_ARN);
    const unsigned short* SELG = (const unsigned short*)F.out;
    const int gw = F.vcu * NWAVES + F.wave, NGW = F.G * NWAVES;
    const int nq_per = (M + NGW - 1) / NGW;
    const float c2 = 0.125f * 1.4426950408889634f;
    const float mref = ((const float*)(F.ws + WS_GAINS))[192] * 8.0f; const float nmc = -mref * (0.125f * 1.4426950408889634f);
    const int trow = 4 * kg + (n16 >> 2), tx = trow & 7;
    const int trbase = trow * 256 + (n16 & 3) * 8;
    const int vkey = lane >> 3, c8 = lane & 7;
    unsigned long long lnext = 0ull;
    if (gw < M && (gw % SEQ) >= TOPK) lnext = *(const GAS unsigned long long*)(SELG + (size_t)gw * 256 + lane * 4);
#pragma unroll 1
    for (int it = 0; it < nq_per; ++it) {
        int qidx;
        if (NGW == 2048) { const int b_ = it >> 1; const int t_ = (it & 1) ? (SEQ - 1 - gw) : gw; qidx = b_ * SEQ + t_; }
        else { qidx = gw + it * NGW; if (qidx >= M) break; }
        int qn = M;
        if (it + 1 < nq_per) { if (NGW == 2048) { const int b_ = (it + 1) >> 1; const int t_ = ((it + 1) & 1) ? (SEQ - 1 - gw) : gw; qn = b_ * SEQ + t_; } else qn = gw + (it + 1) * NGW; }
        const bool qn_list = qn < M && (qn % SEQ) >= TOPK;
        const int b = qidx / SEQ, t = qidx % SEQ, cnt = (t + 1 < TOPK) ? t + 1 : TOPK;
        const GAS unsigned char* kvb = (const GAS unsigned char*)(KV + (size_t)b * SEQ * 256);
        if (t >= TOPK) { *(LAS unsigned long long*)(sl + lane * 4) = lnext; }
        else {
#pragma unroll
            for (int i = 0; i < 4; ++i) { const int j = lane * 4 + i; sl[j] = (unsigned short)(j <= t ? j : t); }
        }
        asm volatile("" ::: "memory");
        v4u vr[2][4];
#pragma unroll
        for (int c = 0; c < 2; ++c)
#pragma unroll
            for (int i = 0; i < 4; ++i) { const unsigned off = (unsigned)sl[32 * c + 8 * i + vkey] * 256u + 128u + (unsigned)c8 * 16u; vr[c][i] = *(const GAS v4u*)(kvb + off); }
        long qb[4];
        { long q0 = 0, q1 = 0;
          if (n16 < 8) { const v4u ua = *(const GAS v4u*)(PA + (size_t)qidx * PA_LD + n16 * 64 + kg * 16), ub = *(const GAS v4u*)(PA + (size_t)qidx * PA_LD + n16 * 64 + kg * 16 + 8);
              int w0 = __builtin_amdgcn_cvt_pk_fp8_f32(bflo(ua.x), bfhi(ua.x), 0, false); w0 = __builtin_amdgcn_cvt_pk_fp8_f32(bflo(ua.y), bfhi(ua.y), w0, true);
              int w1 = __builtin_amdgcn_cvt_pk_fp8_f32(bflo(ua.z), bfhi(ua.z), 0, false); w1 = __builtin_amdgcn_cvt_pk_fp8_f32(bflo(ua.w), bfhi(ua.w), w1, true);
              int w2 = __builtin_amdgcn_cvt_pk_fp8_f32(bflo(ub.x), bfhi(ub.x), 0, false); w2 = __builtin_amdgcn_cvt_pk_fp8_f32(bflo(ub.y), bfhi(ub.y), w2, true);
              int w3 = __builtin_amdgcn_cvt_pk_fp8_f32(bflo(ub.z), bfhi(ub.z), 0, false); w3 = __builtin_amdgcn_cvt_pk_fp8_f32(bflo(ub.w), bfhi(ub.w), w3, true);
              q0 = (long)((unsigned long long)(unsigned)w0 | ((unsigned long long)(unsigned)w1 << 32)); q1 = (long)((unsigned long long)(unsigned)w2 | ((unsigned long long)(unsigned)w3 << 32)); }
          const bool g1 = (n16 >> 2) == 1;
          qb[0] = g1 ? 0 : q0; qb[1] = g1 ? 0 : q1; qb[2] = g1 ? q0 : 0; qb[3] = g1 ? q1 : 0; }
        v4u ka[8][2];
#pragma unroll
        for (int T = 0; T < 7; ++T) { const unsigned off = (unsigned)sl[16 * T + n16] * 256u + (unsigned)kg * 16u;
            ka[T][0] = *(const GAS v4u*)(kvb + off); ka[T][1] = *(const GAS v4u*)(kvb + off + 64); }
        float sum = 0.f;
        bx8 pfr[8];
#pragma unroll
        for (int KS = 0; KS < 8; ++KS) {
            v4u pw;
#pragma unroll
            for (int half = 0; half < 2; ++half) { const int T = 2 * KS + half;
                asm volatile("" ::: "memory");
                if (T + 7 < 16) { const unsigned off = (unsigned)sl[16 * (T + 7) + n16] * 256u + (unsigned)kg * 16u;
                    ka[(T + 7) & 7][0] = *(const GAS v4u*)(kvb + off); ka[(T + 7) & 7][1] = *(const GAS v4u*)(kvb + off + 64); }
                f32x4 s = (f32x4){0.f, 0.f, 0.f, 0.f};
#pragma unroll
                for (int g = 0; g < 2; ++g) { const v4u kk = ka[T & 7][g];
                    const long a0 = (long)((unsigned long long)kk.x | ((unsigned long long)kk.y << 32)), a1 = (long)((unsigned long long)kk.z | ((unsigned long long)kk.w << 32));
                    s = __builtin_amdgcn_mfma_f32_16x16x32_fp8_fp8(a0, qb[2 * g], s, 0, 0, 0);
                    s = __builtin_amdgcn_mfma_f32_16x16x32_fp8_fp8(a1, qb[2 * g + 1], s, 0, 0, 0); }
                float pv4[4];
#pragma unroll
                for (int r = 0; r < 4; ++r) pv4[r] = __builtin_amdgcn_exp2f(__builtin_fmaf(s[r], c2, nmc));
                if (16 * T + 16 > cnt) {
#pragma unroll
                    for (int r = 0; r < 4; ++r) pv4[r] = (16 * T + 4 * kg + r < cnt) ? pv4[r] : 0.f; }
#pragma unroll
                for (int r = 0; r < 4; ++r) sum += pv4[r];
                if (half == 0) { pw.x = pg8::cvt_pk_bf16(pv4[0], pv4[1]); pw.y = pg8::cvt_pk_bf16(pv4[2], pv4[3]); } else { pw.z = pg8::cvt_pk_bf16(pv4[0], pv4[1]); pw.w = pg8::cvt_pk_bf16(pv4[2], pv4[3]); }
            }
            pfr[KS] = __builtin_bit_cast(bx8, pw); asm volatile("" : "+v"(pfr[KS]));
        }
        sum += __shfl_xor(sum, 16); sum += __shfl_xor(sum, 32);
        asm volatile("" ::: "memory");
        f32x4 O[8];
#pragma unroll
        for (int i = 0; i < 8; ++i) O[i] = (f32x4){0.f, 0.f, 0.f, 0.f};
#pragma unroll
        for (int KS = 0; KS < 8; ++KS) {
            LAS unsigned char* buf = wl + (KS & 1) * 8192;
            asm volatile("" ::: "memory");
#pragma unroll
            for (int i = 0; i < 4; ++i) { const int rowl = 8 * i + vkey; const v4u w = vr[KS & 1][i];
                v4u lo, hi4;
                lo.x = fp8x2_to_bf16x2<false>((int)w.x); lo.y = fp8x2_to_bf16x2<true>((int)w.x); lo.z = fp8x2_to_bf16x2<false>((int)w.y); lo.w = fp8x2_to_bf16x2<true>((int)w.y);
                hi4.x = fp8x2_to_bf16x2<false>((int)w.z); hi4.y = fp8x2_to_bf16x2<true>((int)w.z); hi4.z = fp8x2_to_bf16x2<false>((int)w.w); hi4.w = fp8x2_to_bf16x2<true>((int)w.w);
                LAS unsigned char* rp = buf + rowl * 256 + ((c8 * 32) ^ ((rowl & 7) << 5));
                *(LAS v4u*)rp = lo; *(LAS v4u*)(rp + 16) = hi4; }
            if (KS + 2 < 8) {
#pragma unroll
                for (int i = 0; i < 4; ++i) { const unsigned off = (unsigned)sl[32 * (KS + 2) + 8 * i + vkey] * 256u + 128u + (unsigned)c8 * 16u; vr[KS & 1][i] = *(const GAS v4u*)(kvb + off); }
            }
            if (KS == 5 && qn_list) lnext = *(const GAS unsigned long long*)(SELG + (size_t)qn * 256 + lane * 4);
            const bx8 pf = pfr[KS];
#pragma unroll
            for (int gd = 0; gd < 8; ++gd) {
                const LAS unsigned char* p0 = buf + trbase + ((gd ^ tx) << 5);
                const v4i16_t lo = __builtin_amdgcn_ds_read_tr16_b64_v4i16((LAS v4i16_t*)p0);
                const v4i16_t hi4 = __builtin_amdgcn_ds_read_tr16_b64_v4i16((LAS v4i16_t*)(p0 + 4096));
                const bx8 vf = (bx8){lo[0], lo[1], lo[2], lo[3], hi4[0], hi4[1], hi4[2], hi4[3]};
                O[gd] = __builtin_amdgcn_mfma_f32_16x16x32_bf16(pf, vf, O[gd], 0, 0, 0);
            }
        }
        float inv[4];
#pragma unroll
        for (int r = 0; r < 4; ++r) inv[r] = 1.0f / __shfl(sum, (4 * kg + r) & 15);
        if (kg < 2) {
            bf16* orow = ATT + (size_t)qidx * 1536 + (4 * kg) * 64 + n16;
#pragma unroll
            for (int db = 0; db < 4; ++db)
#pragma unroll
                for (int r = 0; r < 4; ++r) { const float v = (kg == 0 ? O[db][r] : O[4 + db][r]) * inv[r]; orow[r * 64 + db * 16] = (bf16)f2bf(v); }
        }
    }
}
constexpr int RG_WT_PITCH = 144;
constexpr int RG_WA_OFF = 0, RG_WX_OFF = 32 * RG_WT_PITCH, RG_XCB_OFF = 2 * 32 * RG_WT_PITCH, RG_XF_OFF = RG_XCB_OFF + 128 * RG_WT_PITCH, RG_CARR_OFF = RG_XF_OFF + 128 * 256;
constexpr int RG_STG_OFF = RG_CARR_OFF + 2 * 8 * 2 * 32 * 4, RG_STG_WAVE = 24 * 128 + 1024 + 1024;
static_assert(RG_STG_OFF + 8 * RG_STG_WAVE <= PHASE_LDS, "rg-lru LDS map");
__device__ __forceinline__ float fast_sigmoid(float x) { return __builtin_amdgcn_rcpf(1.0f + __builtin_amdgcn_exp2f(-1.4426950408889634f * x)); }
__device__ __forceinline__ void p4_rglru(Frame& F) {
    typedef pg8::bf16x8 bx8;
    const int tid = F.tid, lane = F.lane, wave = F.wave, n16 = lane & 15, kg = lane >> 4;
    LAS unsigned char* L = F.lds;
    LAS float* Xf = (LAS float*)(L + RG_XF_OFF); LAS float* carr = (LAS float*)(L + RG_CARR_OFF);
    const bf16* RX = (const bf16*)(F.ws + WS_RX); const bf16* RG = (const bf16*)(F.ws + WS_RGATE); bf16* RNN = (bf16*)((unsigned char*)F.out + OUT_ARN) + 512;
    const float* conv_w = F.in[6]; const float* conv_b = F.in[7]; const float* rg_wa = F.in[8]; const float* rg_ba = F.in[9]; const float* rg_wx = F.in[10]; const float* rg_bx = F.in[11]; const float* lam = F.in[12];
    for (int task = F.vcu; task < NB * 32; task += F.G) {
        const int b = task >> 5, nb = (task >> 1) & 15, hf = task & 1, c0 = nb * 64, e0 = 32 * hf;
        __syncthreads();
        for (int i = tid; i < 2048; i += NWAVES * 64) { const int d = i >> 5, e = i & 31;
            *(LAS bf16*)(L + RG_WA_OFF + e * RG_WT_PITCH + d * 2) = (bf16)f2bf(rg_wa[(size_t)nb * 4096 + d * 64 + e0 + e]);
            *(LAS bf16*)(L + RG_WX_OFF + e * RG_WT_PITCH + d * 2) = (bf16)f2bf(rg_wx[(size_t)nb * 4096 + d * 64 + e0 + e]); }
        const int c = c0 + lane;
        const float cw0 = conv_w[c], cw1 = conv_w[1024 + c], cw2 = conv_w[2048 + c], cw3 = conv_w[3072 + c], cb = conv_b[c];
        float bav[2], bxv[2], lsl[2];
#pragma unroll
        for (int j = 0; j < 2; ++j) { const int ce = c0 + e0 + 16 * j + n16; bav[j] = rg_ba[ce]; bxv[j] = rg_bx[ce]; lsl[j] = -8.0f * 1.4426950408889634f * log1pf(__expf(-lam[ce])); }
        float hst[2] = {0.f, 0.f};
        __syncthreads();
        LAS unsigned char* stg = L + RG_STG_OFF + wave * RG_STG_WAVE;
        const int xr_row = lane >> 3, xr_c8 = lane & 7, gt_tok = lane >> 2, gt_c8 = lane & 3;
        v4u xq[3][3], gq[3];
#pragma unroll
        for (int pc = 0; pc < 3; ++pc) { const int t0 = pc * 128 + wave * 16; const size_t rowb = (size_t)b * SEQ + t0;
#pragma unroll
            for (int i = 0; i < 3; ++i) { const int ri = 8 * i + xr_row, t = t0 - 3 + ri; xq[pc][i] = (v4u){0u, 0u, 0u, 0u};
                if (ri < 19 && t >= 0) xq[pc][i] = *(const GAS v4u*)(RX + (rowb - 3 + ri) * 1024 + c0 + xr_c8 * 8); }
            gq[pc] = *(const GAS v4u*)(RG + (rowb + gt_tok) * 1024 + c0 + e0 + gt_c8 * 8); }
#pragma unroll 1
        for (int ch = 0; ch < SEQ / 128; ++ch) {
            const int t0 = ch * 128 + wave * 16;
            const size_t rowb = (size_t)b * SEQ + t0;
#pragma unroll
            for (int i = 0; i < 3; ++i) *(LAS v4u*)(stg + (8 * i + xr_row) * 128 + xr_c8 * 16) = xq[0][i];
            *(LAS v4u*)(stg + 24 * 128 + gt_tok * 64 + gt_c8 * 16) = gq[0];
#pragma unroll
            for (int i = 0; i < 3; ++i) { xq[0][i] = xq[1][i]; xq[1][i] = xq[2][i]; }
            gq[0] = gq[1]; gq[1] = gq[2];
            if (ch + 3 < SEQ / 128) {
#pragma unroll
                for (int i = 0; i < 3; ++i) { const int ri = 8 * i + xr_row; if (ri < 19) xq[2][i] = *(const GAS v4u*)(RX + (rowb + 384 - 3 + ri) * 1024 + c0 + xr_c8 * 8); }
                gq[2] = *(const GAS v4u*)(RG + (rowb + 384 + gt_tok) * 1024 + c0 + e0 + gt_c8 * 8);
            }
            asm volatile("s_waitcnt lgkmcnt(0)" ::: "memory");
            float xv[19];
#pragma unroll
            for (int i = 0; i < 19; ++i) xv[i] = bf2f(*(const LAS unsigned short*)(stg + i * 128 + lane * 2));
#pragma unroll
            for (int i = 0; i < 16; ++i) { const float x = cb + cw0 * xv[i] + cw1 * xv[i + 1] + cw2 * xv[i + 2] + cw3 * xv[i + 3];
                Xf[(wave * 16 + i) * 64 + lane] = x; *(LAS bf16*)(L + RG_XCB_OFF + (wave * 16 + i) * RG_WT_PITCH + lane * 2) = (bf16)f2bf(x); }
            float gcur[2][4];
#pragma unroll
            for (int j = 0; j < 2; ++j)
#pragma unroll
                for (int r = 0; r < 4; ++r) gcur[j][r] = bf2f(*(const LAS unsigned short*)(stg + 24 * 128 + (4 * kg + r) * 64 + (16 * j + n16) * 2));
            asm volatile("s_waitcnt lgkmcnt(0)" ::: "memory");
            bx8 af[2];
#pragma unroll
            for (int ks = 0; ks < 2; ++ks) af[ks] = *(const LAS bx8*)(L + RG_XCB_OFF + (wave * 16 + n16) * RG_WT_PITCH + (32 * ks + 8 * kg) * 2);
            float av[2][4], bv[2][4], Pl[2], Hl[2];
#pragma unroll
            for (int j = 0; j < 2; ++j) {
                f32x4 cr = (f32x4){0.f, 0.f, 0.f, 0.f}, ci = (f32x4){0.f, 0.f, 0.f, 0.f};
#pragma unroll
                for (int ks = 0; ks < 2; ++ks) {
                    const bx8 wa_f = *(const LAS bx8*)(L + RG_WA_OFF + (16 * j + n16) * RG_WT_PITCH + (32 * ks + 8 * kg) * 2);
                    const bx8 wx_f = *(const LAS bx8*)(L + RG_WX_OFF + (16 * j + n16) * RG_WT_PITCH + (32 * ks + 8 * kg) * 2);
                    cr = __builtin_amdgcn_mfma_f32_16x16x32_bf16(af[ks], wa_f, cr, 0, 0, 0);
                    ci = __builtin_amdgcn_mfma_f32_16x16x32_bf16(af[ks], wx_f, ci, 0, 0, 0);
                }
                float p = 1.f, h = 0.f;
#pragma unroll
                for (int r = 0; r < 4; ++r) {
                    const float rr = fast_sigmoid(cr[r] + bav[j]), ig = fast_sigmoid(ci[r] + bxv[j]);
                    const float l2 = rr * lsl[j];
                    const float a = __builtin_amdgcn_exp2f(l2);
                    const float x2 = l2 * 1.3862943611198906f;
                    const float oma = x2 > -0.0625f ? -x2 * (1.0f + x2 * (0.5f + x2 * (0.16666667f + x2 * 0.041666668f))) : 1.0f - a * a;
                    const float xcv = Xf[(wave * 16 + 4 * kg + r) * 64 + e0 + 16 * j + n16];
                    const float bb = __builtin_amdgcn_sqrtf(oma) * (ig * xcv);
                    av[j][r] = a; bv[j][r] = bb; h = a * h + bb; p *= a;
                }
                Pl[j] = p; Hl[j] = h;
            }
            float Pe[2], He[2];
#pragma unroll
            for (int j = 0; j < 2; ++j) {
                float P = Pl[j], H = Hl[j];
                { const float p1 = __shfl_up(P, 16), h1 = __shfl_up(H, 16); if (kg >= 1) { H = P * h1 + H; P = P * p1; } }
                { const float p2 = __shfl_up(P, 32), h2 = __shfl_up(H, 32); if (kg >= 2) { H = P * h2 + H; P = P * p2; } }
                const float pe = __shfl_up(P, 16), he = __shfl_up(H, 16);
                Pe[j] = kg >= 1 ? pe : 1.f; He[j] = kg >= 1 ? he : 0.f;
                if (kg == 3) { LAS float* cw_ = carr + (ch & 1) * 512 + wave * 64 + j * 32; cw_[n16] = P; cw_[16 + n16] = H; }
            }
            __syncthreads();
#pragma unroll
            for (int j = 0; j < 2; ++j) {
                const LAS float* cr_ = carr + (ch & 1) * 512 + j * 32;
                float cin = 0.f, cc = hst[j];
#pragma unroll
                for (int w2 = 0; w2 < 8; ++w2) { if (w2 == wave) cin = cc; cc = cr_[w2 * 64 + n16] * cc + cr_[w2 * 64 + 16 + n16]; }
                hst[j] = cc;
                float h = Pe[j] * cin + He[j];
#pragma unroll
                for (int r = 0; r < 4; ++r) { h = av[j][r] * h + bv[j][r];
                    const float g = gcur[j][r]; const float u = 0.7978845608028654f * (g + 0.044715f * g * g * g);
                    *(LAS bf16*)(stg + 24 * 128 + 1024 + (4 * kg + r) * 64 + (16 * j + n16) * 2) = (bf16)f2bf(h * (g * fast_sigmoid(2.0f * u))); }
            }
            asm volatile("s_waitcnt lgkmcnt(0)" ::: "memory");
            { const v4u o = *(const LAS v4u*)(stg + 24 * 128 + 1024 + gt_tok * 64 + gt_c8 * 16);
              *(GAS v4u*)(RNN + (rowb + gt_tok) * 1536 + c0 + e0 + gt_c8 * 8) = o; }
        }
    }
}

constexpr int RG2_XCB_OFF = 2 * 32 * RG_WT_PITCH, RG2_XF_OFF = RG2_XCB_OFF + 256 * RG_WT_PITCH, RG2_CARR_OFF = RG2_XF_OFF + 256 * 128;
constexpr int RG2_STG_OFF = RG2_CARR_OFF + 2 * 8 * 2 * 32 * 4, RG2_STG_WAVE = 35 * 128 + 2048 + 2048;
static_assert(RG2_STG_OFF + 8 * RG2_STG_WAVE <= PHASE_LDS, "rg-lru LDS map");
__device__ __forceinline__ unsigned rg_cvt_pk(float lo, float hi) { unsigned r; asm("v_cvt_pk_bf16_f32 %0, %1, %2" : "=v"(r) : "v"(lo), "v"(hi)); return r; }
__device__ __forceinline__ void p4_rglru2(Frame& F) {
    typedef pg8::bf16x8 bx8;
    const int tid = F.tid, lane = F.lane, wave = F.wave, n16 = lane & 15, kg = lane >> 4;
    LAS unsigned char* L = F.lds;
    LAS float* Xf = (LAS float*)(L + RG2_XF_OFF); LAS float* carr = (LAS float*)(L + RG2_CARR_OFF);
    const bf16* RX = (const bf16*)(F.ws + WS_RX); const bf16* RG = (const bf16*)(F.ws + WS_RGATE); bf16* RNN = (bf16*)((unsigned char*)F.out + OUT_ARN) + 512;
    const float* conv_w = F.in[6]; const float* conv_b = F.in[7]; const float* rg_wa = F.in[8]; const float* rg_ba = F.in[9]; const float* rg_wx = F.in[10]; const float* rg_bx = F.in[11]; const float* lam = F.in[12];
    for (int task = F.vcu; task < NB * 32; task += F.G) {
        const int b = task >> 5, nb = (task >> 1) & 15, hf = task & 1, c0 = nb * 64, e0 = 32 * hf;
        __syncthreads();
        for (int i = tid; i < 2048; i += NWAVES * 64) { const int d = i >> 5, e = i & 31;
            *(LAS bf16*)(L + RG_WA_OFF + e * RG_WT_PITCH + d * 2) = (bf16)f2bf(rg_wa[(size_t)nb * 4096 + d * 64 + e0 + e]);
            *(LAS bf16*)(L + RG_WX_OFF + e * RG_WT_PITCH + d * 2) = (bf16)f2bf(rg_wx[(size_t)nb * 4096 + d * 64 + e0 + e]); }
        const int c = c0 + lane;
        const float cw0 = conv_w[c], cw1 = conv_w[1024 + c], cw2 = conv_w[2048 + c], cw3 = conv_w[3072 + c], cb = conv_b[c];
        const bool mine = (lane >> 5) == hf;
        float bav[2], bxv[2], lsl[2];
#pragma unroll
        for (int j = 0; j < 2; ++j) { const int ce = c0 + e0 + 16 * j + n16; bav[j] = rg_ba[ce]; bxv[j] = rg_bx[ce]; lsl[j] = -8.0f * 1.4426950408889634f * log1pf(__expf(-lam[ce])); }
        float hst[2] = {0.f, 0.f};
        const float nba[2] = {-1.4426950408889634f * bav[0], -1.4426950408889634f * bav[1]}, nbx[2] = {-1.4426950408889634f * bxv[0], -1.4426950408889634f * bxv[1]};
        __syncthreads();
        LAS unsigned char* stg = L + RG2_STG_OFF + wave * RG2_STG_WAVE;
        LAS float* xf_w = Xf + (wave * 32) * 32 + (lane & 31); LAS unsigned char* xcb_w = L + RG2_XCB_OFF + (wave * 32) * RG_WT_PITCH + lane * 2;
        asm volatile("" : "+v"(xf_w), "+v"(xcb_w));
        const int xr_row = lane >> 3, xr_c8 = lane & 7, gt_tok = lane >> 2, gt_c8 = lane & 3;
        v4u xq[2][5], gq[2][2];
        const GAS unsigned char* rxb = (const GAS unsigned char*)(RX + (size_t)b * SEQ * 1024 + c0); const GAS unsigned char* rgb = (const GAS unsigned char*)(RG + (size_t)b * SEQ * 1024 + c0 + e0);
        GAS unsigned char* rnb = (GAS unsigned char*)(RNN + (size_t)b * SEQ * 1536 + c0 + e0);
        const unsigned xoff = (unsigned)(xr_row * 1024 + xr_c8 * 8) * 2u, goff = (unsigned)(gt_tok * 1024 + gt_c8 * 8) * 2u, ooff = (unsigned)(gt_tok * 1536 + gt_c8 * 8) * 2u;
#pragma unroll
        for (int pc = 0; pc < 2; ++pc) { const int t0 = pc * 256 + wave * 32;
#pragma unroll
            for (int i = 0; i < 5; ++i) { const int ri = 8 * i + xr_row, t = t0 - 3 + ri; xq[pc][i] = (v4u){0u, 0u, 0u, 0u};
                if (ri < 35 && t >= 0) xq[pc][i] = *(const GAS v4u*)(rxb + (unsigned)((t0 - 3 + 8 * i) * 2048 + (int)xoff)); }
#pragma unroll
            for (int i = 0; i < 2; ++i) gq[pc][i] = *(const GAS v4u*)(rgb + (unsigned)((t0 + 16 * i) * 2048 + (int)goff)); }
#pragma unroll 1
        for (int ch = 0; ch < SEQ / 256; ++ch) {
            const int t0 = ch * 256 + wave * 32;
#pragma unroll
            for (int i = 0; i < 5; ++i) { if (8 * i + xr_row < 35) *(LAS v4u*)(stg + (8 * i + xr_row) * 128 + xr_c8 * 16) = xq[0][i]; }
#pragma unroll
            for (int i = 0; i < 2; ++i) *(LAS v4u*)(stg + 35 * 128 + (16 * i + gt_tok) * 64 + gt_c8 * 16) = gq[0][i];
#pragma unroll
            for (int i = 0; i < 5; ++i) xq[0][i] = xq[1][i];
            gq[0][0] = gq[1][0]; gq[0][1] = gq[1][1];
            if (ch + 2 < SEQ / 256) {
#pragma unroll
                for (int i = 0; i < 5; ++i) { const int ri = 8 * i + xr_row; if (ri < 35) xq[1][i] = *(const GAS v4u*)(rxb + (unsigned)((t0 + 512 - 3 + 8 * i) * 2048 + (int)xoff)); }
#pragma unroll
                for (int i = 0; i < 2; ++i) gq[1][i] = *(const GAS v4u*)(rgb + (unsigned)((t0 + 512 + 16 * i) * 2048 + (int)goff));
            }
            asm volatile("s_waitcnt lgkmcnt(0)" ::: "memory");
            { float xv[35];
#pragma unroll
              for (int i = 0; i < 35; ++i) xv[i] = bf2f(*(const LAS unsigned short*)(stg + i * 128 + lane * 2));
              float xo[32];
#pragma unroll
              for (int i = 0; i < 32; i += 2) { xo[i] = cb + cw0 * xv[i] + cw1 * xv[i + 1] + cw2 * xv[i + 2] + cw3 * xv[i + 3]; xo[i + 1] = cb + cw0 * xv[i + 1] + cw1 * xv[i + 2] + cw2 * xv[i + 3] + cw3 * xv[i + 4];
                  const unsigned pk = pg8::cvt_pk_bf16(xo[i], xo[i + 1]);
                  *(LAS bf16*)(xcb_w + i * RG_WT_PITCH) = (bf16)(pk & 0xFFFFu); *(LAS bf16*)(xcb_w + (i + 1) * RG_WT_PITCH) = (bf16)(pk >> 16); }
              if (mine) {
#pragma unroll
                  for (int i = 0; i < 32; ++i) xf_w[i * 32] = xo[i]; } }
            float gcur[2][2][4];
#pragma unroll
            for (int s = 0; s < 2; ++s)
#pragma unroll
                for (int j = 0; j < 2; ++j)
#pragma unroll
                    for (int r = 0; r < 4; ++r) gcur[s][j][r] = bf2f(*(const LAS unsigned short*)(stg + 35 * 128 + (16 * s + 4 * kg + r) * 64 + (16 * j + n16) * 2));
            asm volatile("s_waitcnt lgkmcnt(0)" ::: "memory");
            float av[2][2][4], bv[2][2][4], Pe[2][2], He[2][2], Pt[2][2], Ht[2][2];
#pragma unroll
            for (int s = 0; s < 2; ++s) {
                bx8 af[2];
#pragma unroll
                for (int ks = 0; ks < 2; ++ks) af[ks] = *(const LAS bx8*)(L + RG2_XCB_OFF + (wave * 32 + 16 * s + n16) * RG_WT_PITCH + (32 * ks + 8 * kg) * 2);
#pragma unroll
                for (int j = 0; j < 2; ++j) {
                    f32x4 cr = (f32x4){0.f, 0.f, 0.f, 0.f}, ci = (f32x4){0.f, 0.f, 0.f, 0.f};
#pragma unroll
                    for (int ks = 0; ks < 2; ++ks) {
                        const bx8 wa_f = *(const LAS bx8*)(L + RG_WA_OFF + (16 * j + n16) * RG_WT_PITCH + (32 * ks + 8 * kg) * 2);
                        const bx8 wx_f = *(const LAS bx8*)(L + RG_WX_OFF + (16 * j + n16) * RG_WT_PITCH + (32 * ks + 8 * kg) * 2);
                        cr = __builtin_amdgcn_mfma_f32_16x16x32_bf16(af[ks], wa_f, cr, 0, 0, 0);
                        ci = __builtin_amdgcn_mfma_f32_16x16x32_bf16(af[ks], wx_f, ci, 0, 0, 0);
                    }
                    float p = 1.f, h = 0.f;
#pragma unroll
                    for (int r = 0; r < 4; ++r) {
                        const float rr = __builtin_amdgcn_rcpf(1.0f + __builtin_amdgcn_exp2f(__builtin_fmaf(cr[r], -1.4426950408889634f, nba[j]))), ig = __builtin_amdgcn_rcpf(1.0f + __builtin_amdgcn_exp2f(__builtin_fmaf(ci[r], -1.4426950408889634f, nbx[j])));
                        const float l2 = rr * lsl[j];
                        const float a = __builtin_amdgcn_exp2f(l2);
                        const float oma = __builtin_fmaf(-a, a, 1.0f);
                        const float xcv = Xf[(wave * 32 + 16 * s + 4 * kg + r) * 32 + 16 * j + n16];
                        const float bb = __builtin_amdgcn_sqrtf(oma) * (ig * xcv);
                        av[s][j][r] = a; bv[s][j][r] = bb; h = a * h + bb; p *= a;
                    }
                    float P = p, H = h;
                    { const float p1 = __shfl_up(P, 16), h1 = __shfl_up(H, 16); if (kg >= 1) { H = P * h1 + H; P = P * p1; } }
                    { const float p2 = __shfl_up(P, 32), h2 = __shfl_up(H, 32); if (kg >= 2) { H = P * h2 + H; P = P * p2; } }
                    const float pe = __shfl_up(P, 16), he = __shfl_up(H, 16);
                    Pe[s][j] = kg >= 1 ? pe : 1.f; He[s][j] = kg >= 1 ? he : 0.f;
                    Pt[s][j] = __shfl(P, 48 + n16); Ht[s][j] = __shfl(H, 48 + n16);
                }
            }
#pragma unroll
            for (int j = 0; j < 2; ++j)
                if (kg == 3) { LAS float* cw_ = carr + (ch & 1) * 512 + wave * 64 + j * 32; cw_[n16] = Pt[1][j] * Pt[0][j]; cw_[16 + n16] = Pt[1][j] * Ht[0][j] + Ht[1][j]; }
            __syncthreads();
#pragma unroll
            for (int j = 0; j < 2; ++j) {
                const LAS float* cr_ = carr + (ch & 1) * 512 + j * 32;
                float cin = 0.f, cc = hst[j];
#pragma unroll
                for (int w2 = 0; w2 < 8; ++w2) { if (w2 == wave) cin = cc; cc = cr_[w2 * 64 + n16] * cc + cr_[w2 * 64 + 16 + n16]; }
                hst[j] = cc;
#pragma unroll
                for (int s = 0; s < 2; ++s) {
                    const float sin_ = s == 0 ? cin : Pt[0][j] * cin + Ht[0][j];
                    float h = Pe[s][j] * sin_ + He[s][j];
#pragma unroll
                    for (int r = 0; r < 4; ++r) { h = av[s][j][r] * h + bv[s][j][r];
                        const float g = gcur[s][j][r];
#if GATE_GELU
                        *(LAS bf16*)(stg + 35 * 128 + 2048 + (16 * s + 4 * kg + r) * 64 + (16 * j + n16) * 2) = (bf16)f2bf(h * g); }
#else
                        const float e2 = g * __builtin_fmaf(g * g, -2.0f * 0.7978845608028654f * 1.4426950408889634f * 0.044715f, -2.0f * 0.7978845608028654f * 1.4426950408889634f);
                        *(LAS bf16*)(stg + 35 * 128 + 2048 + (16 * s + 4 * kg + r) * 64 + (16 * j + n16) * 2) = (bf16)f2bf((h * g) * __builtin_amdgcn_rcpf(1.0f + __builtin_amdgcn_exp2f(e2))); }
#endif
                }
            }
            asm volatile("s_waitcnt lgkmcnt(0)" ::: "memory");
#pragma unroll
            for (int i = 0; i < 2; ++i) { const v4u o = *(const LAS v4u*)(stg + 35 * 128 + 2048 + (16 * i + gt_tok) * 64 + gt_c8 * 16);
              *(GAS v4u*)(rnb + (unsigned)((t0 + 16 * i) * 3072 + (int)ooff)) = o; }
        }
    }
}
__device__ __forceinline__ void p_fixup_items(Frame& F, int first, int last, int gt, int NGT);
__device__ __forceinline__ void p_fixup(Frame& F) {
    const bf16* HALO = (const bf16*)(F.ws + WS_HALO); bf16* H = (bf16*)(F.ws + WS_H);
    const float* fw = F.in[18]; const float* fb = F.in[19];
    p_fixup_items(F, 0, (M / 256) * (DFF / 4), F.vcu * (NWAVES * 64) + F.tid, F.G * NWAVES * 64);
}
__device__ __forceinline__ void p_fixup_items(Frame& F, int first, int last, int gt, int NGT) {
    const bf16* HALO = (const bf16*)(F.ws + WS_HALO); bf16* H = (bf16*)(F.ws + WS_H);
    const float* fw = F.in[18]; const float* fb = F.in[19];
    for (int it = first + gt; it < last; it += NGT) {
        const int pm = it / (DFF / 4), c = (it % (DFF / 4)) * 4;
        const int col = (c >> 7) * 256 + (c & 127);
        const bool hasprev = (pm % (SEQ / 256)) != 0;
        f32x4 u[4][2];
#pragma unroll
        for (int r = 0; r < 4; ++r)
#pragma unroll
            for (int gv = 0; gv < 2; ++gv) {
                u[r][gv] = (f32x4){0.f, 0.f, 0.f, 0.f};
                unsigned long long raw = 0ull;
                if (r >= 2) raw = *(const GAS unsigned long long*)(HALO + ((size_t)pm * 4 + (r - 2)) * NUP + col + gv * 128);
                else if (hasprev) raw = *(const GAS unsigned long long*)(HALO + ((size_t)(pm - 1) * 4 + 2 + r) * NUP + col + gv * 128);
                u[r][gv] = (f32x4){bflo((unsigned)raw), bfhi((unsigned)raw), bflo((unsigned)(raw >> 32)), bfhi((unsigned)(raw >> 32))};
            }
        f32x4 w[3][2], bb[2];
#pragma unroll
        for (int gv = 0; gv < 2; ++gv) { bb[gv] = *(const GAS f32x4*)(fb + gv * DFF + c);
#pragma unroll
            for (int j = 0; j < 3; ++j) w[j][gv] = *(const GAS f32x4*)(fw + (size_t)j * NUP + gv * DFF + c); }
#pragma unroll
        for (int r = 0; r < 2; ++r) {
            const f32x4 yg = bb[0] + w[0][0] * u[r][0] + w[1][0] * u[r + 1][0] + w[2][0] * u[r + 2][0];
            const f32x4 yv = bb[1] + w[0][1] * u[r][1] + w[1][1] * u[r + 1][1] + w[2][1] * u[r + 2][1];
            float hh[4];
#pragma unroll
            for (int i = 0; i < 4; ++i) hh[i] = yg[i] * sigmoid_f(yg[i]) * yv[i];
            *(GAS unsigned long long*)(H + (size_t)(pm * 256 + r) * DFF + c) = (unsigned long long)pk2(hh[0], hh[1]) | ((unsigned long long)pk2(hh[2], hh[3]) << 32);
        }
    }
}
#ifndef STAG_IN
#define STAG_IN 5
#endif
#ifndef STAG_XCD
#define STAG_XCD 0
#endif
#ifndef STAG_N
#define STAG_N 3
#endif
#ifndef STAG_UP
#define STAG_UP 5
#endif
__device__ __forceinline__ void phase_stagger(Frame& F, int us) {
    const int g = STAG_XCD ? ((int)blockIdx.x & (STAG_XCD - 1)) : (((int)blockIdx.x >> 3) & 3);
    if (us > 0 && g) {
        if (F.tid == 0) { const unsigned long long t0 = wall_clock64(), dt = (unsigned long long)(g * us) * 100ull; while (wall_clock64() - t0 < dt) __builtin_amdgcn_s_sleep(4); }
        __syncthreads();
    }
}
struct Args { const float* in[21]; float* out; unsigned char* ws; int ph_lo, ph_hi, li, pad; };
static_assert(sizeof(Args) == 23 * 8 + 16, "Args has no padding");
__global__ void __launch_bounds__(NWAVES * 64, 2) mk_fwd(Args args) {
    extern __shared__ __attribute__((aligned(16))) unsigned char lds[];
    Frame F;
    F.lds = (LAS unsigned char*)lds;
    F.MISC = (volatile LAS unsigned*)(F.lds + MISC_OFF);
    F.tid = threadIdx.x; F.lane = F.tid & 63; F.wave = __builtin_amdgcn_readfirstlane(F.tid >> 6);
    F.G = gridDim.x; { const int bx = blockIdx.x; F.vcu = (F.G % 8 == 0) ? (bx % 8) * (F.G / 8) + bx / 8 : bx; }
    F.ws = args.ws; F.out = args.out; F.ctl = (gu32*)(args.ws + WS_CTL);
#pragma unroll
    for (int i = 0; i < 21; ++i) F.in[i] = args.in[i];
    for (int u = F.tid; u < (LDS_BYTES - LDSCTL_OFF) / 4; u += NWAVES * 64) ((LAS unsigned*)(F.lds + LDSCTL_OFF))[u] = 0u;
    __syncthreads();
    XcdBarrier bar; bar.bar = (unsigned*)(F.ctl + CW_BAR) + args.li * XCD_BAR_WORDS; bar.x = 0; bar.st = nullptr;
    if (MK_ONE_LAUNCH) bar = xcd_barrier_post((unsigned*)(F.ctl + CW_BAR) + args.li * XCD_BAR_WORDS, F.MISC + 8);
#define GRID_BAR() do { if (MK_ONE_LAUNCH) xcd_barrier(bar); } while (0)
    const int lo = args.ph_lo, hi = args.ph_hi;
#ifndef PHASE_MASK
#define PHASE_MASK 0x1FFFF
#endif
#define IN(k) ((((PHASE_MASK) >> (k)) & 1) && lo <= (k) && (k) < hi)
#define BOTH(k) (IN(k) && IN((k) + 1))
    unsigned char* ws = args.ws;
    typedef pg8::bf16_t pbf;

    if (IN(0)) { p0_prologue(F); if (BOTH(0)) GRID_BAR(); }

    if (IN(1)) {
        pg8::Gemm g{(const pbf*)(ws + WS_XB), (const pbf*)(ws + WS_WIN), M, NIN, 1024}; pg8::StaticOrder S; S.init(M, NIN, F.G, (int)blockIdx.x);
        pg8::EpiIn E{(pbf*)(ws + WS_PA), (pbf*)(ws + WS_RX), (size_t)(WS_RGATE - WS_RX) / 2, (const float*)(ws + WS_RINV1), (unsigned char*)F.out + OUT_KV, (pbf*)(ws + WS_KI), (float*)(ws + WS_WI), (const float*)(ws + WS_GAINS)};
        phase_stagger(F, STAG_IN);
        pg8::gemm_phase<pg8::EpiIn, pg8::StaticOrder, true, true>(F.lds + RING_OFF, g, S, E);
        if (p0_defer(F.G) && blockIdx.x >= 128) p0_transposes(F, P0_I_IN, P0_NITEMS, ((int)blockIdx.x - 128) * NWAVES + F.wave, 128 * NWAVES);
        if (BOTH(1)) GRID_BAR();
    }
#ifndef RG_V2
#define RG_V2 1
#endif
    if (IN(3)) { if (RG_V2) p4_rglru2(F); else p4_rglru(F); }
    if (IN(4)) { p3_topk(F, args.li); if (BOTH(4)) GRID_BAR(); }
#if TKPROBE == 9
    if (F.vcu == 0 && F.tid == 0) { const unsigned nfb = __hip_atomic_load(F.ctl + CW_QUEUE + 32, RLX_AGENT); const unsigned long long t0 = wall_clock64(); while (wall_clock64() - t0 < (unsigned long long)nfb * 100ull) __builtin_amdgcn_s_sleep(8); }
#endif
#if TKPROBE == 21
    if (F.vcu == 0 && F.tid == 0) { const unsigned nfb = __hip_atomic_load(F.ctl + CW_QUEUE + 32, RLX_AGENT); const unsigned long long t0 = wall_clock64(); while (wall_clock64() - t0 < (unsigned long long)(nfb >> 10) * 100ull) __builtin_amdgcn_s_sleep(8); }
#endif
    if (IN(5)) { p4_attn(F); if (BOTH(5)) GRID_BAR(); }
    if (IN(6)) {
        pg8::Gemm g{(const pbf*)((unsigned char*)F.out + OUT_ARN), (const pbf*)(ws + WS_WOA), M, 1024, 1536}; pg8::StaticOrder S; S.init(M, 1024, F.G, (int)blockIdx.x);
        pg8::EpiMerge E{(pbf*)(ws + WS_MERGED), (const unsigned char*)(ws + WS_GA), (const unsigned char*)(ws + WS_GB)};
        phase_stagger(F, STAG_N);
        pg8::gemm_phase<pg8::EpiMerge, pg8::StaticOrder, true, true>(F.lds + RING_OFF, g, S, E);
        if (BOTH(6)) GRID_BAR();
    }
    if (IN(7)) {
        pg8::Gemm g{(const pbf*)(ws + WS_MERGED), (const pbf*)(ws + WS_WOUT), M, 1024, 1024}; pg8::StaticOrder S; S.init(M, 1024, F.G, (int)blockIdx.x);
        pg8::EpiRes E{(const pbf*)(ws + WS_XB), (const float*)(ws + WS_RINV1), (pbf*)(ws + WS_X1B), (float*)(ws + WS_SSQ2)};
        phase_stagger(F, STAG_N);
        pg8::gemm_phase<pg8::EpiRes, pg8::StaticOrder, true, true>(F.lds + RING_OFF, g, S, E);
        if (BOTH(7)) GRID_BAR();
    }
    if (IN(8)) {
        pg8::Gemm g{(const pbf*)(ws + WS_X1B), (const pbf*)(ws + WS_WUP), M, NUP, 1024}; pg8::StaticOrder S; S.init(M, NUP, F.G, (int)blockIdx.x);
#ifndef UP_INREG
#define UP_INREG 1
#endif
#if UP_INREG
        pg8::EpiUpR E{(pbf*)(ws + WS_H), (pbf*)(ws + WS_HALO), (const float*)(ws + WS_SSQ2), F.in[18], F.in[19], F.lds + XSLAB_OFF, DFF};
        phase_stagger(F, STAG_UP);
        pg8::gemm_phase<pg8::EpiUpR, pg8::StaticOrder, true, true>(F.lds + RING_OFF, g, S, E);
#else
        pg8::EpiUp E{(pbf*)(ws + WS_H), (pbf*)(ws + WS_HALO), (pbf*)(ws + WS_SCR) + (size_t)blockIdx.x * 65536, (const float*)(ws + WS_SSQ2), F.in[18], F.in[19], DFF};
        pg8::gemm_phase<pg8::EpiUp, pg8::StaticOrder, true, true>(F.lds + RING_OFF, g, S, E);
#endif
        if (BOTH(8)) GRID_BAR();
    }
#ifndef FIXUP_FOLD
#define FIXUP_FOLD 0
#endif
    if (!FIXUP_FOLD && IN(9)) { p_fixup(F); if (BOTH(9)) GRID_BAR(); }
    if (IN(10)) {
        pg8::Gemm g{(const pbf*)(ws + WS_H), (const pbf*)(ws + WS_WDN), M, 1024, DFF}; pg8::StaticOrder S; S.init(M, 1024, F.G, (int)blockIdx.x);
        pg8::EpiAcc E{(const pbf*)(ws + WS_X1B), F.out};
        if (FIXUP_FOLD) {
            const int nun = (128 * 4 + F.G - 1) / F.G;
            for (int i = 0; i < nun; ++i) { pg8::Unit uu; uu.pm = 0; uu.pn = 0; const bool has = S.next(i, uu); const int pmv = has ? uu.pm : -1;
                if (pmv >= 0) p_fixup_items(F, pmv * (DFF / 4), (pmv + 1) * (DFF / 4), F.tid, NWAVES * 64); }
            asm volatile("s_waitcnt vmcnt(0)" ::: "memory"); __builtin_amdgcn_fence(__ATOMIC_RELEASE, "workgroup"); __syncthreads();
        }
        phase_stagger(F, STAG_N);
        pg8::gemm_phase<pg8::EpiAcc, pg8::StaticOrder, true, true>(F.lds + RING_OFF, g, S, E);
    }
#undef IN
#undef BOTH
}

extern "C" void kernel_launch(void* const* d_in, const int* in_sizes, int n_in, void* d_out, int out_size, void* d_ws, size_t ws_size, hipStream_t stream) {
    static int grid = 0;
    if (grid == 0) {
        if (n_in != 21 || out_size != M * DM || ws_size < WS_END) { fprintf(stderr, "kernel_launch: unexpected shapes: n_in %d out %d ws %zu (need %zu)\n", n_in, out_size, ws_size, (size_t)WS_END); grid = -1; return; }
        int dev = 0, cus = 0;
        if (hipGetDevice(&dev) != hipSuccess || hipDeviceGetAttribute(&cus, hipDeviceAttributeMultiprocessorCount, dev) != hipSuccess) { grid = -1; return; }
        if (hipFuncSetAttribute((const void*)mk_fwd, hipFuncAttributeMaxDynamicSharedMemorySize, LDS_BYTES) != hipSuccess) { fprintf(stderr, "kernel_launch: hipFuncSetAttribute failed\n"); grid = -1; return; }
        (void)hipGetLastError();
        grid = cus;
    }
    if (grid < 0) return;
    if (hipMemsetAsync((char*)d_ws + WS_CTL, 0, CTL_ZERO_BYTES, stream) != hipSuccess) return;
    Args a{};
    for (int i = 0; i < 21; ++i) a.in[i] = (const float*)d_in[i];
    a.out = (float*)d_out; a.ws = (unsigned char*)d_ws;
#if MK_ONE_LAUNCH && defined(PROBE_DUP_LO)
    a.ph_lo = 0; a.ph_hi = PROBE_DUP_HI + 1; a.li = 0; hipLaunchKernelGGL(mk_fwd, dim3(grid), dim3(NWAVES * 64), LDS_BYTES, stream, a);
    a.ph_lo = PROBE_DUP_LO; a.ph_hi = PROBE_DUP_HI + 1; a.li = 1; hipLaunchKernelGGL(mk_fwd, dim3(grid), dim3(NWAVES * 64), LDS_BYTES, stream, a);
    if (PROBE_DUP_HI + 1 < NPH) { a.ph_lo = PROBE_DUP_HI + 1; a.ph_hi = NPH; a.li = 2; hipLaunchKernelGGL(mk_fwd, dim3(grid), dim3(NWAVES * 64), LDS_BYTES, stream, a); }
#elif MK_ONE_LAUNCH
    a.ph_lo = 0; a.ph_hi = NPH;
    hipLaunchKernelGGL(mk_fwd, dim3(grid), dim3(NWAVES * 64), LDS_BYTES, stream, a);
#else
    for (int p = 0; p < NPH; ++p) { a.ph_lo = p; a.ph_hi = p + 1; hipLaunchKernelGGL(mk_fwd, dim3(grid), dim3(NWAVES * 64), LDS_BYTES, stream, a); }
#endif
}
```

```cpp
#define STAG_IN 0
#define STAG_UP 0
#define STAG_N 0
#define PG8_KROT 0
#include <hip/hip_runtime.h>
#include <cstdio>
#include <cstdint>
#ifndef PG8_KROT
#define PG8_KROT 1
#endif
#ifndef PG8_WGM
#define PG8_WGM 8
#endif
namespace pg8 {
#define PG8_LAS __attribute__((address_space(3)))
typedef unsigned short bf16_t;
typedef short bf16x8 __attribute__((ext_vector_type(8)));
typedef float f32x4 __attribute__((ext_vector_type(4)));
typedef unsigned u32x4 __attribute__((ext_vector_type(4)));
constexpr int BM = 256, BK = 64, HALF = 128, HTB = HALF * BK * 2  , STAGE_BYTES = 8 * HTB, NXCD = 8, WGM = PG8_WGM;

__host__ __device__ __forceinline__ int lds_byte(int r, int c) { const int st = (r >> 4) * 2 + (c >> 5), rr = r & 15, cc = c & 31, ob = rr * 64 + cc * 2; return st * 1024 + (ob ^ (((ob >> 9) & 1) << 5)); }
__host__ __device__ __forceinline__ void stage_rc(int b, int& R, int& C) { const int st = b / 1024, sb = b % 1024, swz = sb ^ (((sb >> 9) & 1) << 5); R = (st >> 1) * 16 + swz / 64; C = (st & 1) * 32 + (swz % 64) / 2; }
__host__ __device__ __forceinline__ int perm32(int rho) { const int n = rho >> 4, i = rho & 15; return 8 * (i >> 2) + 4 * n + (i & 3); }

struct Unit { int pm, pn; };
struct Gemm { const bf16_t* A; const bf16_t* Bt; int M, N, K; };

struct StaticOrder {
    int nM, nN, nwg, G, c;
    __host__ __device__ void init(int M, int N, int G_, int c_) { nM = M / BM; nN = N / BM; nwg = nM * nN; G = G_; c = c_; }
    __host__ __device__ __forceinline__ bool next(int i, Unit& u) const {
        const long L = (long)i * G + c; if (L >= nwg) return false;
        int wgid = (int)L; { const int q = nwg / NXCD, r = nwg % NXCD, xcd = wgid % NXCD, off = wgid / NXCD; wgid = (xcd < r ? xcd * (q + 1) : r * (q + 1) + (xcd - r) * q) + off; }
        const int nig = WGM * nN, gid = wgid / nig, fm = gid * WGM, gsz = (nM - fm) < WGM ? (nM - fm) : WGM;
        u.pm = fm + ((wgid % nig) % gsz); u.pn = (wgid % nig) / gsz; return true;
    }
    __device__ __forceinline__ void a_ready(const Unit&) const {}
    __device__ __forceinline__ void done(const Unit&) const {}
};

__device__ __forceinline__ unsigned cvt_pk_bf16(float lo, float hi) { unsigned r; asm volatile("v_cvt_pk_bf16_f32 %0, %1, %2" : "=v"(r) : "v"(lo), "v"(hi)); return r; }
typedef float f32x2 __attribute__((ext_vector_type(2)));
__device__ __forceinline__ f32x2 gelu_pk(f32x2 v) {
    const f32x2 av = __builtin_elementwise_abs(v), d = av * 0.2316418882f + 1.0f;
    f32x2 t; t.x = __builtin_amdgcn_rcpf(d.x); t.y = __builtin_amdgcn_rcpf(d.y);
    f32x2 q = t * 0.5307027145f + (-0.7265760135f); q = q * t + 0.7107068705f; q = q * t + (-0.142248368f); q = q * t + 0.127414796f; q = q * t;
    const f32x2 s = (v * v) * (-0.72134752044f);
    f32x2 e; e.x = __builtin_amdgcn_exp2f(s.x); e.y = __builtin_amdgcn_exp2f(s.y);
    const f32x2 m = v * (q * e), r = v - m;
    f32x2 o; o.x = v.x < 0.f ? m.x : r.x; o.y = v.y < 0.f ? m.y : r.y; return o;
}

template <int ACT  > struct EpiBf16 {
    static constexpr int MIDK = 0; static constexpr bool PERM = true, AFTER_DRAIN = false; static_assert(ACT == 0 || ACT == 1, "EpiBf16: ACT is 0 (none) or 1 (gelu_pk)");
    bf16_t* O; int ldc; const float* bias; int split_cols; size_t split_stride; float scale0;
    __device__ __forceinline__ void operator()(const f32x4 (&acc)[2][2][4][2], const Unit& u, int wr, int wc, int fr, int fq) const {
        const int row0 = u.pm * BM + wr * 64 + fr; int colt = u.pn * BM; bf16_t* base = O;
        float sc = 1.f; if (split_cols) { const int t = colt / split_cols; base += (size_t)t * split_stride; colt -= t * split_cols; if (t == 0) sc = scale0; }
        const int col0 = colt + wc * 32 + 8 * fq, bcol0 = u.pn * BM + wc * 32 + 8 * fq;
        f32x4 bv[2][2];
#pragma unroll
        for (int bj = 0; bj < 2; ++bj)
#pragma unroll
            for (int n = 0; n < 2; ++n) bv[bj][n] = bias ? *(const f32x4*)(bias + bcol0 + bj * HALF + 4 * n) : (f32x4){0.f, 0.f, 0.f, 0.f};
#pragma unroll
        for (int ai = 0; ai < 2; ++ai)
#pragma unroll
            for (int m = 0; m < 4; ++m) { bf16_t* rowp = base + (size_t)(row0 + ai * HALF + m * 16) * ldc + col0;
#pragma unroll
                for (int bj = 0; bj < 2; ++bj) { f32x4 v0 = acc[ai][bj][m][0] + bv[bj][0], v1 = acc[ai][bj][m][1] + bv[bj][1];
                    if (ACT == 1) { f32x2 a = gelu_pk((f32x2){v0[0], v0[1]}), b = gelu_pk((f32x2){v0[2], v0[3]}), c = gelu_pk((f32x2){v1[0], v1[1]}), d = gelu_pk((f32x2){v1[2], v1[3]});
                        v0 = (f32x4){a.x, a.y, b.x, b.y}; v1 = (f32x4){c.x, c.y, d.x, d.y}; }
                    v0 = v0 * sc; v1 = v1 * sc; u32x4 w; w.x = cvt_pk_bf16(v0[0], v0[1]); w.y = cvt_pk_bf16(v0[2], v0[3]); w.z = cvt_pk_bf16(v1[0], v1[1]); w.w = cvt_pk_bf16(v1[2], v1[3]);
                    *(u32x4*)(rowp + bj * HALF) = w; } }
    }
};

#ifndef UP_PRE
#define UP_PRE 1
#endif
#ifndef GATE_GELU
#define GATE_GELU 0
#endif
#ifndef GATES_U8
#define GATES_U8 1
#endif
#ifndef MERGE_DEPTH
#define MERGE_DEPTH 3
#endif
#ifndef EPIDUP_IN
#define EPIDUP_IN 0
#endif
#ifndef EPIDUP_MERGE
#define EPIDUP_MERGE 0
#endif
#ifndef EPIDUP_RES
#define EPIDUP_RES 0
#endif
#ifndef EPIDUP_ACC
#define EPIDUP_ACC 0
#endif
#ifndef EPIDUP_UP
#define EPIDUP_UP 0
#endif

__device__ __forceinline__ float bf_lo(unsigned u) { return __builtin_bit_cast(float, u << 16); }
__device__ __forceinline__ float bf_hi(unsigned u) { return __builtin_bit_cast(float, u & 0xffff0000u); }
__device__ __forceinline__ float sigmoidf_(float x) { return __builtin_amdgcn_rcpf(1.0f + __expf(-x)); }

struct EpiIn {
    static constexpr bool PRE = false;
    static constexpr int dup = EPIDUP_IN;
    static constexpr int MIDK = 0; static constexpr bool PERM = true, AFTER_DRAIN = false;
    bf16_t* PA; bf16_t* SEC; size_t sec_stride; const float* rinv; unsigned char* KV; bf16_t* KI; float* WI; const float* gains;
    __device__ __forceinline__ void operator()(const f32x4 (&acc)[2][2][4][2], const Unit& u, int wr, int wc, int fr, int fq) const {
        typedef unsigned u32x2v __attribute__((ext_vector_type(2)));
        asm volatile("" : "+v"(fr), "+v"(fq));
        const int row0 = u.pm * BM + wr * 64 + fr;
        if (u.pn >= 5) {
            const int s = (u.pn - 5) >> 2; bf16_t* base = SEC + (size_t)s * sec_stride; const int col0 = ((u.pn - 5) & 3) * 256 + wc * 32 + 8 * fq;
            if (GATES_U8 && s >= 2) {
                unsigned char* b8 = (unsigned char*)base;
#pragma unroll
                for (int ai = 0; ai < 2; ++ai)
#pragma unroll
                    for (int m = 0; m < 4; ++m) { const int row = row0 + ai * HALF + m * 16; unsigned char* rowp = b8 + (size_t)row * 1024 + col0;
#pragma unroll
                        for (int bj = 0; bj < 2; ++bj) { u32x2v w; w.x = 0u; w.y = 0u;
#pragma unroll
                            for (int i = 0; i < 4; ++i) { w.x = __builtin_amdgcn_cvt_pk_u8_f32(255.0f * sigmoidf_(acc[ai][bj][m][0][i]), i, w.x); w.y = __builtin_amdgcn_cvt_pk_u8_f32(255.0f * sigmoidf_(acc[ai][bj][m][1][i]), i, w.y); }
                            *(u32x2v*)(rowp + bj * HALF) = w; } }
                return;
            }
            const bool gel = GATE_GELU && s == 1;
#pragma unroll
            for (int ai = 0; ai < 2; ++ai)
#pragma unroll
                for (int m = 0; m < 4; ++m) { const int row = row0 + ai * HALF + m * 16; bf16_t* rowp = base + (size_t)row * 1024 + col0;
#pragma unroll
                    for (int bj = 0; bj < 2; ++bj) { f32x4 v0 = acc[ai][bj][m][0], v1 = acc[ai][bj][m][1];
                        if (gel) {
#pragma unroll
                            for (int i = 0; i < 4; ++i) { const float g0 = v0[i], g1 = v1[i]; v0[i] = g0 * sigmoidf_(1.5957691216057308f * (g0 + 0.044715f * g0 * g0 * g0)); v1[i] = g1 * sigmoidf_(1.5957691216057308f * (g1 + 0.044715f * g1 * g1 * g1)); } }
                        u32x4 w; w.x = cvt_pk_bf16(v0[0], v0[1]); w.y = cvt_pk_bf16(v0[2], v0[3]); w.z = cvt_pk_bf16(v1[0], v1[1]); w.w = cvt_pk_bf16(v1[2], v1[3]);
                        *(u32x4*)(rowp + bj * HALF) = w; } }
            return;
        }
        const int H = 4 * u.pn + wc;
        if (H >= 18) return;
        const bool donorm = (H < 10) || (H == 16);
        const float* gp = gains + (H < 8 ? 0 : (H < 10 ? 64 : 128));
        f32x4 g[2][2];
#pragma unroll
        for (int bj = 0; bj < 2; ++bj)
#pragma unroll
            for (int n = 0; n < 2; ++n) g[bj][n] = donorm ? *(const f32x4*)(gp + 32 * bj + 8 * fq + 4 * n) : (f32x4){1.f, 1.f, 1.f, 1.f};
        const float post = (H >= 12 && H < 16) ? 0.125f : (H == 17 ? 0.5f : 1.0f);
#pragma unroll
        for (int ai = 0; ai < 2; ++ai)
#pragma unroll
            for (int m = 0; m < 4; ++m) { const int row = row0 + ai * HALF + m * 16;
                f32x4 v[2][2]; float ss = 0.f;
#pragma unroll
                for (int bj = 0; bj < 2; ++bj)
#pragma unroll
                    for (int n = 0; n < 2; ++n) { v[bj][n] = acc[ai][bj][m][n]; ss += (v[bj][n][0] * v[bj][n][0] + v[bj][n][1] * v[bj][n][1]) + (v[bj][n][2] * v[bj][n][2] + v[bj][n][3] * v[bj][n][3]); }
                ss += __shfl_xor(ss, 16); ss += __shfl_xor(ss, 32);
                const float sc = donorm ? 1.0f / sqrtf(ss * (1.0f / 64.0f) + 1e-6f) : post;
#pragma unroll
                for (int bj = 0; bj < 2; ++bj)
#pragma unroll
                    for (int n = 0; n < 2; ++n) v[bj][n] = v[bj][n] * sc * g[bj][n];
                if (H < 8 || (H >= 12 && H < 16)) {
                    bf16_t* rowp = PA + (size_t)row * 1280 + 64 * H + 8 * fq;
#pragma unroll
                    for (int bj = 0; bj < 2; ++bj) { u32x4 w; w.x = cvt_pk_bf16(v[bj][0][0], v[bj][0][1]); w.y = cvt_pk_bf16(v[bj][0][2], v[bj][0][3]); w.z = cvt_pk_bf16(v[bj][1][0], v[bj][1][1]); w.w = cvt_pk_bf16(v[bj][1][2], v[bj][1][3]);
                        *(u32x4*)(rowp + 32 * bj) = w; }
                } else if (H < 12) {
                    unsigned char* rowp = KV + (size_t)row * 256 + 64 * (H - 8) + 8 * fq;
#pragma unroll
                    for (int bj = 0; bj < 2; ++bj) { int w0 = __builtin_amdgcn_cvt_pk_fp8_f32(v[bj][0][0], v[bj][0][1], 0, false); w0 = __builtin_amdgcn_cvt_pk_fp8_f32(v[bj][0][2], v[bj][0][3], w0, true);
                        int w1 = __builtin_amdgcn_cvt_pk_fp8_f32(v[bj][1][0], v[bj][1][1], 0, false); w1 = __builtin_amdgcn_cvt_pk_fp8_f32(v[bj][1][2], v[bj][1][3], w1, true);
                        u32x2v w; w.x = (unsigned)w0; w.y = (unsigned)w1; *(u32x2v*)(rowp + 32 * bj) = w; }
                } else if (H == 16) {
                    bf16_t* rowp = KI + (size_t)row * 64 + 8 * fq;
#pragma unroll
                    for (int bj = 0; bj < 2; ++bj) { u32x4 w; w.x = cvt_pk_bf16(v[bj][0][0], v[bj][0][1]); w.y = cvt_pk_bf16(v[bj][0][2], v[bj][0][3]); w.z = cvt_pk_bf16(v[bj][1][0], v[bj][1][1]); w.w = cvt_pk_bf16(v[bj][1][2], v[bj][1][3]);
                        *(u32x4*)(rowp + 32 * bj) = w; }
                } else {
                    if (fq == 0) *(f32x4*)(WI + (size_t)row * 4) = v[0][0];
                }
            }
    }
};
struct EpiPlain {
    static constexpr bool PRE = false;
    static constexpr int dup = 0;
    static constexpr int MIDK = 0; static constexpr bool PERM = true, AFTER_DRAIN = false;
    bf16_t* O; int ldc;
    __device__ __forceinline__ void operator()(const f32x4 (&acc)[2][2][4][2], const Unit& u, int wr, int wc, int fr, int fq) const {
        const int row0 = u.pm * BM + wr * 64 + fr, col0 = u.pn * BM + wc * 32 + 8 * fq;
#pragma unroll
        for (int ai = 0; ai < 2; ++ai)
#pragma unroll
            for (int m = 0; m < 4; ++m) { bf16_t* rowp = O + (size_t)(row0 + ai * HALF + m * 16) * ldc + col0;
#pragma unroll
                for (int bj = 0; bj < 2; ++bj) { const f32x4 v0 = acc[ai][bj][m][0], v1 = acc[ai][bj][m][1];
                    u32x4 w; w.x = cvt_pk_bf16(v0[0], v0[1]); w.y = cvt_pk_bf16(v0[2], v0[3]); w.z = cvt_pk_bf16(v1[0], v1[1]); w.w = cvt_pk_bf16(v1[2], v1[3]);
                    *(u32x4*)(rowp + bj * HALF) = w; } }
    }
};
template <int MODE> struct EpiGate {
    static constexpr bool PRE = false;
    static constexpr int dup = 0;
    static constexpr int MIDK = 0; static constexpr bool PERM = true, AFTER_DRAIN = false;
    bf16_t* O; const bf16_t* G;
    __device__ __forceinline__ void operator()(const f32x4 (&acc)[2][2][4][2], const Unit& u, int wr, int wc, int fr, int fq) const {
        const int row0 = u.pm * BM + wr * 64 + fr, col0 = u.pn * BM + wc * 32 + 8 * fq;
#pragma unroll
        for (int ai = 0; ai < 2; ++ai)
#pragma unroll
            for (int m = 0; m < 4; ++m) { const size_t off = (size_t)(row0 + ai * HALF + m * 16) * 1024 + col0;
#pragma unroll
                for (int bj = 0; bj < 2; ++bj) { const u32x4 g = *(const u32x4*)(G + off + bj * HALF);
                    const f32x4 a0 = acc[ai][bj][m][0], a1 = acc[ai][bj][m][1];
                    float r[8];
                    r[0] = sigmoidf_(bf_lo(g.x)) * a0[0]; r[1] = sigmoidf_(bf_hi(g.x)) * a0[1]; r[2] = sigmoidf_(bf_lo(g.y)) * a0[2]; r[3] = sigmoidf_(bf_hi(g.y)) * a0[3];
                    r[4] = sigmoidf_(bf_lo(g.z)) * a1[0]; r[5] = sigmoidf_(bf_hi(g.z)) * a1[1]; r[6] = sigmoidf_(bf_lo(g.w)) * a1[2]; r[7] = sigmoidf_(bf_hi(g.w)) * a1[3];
                    if (MODE == 1) { const u32x4 p = *(const u32x4*)(O + off + bj * HALF);
                        r[0] += bf_lo(p.x); r[1] += bf_hi(p.x); r[2] += bf_lo(p.y); r[3] += bf_hi(p.y); r[4] += bf_lo(p.z); r[5] += bf_hi(p.z); r[6] += bf_lo(p.w); r[7] += bf_hi(p.w); }
                    u32x4 w; w.x = cvt_pk_bf16(r[0], r[1]); w.y = cvt_pk_bf16(r[2], r[3]); w.z = cvt_pk_bf16(r[4], r[5]); w.w = cvt_pk_bf16(r[6], r[7]);
                    *(u32x4*)(O + off + bj * HALF) = w; } }
    }
};
struct EpiMerge {
    static constexpr bool PRE = false;
    static constexpr int dup = EPIDUP_MERGE;
    static constexpr int MIDK = 8; static constexpr bool PERM = true, AFTER_DRAIN = false;
    bf16_t* O; const unsigned char* GA; const unsigned char* GB;
    static __device__ __forceinline__ float ub(unsigned w, int i) { return (float)((w >> (8 * i)) & 0xFFu); }
    __device__ __forceinline__ void mid(f32x4 (&acc)[2][2][4][2], const Unit& u, int wr, int wc, int fr, int fq) const {
        typedef unsigned u32x2v __attribute__((ext_vector_type(2)));
        asm volatile("" : "+v"(fr), "+v"(fq));
        const int row0 = u.pm * BM + wr * 64 + fr, col0 = u.pn * BM + wc * 32 + 8 * fq;
        u32x2v ra[MERGE_DEPTH + 1][2], rb[MERGE_DEPTH + 1][2];
#pragma unroll
        for (int g = 0; g < MERGE_DEPTH; ++g) { const size_t off = (size_t)(row0 + (g >> 2) * HALF + (g & 3) * 16) * 1024 + col0;
#pragma unroll
            for (int bj = 0; bj < 2; ++bj) { ra[g][bj] = *(const u32x2v*)(GA + off + bj * HALF); rb[g][bj] = *(const u32x2v*)(GB + off + bj * HALF); } }
#pragma unroll
        for (int g = 0; g < 8; ++g) { const int ai = g >> 2, m = g & 3, sl = g % (MERGE_DEPTH + 1);
            asm volatile("" ::: "memory");
            if (g + MERGE_DEPTH < 8) { const int g2 = g + MERGE_DEPTH, s2 = g2 % (MERGE_DEPTH + 1); const size_t off = (size_t)(row0 + (g2 >> 2) * HALF + (g2 & 3) * 16) * 1024 + col0;
#pragma unroll
                for (int bj = 0; bj < 2; ++bj) { ra[s2][bj] = *(const u32x2v*)(GA + off + bj * HALF); rb[s2][bj] = *(const u32x2v*)(GB + off + bj * HALF); } }
            asm volatile("" ::: "memory");
#pragma unroll
            for (int bj = 0; bj < 2; ++bj) { const u32x2v a = ra[sl][bj], b = rb[sl][bj];
#pragma unroll
                for (int i = 0; i < 4; ++i) { acc[ai][bj][m][0][i] *= ub(a.x, i) * __builtin_amdgcn_rcpf(fmaxf(ub(b.x, i), 1.0f)); acc[ai][bj][m][1][i] *= ub(a.y, i) * __builtin_amdgcn_rcpf(fmaxf(ub(b.y, i), 1.0f)); } } }
    }
    __device__ __forceinline__ void operator()(const f32x4 (&acc)[2][2][4][2], const Unit& u, int wr, int wc, int fr, int fq) const {
        typedef unsigned u32x2v __attribute__((ext_vector_type(2)));
        const int row0 = u.pm * BM + wr * 64 + fr, col0 = u.pn * BM + wc * 32 + 8 * fq;
#pragma unroll
        for (int ai = 0; ai < 2; ++ai)
#pragma unroll
            for (int m = 0; m < 4; ++m) { const size_t off = (size_t)(row0 + ai * HALF + m * 16) * 1024 + col0;
#pragma unroll
                for (int bj = 0; bj < 2; ++bj) { const u32x2v g = *(const u32x2v*)(GB + off + bj * HALF);
                    const f32x4 a0 = acc[ai][bj][m][0], a1 = acc[ai][bj][m][1];
                    float r[8];
#pragma unroll
                    for (int i = 0; i < 4; ++i) { r[i] = fmaxf(ub(g.x, i), 1.0f) * (1.0f / 255.0f) * a0[i]; r[4 + i] = fmaxf(ub(g.y, i), 1.0f) * (1.0f / 255.0f) * a1[i]; }
                    u32x4 w; w.x = cvt_pk_bf16(r[0], r[1]); w.y = cvt_pk_bf16(r[2], r[3]); w.z = cvt_pk_bf16(r[4], r[5]); w.w = cvt_pk_bf16(r[6], r[7]);
                    *(u32x4*)(O + off + bj * HALF) = w; } }
    }
};
struct EpiRes {
    static constexpr bool PRE = false;
    static constexpr int dup = EPIDUP_RES;
    static constexpr int MIDK = 0; static constexpr bool PERM = true, AFTER_DRAIN = false;
    const bf16_t* X; const float* RMS; bf16_t* XB; float* SSQ;
    __device__ __forceinline__ void operator()(const f32x4 (&acc)[2][2][4][2], const Unit& u, int wr, int wc, int fr, int fq) const {
        const int row0 = u.pm * BM + wr * 64 + fr, col0 = u.pn * BM + wc * 32 + 8 * fq;
#pragma unroll
        for (int ai = 0; ai < 2; ++ai)
#pragma unroll
            for (int m = 0; m < 4; ++m) { const int row = row0 + ai * HALF + m * 16; const size_t off = (size_t)row * 1024 + col0; float s = 0.f; const float rm = RMS[row];
#pragma unroll
                for (int bj = 0; bj < 2; ++bj) { const u32x4 xr = *(const u32x4*)(X + off + bj * HALF);
                    const f32x4 x0 = (f32x4){bf_lo(xr.x), bf_hi(xr.x), bf_lo(xr.y), bf_hi(xr.y)}, x1 = (f32x4){bf_lo(xr.z), bf_hi(xr.z), bf_lo(xr.w), bf_hi(xr.w)};
                    const f32x4 o0 = x0 * rm + acc[ai][bj][m][0], o1 = x1 * rm + acc[ai][bj][m][1];
                    s += (o0[0] * o0[0] + o0[1] * o0[1]) + (o0[2] * o0[2] + o0[3] * o0[3]); s += (o1[0] * o1[0] + o1[1] * o1[1]) + (o1[2] * o1[2] + o1[3] * o1[3]);
                    u32x4 w; w.x = cvt_pk_bf16(o0[0], o0[1]); w.y = cvt_pk_bf16(o0[2], o0[3]); w.z = cvt_pk_bf16(o1[0], o1[1]); w.w = cvt_pk_bf16(o1[2], o1[3]); *(u32x4*)(XB + off + bj * HALF) = w; }
                s += __shfl_xor(s, 16); s += __shfl_xor(s, 32);
                if (fq == 0) SSQ[(size_t)row * 16 + u.pn * 4 + wc] = s; }
    }
};
struct EpiAcc {
    static constexpr bool PRE = false;
    static constexpr int dup = EPIDUP_ACC;
    static constexpr int MIDK = 0; static constexpr bool PERM = true, AFTER_DRAIN = false;
    const bf16_t* XB; float* OUT;
    __device__ __forceinline__ void operator()(const f32x4 (&acc)[2][2][4][2], const Unit& u, int wr, int wc, int fr, int fq) const {
        const int row0 = u.pm * BM + wr * 64 + fr, col0 = u.pn * BM + wc * 32 + 8 * fq;
#pragma unroll
        for (int ai = 0; ai < 2; ++ai)
#pragma unroll
            for (int m = 0; m < 4; ++m) { const size_t off = (size_t)(row0 + ai * HALF + m * 16) * 1024 + col0;
#pragma unroll
                for (int bj = 0; bj < 2; ++bj) { const u32x4 xb = *(const u32x4*)(XB + off + bj * HALF);
                    const f32x4 x0 = (f32x4){bf_lo(xb.x), bf_hi(xb.x), bf_lo(xb.y), bf_hi(xb.y)}, x1 = (f32x4){bf_lo(xb.z), bf_hi(xb.z), bf_lo(xb.w), bf_hi(xb.w)};
                    *(f32x4*)(OUT + off + bj * HALF) = x0 + acc[ai][bj][m][0]; *(f32x4*)(OUT + off + bj * HALF + 4) = x1 + acc[ai][bj][m][1]; } }
    }
};
struct EpiUp {
    static constexpr bool PRE = false;
    static constexpr int dup = 0;
    static constexpr int MIDK = 0; static constexpr bool PERM = true, AFTER_DRAIN = false;
    bf16_t* H; bf16_t* HALO; bf16_t* SCR; const float* SSQ; const float* fw; const float* fb; int dff;
    __device__ __forceinline__ void operator()(const f32x4 (&acc)[2][2][4][2], const Unit& u, int wr, int wc, int fr, int fq) const {
        const int nup = 2 * dff;
        {
            const int col0 = wc * 32 + 8 * fq;
#pragma unroll
            for (int ai = 0; ai < 2; ++ai)
#pragma unroll
                for (int m = 0; m < 4; ++m) { asm volatile("" ::: "memory"); const int rl = ai * HALF + wr * 64 + m * 16 + fr; const int row = u.pm * BM + rl; float ss = 0.f;
#pragma unroll
                    for (int q = 0; q < 4; ++q) { const f32x4 p = *(const f32x4*)(SSQ + (size_t)row * 16 + q * 4); ss += (p[0] + p[1]) + (p[2] + p[3]); }
                    const float ri = 1.0f / sqrtf(ss * (1.0f / 1024.0f) + 1e-6f);
#pragma unroll
                    for (int bj = 0; bj < 2; ++bj) { const f32x4 v0 = acc[ai][bj][m][0] * ri, v1 = acc[ai][bj][m][1] * ri;
                        u32x4 w; w.x = cvt_pk_bf16(v0[0], v0[1]); w.y = cvt_pk_bf16(v0[2], v0[3]); w.z = cvt_pk_bf16(v1[0], v1[1]); w.w = cvt_pk_bf16(v1[2], v1[3]);
                        *(u32x4*)(SCR + rl * 256 + bj * HALF + col0) = w; } }
        }
        asm volatile("s_waitcnt vmcnt(0) lgkmcnt(0)" ::: "memory"); __builtin_amdgcn_s_barrier(); asm volatile("" ::: "memory");
        {
            int tid = threadIdx.x; asm volatile("" : "+v"(tid));
            const int cg8 = (tid & 15) * 8, rg = tid >> 4, r0 = rg * 8;
            const int ch = u.pn * 128 + cg8;
            float wgt[3][2][8], bia[2][8];
#pragma unroll
            for (int gv = 0; gv < 2; ++gv) {
#pragma unroll
                for (int h4 = 0; h4 < 2; ++h4) { const f32x4 b4 = *(const f32x4*)(fb + gv * dff + ch + 4 * h4);
#pragma unroll
                    for (int i = 0; i < 4; ++i) bia[gv][4 * h4 + i] = b4[i];
#pragma unroll
                    for (int j = 0; j < 3; ++j) { const f32x4 w4 = *(const f32x4*)(fw + (size_t)j * nup + gv * dff + ch + 4 * h4);
#pragma unroll
                        for (int i = 0; i < 4; ++i) wgt[j][gv][4 * h4 + i] = w4[i]; } }
            }
            float p2[2][8], p1[2][8];
#pragma unroll
            for (int gv = 0; gv < 2; ++gv)
#pragma unroll
                for (int i = 0; i < 8; ++i) { p2[gv][i] = 0.f; p1[gv][i] = 0.f; }
            if (rg > 0) {
#pragma unroll
                for (int gv = 0; gv < 2; ++gv) { const u32x4 a = __builtin_nontemporal_load((const u32x4*)(SCR + (r0 - 2) * 256 + gv * HALF + cg8)), b = __builtin_nontemporal_load((const u32x4*)(SCR + (r0 - 1) * 256 + gv * HALF + cg8));
                    p2[gv][0] = bf_lo(a.x); p2[gv][1] = bf_hi(a.x); p2[gv][2] = bf_lo(a.y); p2[gv][3] = bf_hi(a.y); p2[gv][4] = bf_lo(a.z); p2[gv][5] = bf_hi(a.z); p2[gv][6] = bf_lo(a.w); p2[gv][7] = bf_hi(a.w);
                    p1[gv][0] = bf_lo(b.x); p1[gv][1] = bf_hi(b.x); p1[gv][2] = bf_lo(b.y); p1[gv][3] = bf_hi(b.y); p1[gv][4] = bf_lo(b.z); p1[gv][5] = bf_hi(b.z); p1[gv][6] = bf_lo(b.w); p1[gv][7] = bf_hi(b.w); }
            }
#pragma unroll
            for (int k = 0; k < 8; ++k) {
                const int rl = r0 + k;
                u32x4 raw[2]; float c[2][8];
#pragma unroll
                for (int gv = 0; gv < 2; ++gv) { raw[gv] = __builtin_nontemporal_load((const u32x4*)(SCR + rl * 256 + gv * HALF + cg8));
                    c[gv][0] = bf_lo(raw[gv].x); c[gv][1] = bf_hi(raw[gv].x); c[gv][2] = bf_lo(raw[gv].y); c[gv][3] = bf_hi(raw[gv].y); c[gv][4] = bf_lo(raw[gv].z); c[gv][5] = bf_hi(raw[gv].z); c[gv][6] = bf_lo(raw[gv].w); c[gv][7] = bf_hi(raw[gv].w); }
                if (rl < 2 || rl >= 254) {
                    bf16_t* hp = HALO + ((size_t)u.pm * 4 + (rl < 2 ? rl : rl - 252)) * nup + u.pn * BM + cg8;
                    *(u32x4*)hp = raw[0]; *(u32x4*)(hp + HALF) = raw[1]; }
                float hh[8];
#pragma unroll
                for (int i = 0; i < 8; ++i) {
                    const float yg = bia[0][i] + wgt[0][0][i] * p2[0][i] + wgt[1][0][i] * p1[0][i] + wgt[2][0][i] * c[0][i];
                    const float yv = bia[1][i] + wgt[0][1][i] * p2[1][i] + wgt[1][1][i] * p1[1][i] + wgt[2][1][i] * c[1][i];
                    hh[i] = yg * sigmoidf_(yg) * yv;
                    p2[0][i] = p1[0][i]; p1[0][i] = c[0][i]; p2[1][i] = p1[1][i]; p1[1][i] = c[1][i];
                }
                if (rl >= 2) { u32x4 w; w.x = cvt_pk_bf16(hh[0], hh[1]); w.y = cvt_pk_bf16(hh[2], hh[3]); w.z = cvt_pk_bf16(hh[4], hh[5]); w.w = cvt_pk_bf16(hh[6], hh[7]);
                    *(u32x4*)(H + (size_t)(u.pm * BM + rl) * dff + ch) = w; }
            }
        }
    }
};
__device__ __forceinline__ float dpp_shr1(float oldv, float src) { return __builtin_bit_cast(float, __builtin_amdgcn_update_dpp(__builtin_bit_cast(int, oldv), __builtin_bit_cast(int, src), 0x111, 0xf, 0xf, false)); }
__device__ __forceinline__ float dpp_shr2(float oldv, float src) { return __builtin_bit_cast(float, __builtin_amdgcn_update_dpp(__builtin_bit_cast(int, oldv), __builtin_bit_cast(int, src), 0x112, 0xf, 0xf, false)); }
__device__ __forceinline__ float dpp_shl15(float src) { return __builtin_bit_cast(float, __builtin_amdgcn_update_dpp(0, __builtin_bit_cast(int, src), 0x10F, 0xf, 0xf, false)); }
__device__ __forceinline__ float dpp_shl14(float src) { return __builtin_bit_cast(float, __builtin_amdgcn_update_dpp(0, __builtin_bit_cast(int, src), 0x10E, 0xf, 0xf, false)); }
struct EpiUpR {
    static constexpr bool PRE = UP_PRE;
    static constexpr int dup = EPIDUP_UP;
    static constexpr int MIDK = 0; static constexpr bool PERM = true, AFTER_DRAIN = false;
    bf16_t* H; bf16_t* HALO; const float* SSQ; const float* fw; const float* fb; PG8_LAS unsigned char* xl; int dff;
    __device__ __forceinline__ void pre(const Unit& u) const {
        int tid = threadIdx.x; asm volatile("" : "+v"(tid));
        const int w = __builtin_amdgcn_readfirstlane(tid >> 6);
        if (w < 4) {
            const int nup = 2 * dff;
            const int e = tid * 4, kgv = e >> 7, k = kgv >> 1, gv = kgv & 1, c = e & 127;
            const float* src = (k < 3 ? fw + (size_t)k * nup : fb) + gv * dff + u.pn * 128 + c;
            __builtin_amdgcn_global_load_lds((const unsigned*)src, (PG8_LAS unsigned*)(xl + 8192 + w * 1024), 16, 0, 0);
            const float* sp = SSQ + (size_t)(u.pm * BM + tid) * 16;
#pragma unroll
            for (int q = 0; q < 4; ++q) __builtin_amdgcn_global_load_lds((const unsigned*)(sp + q * 4), (PG8_LAS unsigned*)(xl + 13312 + q * 4096 + w * 1024), 16, 0, 0);
        }
    }
    __device__ __forceinline__ void operator()(f32x4 (&acc)[2][2][4][2], const Unit& u, int wr, int wc, int fr, int fq) const {
        typedef unsigned u32x2v __attribute__((ext_vector_type(2)));
        asm volatile("" : "+v"(fr), "+v"(fq));
        const int nup = 2 * dff;
        const int colt = wc * 32 + 8 * fq;
        const int ch0 = u.pn * 128 + colt;
        const int row0 = u.pm * BM + wr * 64 + fr;
        PG8_LAS float* slab = (PG8_LAS float*)xl;
        PG8_LAS float* wl = (PG8_LAS float*)(xl + 8192);
        PG8_LAS float* rl = (PG8_LAS float*)(xl + 12288);
        if (PRE) {
            asm volatile("s_waitcnt vmcnt(16)" ::: "memory"); __builtin_amdgcn_s_barrier(); asm volatile("" ::: "memory");
            int tid = threadIdx.x; asm volatile("" : "+v"(tid));
            if (tid < 256) { const PG8_LAS f32x4* sq = (const PG8_LAS f32x4*)(xl + 13312);
                const f32x4 ps = (sq[tid] + sq[256 + tid]) + (sq[512 + tid] + sq[768 + tid]);
                rl[tid] = __builtin_amdgcn_rsqf(((ps[0] + ps[1]) + (ps[2] + ps[3])) * (1.0f / 1024.0f) + 1e-6f); }
        } else {
            int tid = threadIdx.x; asm volatile("" : "+v"(tid));
            if (tid < 256) { const int e = tid * 4, kgv = e >> 7, k = kgv >> 1, gv = kgv & 1, c = e & 127;
                const float* src = (k < 3 ? fw + (size_t)k * nup : fb) + gv * dff + u.pn * 128 + c;
                *(PG8_LAS f32x4*)(wl + e) = *(const f32x4*)src;
                const int row = u.pm * BM + tid; const f32x4 p0 = *(const f32x4*)(SSQ + (size_t)row * 16), p1 = *(const f32x4*)(SSQ + (size_t)row * 16 + 4), p2 = *(const f32x4*)(SSQ + (size_t)row * 16 + 8), p3 = *(const f32x4*)(SSQ + (size_t)row * 16 + 12);
                const f32x4 ps = (p0 + p1) + (p2 + p3);
                rl[tid] = __builtin_amdgcn_rsqf(((ps[0] + ps[1]) + (ps[2] + ps[3])) * (1.0f / 1024.0f) + 1e-6f); }
        }
        asm volatile("s_waitcnt lgkmcnt(0)" ::: "memory"); __builtin_amdgcn_s_barrier(); asm volatile("" ::: "memory");
#pragma unroll
        for (int ai = 0; ai < 2; ++ai)
#pragma unroll
            for (int m = 0; m < 4; ++m) { const float ri = rl[wr * 64 + fr + ai * HALF + m * 16];
#pragma unroll
                for (int bj = 0; bj < 2; ++bj)
#pragma unroll
                    for (int n = 0; n < 2; ++n) acc[ai][bj][m][n] = acc[ai][bj][m][n] * ri; }
        if (fr >= 14) {
#pragma unroll
            for (int ai = 0; ai < 2; ++ai)
#pragma unroll
                for (int bj = 0; bj < 2; ++bj)
#pragma unroll
                    for (int n = 0; n < 2; ++n) *(PG8_LAS f32x4*)(slab + ((2 * ai + wr) * 2 + (fr - 14)) * 256 + bj * HALF + colt + 4 * n) = acc[ai][bj][3][n];
            if (wr == 1) {
#pragma unroll
                for (int bj = 0; bj < 2; ++bj) { const f32x4 v0 = acc[1][bj][3][0], v1 = acc[1][bj][3][1];
                    u32x4 w; w.x = cvt_pk_bf16(v0[0], v0[1]); w.y = cvt_pk_bf16(v0[2], v0[3]); w.z = cvt_pk_bf16(v1[0], v1[1]); w.w = cvt_pk_bf16(v1[2], v1[3]);
                    *(u32x4*)(HALO + ((size_t)u.pm * 4 + 2 + (fr - 14)) * nup + u.pn * BM + bj * HALF + colt) = w; }
            }
        }
        if (fr < 2 && wr == 0) {
#pragma unroll
            for (int bj = 0; bj < 2; ++bj) { const f32x4 v0 = acc[0][bj][0][0], v1 = acc[0][bj][0][1];
                u32x4 w; w.x = cvt_pk_bf16(v0[0], v0[1]); w.y = cvt_pk_bf16(v0[2], v0[3]); w.z = cvt_pk_bf16(v1[0], v1[1]); w.w = cvt_pk_bf16(v1[2], v1[3]);
                *(u32x4*)(HALO + ((size_t)u.pm * 4 + fr) * nup + u.pn * BM + bj * HALF + colt) = w; }
        }
        asm volatile("s_waitcnt lgkmcnt(0)" ::: "memory"); __builtin_amdgcn_s_barrier(); asm volatile("" ::: "memory");
        int fr3 = fr; asm volatile("" : "+v"(fr3));
        const int row3 = u.pm * BM + wr * 64 + fr3;
#pragma unroll
        for (int ai = 0; ai < 2; ++ai) {
            const int blk = 2 * ai + wr;
#pragma unroll
            for (int m = 3; m >= 0; --m) {
                f32x4 hv[2];
#pragma unroll
                for (int n = 0; n < 2; ++n) {
                    asm volatile("" ::: "memory");
                    const PG8_LAS float* wp = wl + colt + 4 * n;
                    f32x4 yg, yv;
#pragma unroll
                    for (int gv = 0; gv < 2; ++gv) {
                        const f32x4 w0 = *(const PG8_LAS f32x4*)(wp + gv * 128), w1 = *(const PG8_LAS f32x4*)(wp + 256 + gv * 128), w2 = *(const PG8_LAS f32x4*)(wp + 512 + gv * 128), bb = *(const PG8_LAS f32x4*)(wp + 768 + gv * 128);
                        const f32x4 cc = acc[ai][gv][m][n];
                        f32x4 o1 = (f32x4){0.f, 0.f, 0.f, 0.f}, o2 = o1;
                        if (m > 0) { const f32x4 pp = acc[ai][gv][m - 1][n];
#pragma unroll
                            for (int i = 0; i < 4; ++i) { o1[i] = dpp_shl15(pp[i]); o2[i] = dpp_shl14(pp[i]); } }
                        else if (blk > 0) { const PG8_LAS float* sp = slab + ((blk - 1) * 2) * 256 + gv * HALF + colt + 4 * n; const int r2 = (fr3 == 0) ? 0 : 256;
                            o1 = *(const PG8_LAS f32x4*)(sp + 256); o2 = *(const PG8_LAS f32x4*)(sp + r2); }
                        f32x4 y;
#pragma unroll
                        for (int i = 0; i < 4; ++i) { const float x1 = dpp_shr1(o1[i], cc[i]), x2 = dpp_shr2(o2[i], cc[i]); y[i] = bb[i] + w0[i] * x2 + w1[i] * x1 + w2[i] * cc[i]; }
                        if (gv == 0) yg = y; else yv = y;
                        __builtin_amdgcn_sched_barrier(0);
                    }
#pragma unroll
                    for (int i = 0; i < 4; ++i) hv[n][i] = yg[i] * sigmoidf_(yg[i]) * yv[i];
                }
                if (!(blk == 0 && m == 0 && fr3 < 2)) { u32x4 w; w.x = cvt_pk_bf16(hv[0][0], hv[0][1]); w.y = cvt_pk_bf16(hv[0][2], hv[0][3]); w.z = cvt_pk_bf16(hv[1][0], hv[1][1]); w.w = cvt_pk_bf16(hv[1][2], hv[1][3]);
                    *(u32x4*)(H + (size_t)(row3 + ai * HALF + m * 16) * dff + ch0) = w; }
            }
        }
    }
};
template <class Epi, class Sched, bool ALIGN_EPI = false, bool SP2 = false>
__device__ __forceinline__ void gemm_phase(PG8_LAS unsigned char* lds, const Gemm g, const Sched& S, const Epi& E) {
    const int tid = threadIdx.x, wid = __builtin_amdgcn_readfirstlane(tid >> 6), lane = tid & 63, wr = wid >> 2, wc = wid & 3, fr = lane & 15, fq = lane >> 4;
    const int K = g.K, nt = K / BK;
    auto krot = [&](const Unit& u) -> int { return (Epi::MIDK > 0 || !PG8_KROT) ? 0 : 2 * ((u.pm + 2 * u.pn) % (nt >> 1)); };
    unsigned voffA[2], voffB[2];
#pragma unroll
    for (int i = 0; i < 2; ++i) { int R, C; stage_rc(tid * 16 + i * 8192, R, C); const int Rb = Epi::PERM ? ((R & ~31) + perm32(R & 31)) : R;
        voffA[i] = (unsigned)(R * K + C) * 2u; voffB[i] = (unsigned)(Rb * K + C) * 2u; }
    const size_t kstep = (size_t)(BK * 2);
    const size_t hstep = (size_t)HALF * K * 2;
    const size_t tstep = 2 * hstep;
    const unsigned ldsw = (unsigned)wid * 1024u;
    const int aoff = lds_byte(wr * 64 + fr, fq * 8), boff = lds_byte(wc * 32 + fr, fq * 8);
#define PG8_SA(b, h) (((b) * 2 + (h)) * HTB)
#define PG8_SB(b, h) ((4 + (b) * 2 + (h)) * HTB)
#define PG8_STAGE(bufoff, gbase, voff) do { _Pragma("unroll") for (int _i = 0; _i < 2; ++_i) \
        __builtin_amdgcn_global_load_lds((const unsigned*)((const char*)(gbase) + (voff)[_i]), (PG8_LAS unsigned*)(lds + (bufoff) + ldsw + _i * 8192), 16, 0, 0); } while (0)
#define PG8_LDA(dst, b, h) do { _Pragma("unroll") for (int m = 0; m < 4; ++m) _Pragma("unroll") for (int k = 0; k < 2; ++k) dst[m][k] = *(const PG8_LAS bf16x8*)(lds + PG8_SA(b, h) + aoff + m * 2048 + k * 1024); } while (0)
#define PG8_LDB(dst, b, h) do { _Pragma("unroll") for (int n = 0; n < 2; ++n) _Pragma("unroll") for (int k = 0; k < 2; ++k) dst[n][k] = *(const PG8_LAS bf16x8*)(lds + PG8_SB(b, h) + boff + n * 2048 + k * 1024); } while (0)
#define PG8_MMA(ai, bj, At, Bt) do { __builtin_amdgcn_s_setprio(1); _Pragma("unroll") for (int m = 0; m < 4; ++m) _Pragma("unroll") for (int n = 0; n < 2; ++n) _Pragma("unroll") for (int k = 0; k < 2; ++k) \
        acc[ai][bj][m][n] = __builtin_amdgcn_mfma_f32_16x16x32_bf16(Bt[n][k], At[m][k], acc[ai][bj][m][n], 0, 0, 0); __builtin_amdgcn_s_setprio(0); } while (0)
#define PG8_WAIT_V(n) asm volatile("s_waitcnt vmcnt(" #n ")" ::: "memory")
#define PG8_WAIT_L(n) asm volatile("s_waitcnt lgkmcnt(" #n ")" ::: "memory")
#define PG8_BAR __builtin_amdgcn_s_barrier()
#define PG8_SCHED __builtin_amdgcn_sched_barrier(0)
    Unit cur, nxt; int ui = 0;
    if (!S.next(0, cur)) return;
    f32x4 acc[2][2][4][2];
#pragma unroll
    for (int a = 0; a < 2; ++a)
#pragma unroll
        for (int b = 0; b < 2; ++b)
#pragma unroll
            for (int m = 0; m < 4; ++m)
#pragma unroll
                for (int n = 0; n < 2; ++n) acc[a][b][m][n] = (f32x4){0.f, 0.f, 0.f, 0.f};
    bf16x8 At[4][2], B0[2][2], B1[2][2];
    const char* cA = (const char*)g.A + (size_t)cur.pm * tstep; const char* cB = (const char*)g.Bt + (size_t)cur.pn * tstep;
    S.a_ready(cur);
    int rc = krot(cur);
    { const char* cA0 = cA; const char* cB0 = cB; cA = cA0 + (size_t)rc * kstep; cB = cB0 + (size_t)rc * kstep;
    if constexpr (SP2) {
        PG8_STAGE(PG8_SB(0, 0), cB, voffB); PG8_STAGE(PG8_SB(0, 1), cB + hstep, voffB); PG8_STAGE(PG8_SA(0, 0), cA, voffA); PG8_STAGE(PG8_SA(0, 1), cA + hstep, voffA);
        if (wr == 1) PG8_BAR;
        PG8_WAIT_V(2); PG8_BAR;
        PG8_STAGE(PG8_SB(1, 0), cB + kstep, voffB); PG8_STAGE(PG8_SA(1, 0), cA + kstep, voffA); PG8_STAGE(PG8_SB(1, 1), cB + hstep + kstep, voffB);
        PG8_WAIT_V(6); PG8_BAR;
    } else {
        PG8_STAGE(PG8_SB(0, 0), cB, voffB); PG8_STAGE(PG8_SA(0, 0), cA, voffA); PG8_STAGE(PG8_SB(0, 1), cB + hstep, voffB); PG8_STAGE(PG8_SA(0, 1), cA + hstep, voffA);
        if (wr == 1) PG8_BAR;
        PG8_WAIT_V(4); PG8_BAR;
        PG8_STAGE(PG8_SB(1, 0), cB + kstep, voffB); PG8_STAGE(PG8_SA(1, 0), cA + kstep, voffA); PG8_STAGE(PG8_SB(1, 1), cB + hstep + kstep, voffB);
        PG8_WAIT_V(6); PG8_BAR;
    }
      cA = cA0; cB = cB0; }
    for (;;) {
        const bool has_next = S.next(ui + 1, nxt);
        const char* nA = has_next ? (const char*)g.A + (size_t)nxt.pm * tstep : cA; const char* nB = has_next ? (const char*)g.Bt + (size_t)nxt.pn * tstep : cB;
        const int rn = has_next ? krot(nxt) : rc;
        for (int t = 0; t < nt; t += 2) {
            const bool last = (t == nt - 2);
            int kt = t + rc; kt = kt >= nt ? kt - nt : kt; int kt2 = kt + 2; kt2 = kt2 >= nt ? kt2 - nt : kt2;
            const char* a1 = cA + (size_t)(kt + 1) * kstep;
            const char* a2 = last ? nA + (size_t)rn * kstep : cA + (size_t)kt2 * kstep; const char* b2 = last ? nB + (size_t)rn * kstep : cB + (size_t)kt2 * kstep;
            const char* a3 = a2 + kstep; const char* b3 = b2 + kstep;
            if (last && has_next) S.a_ready(nxt);
            if constexpr (Epi::PRE) { if (last) E.pre(cur); }
            if constexpr (Epi::MIDK > 0) { if (t == Epi::MIDK) E.mid(acc, cur, wr, wc, fr, fq); }
            if constexpr (SP2) {
            PG8_LDB(B0, 0, 0); PG8_LDB(B1, 0, 1); PG8_SCHED; PG8_LDA(At, 0, 0); PG8_STAGE(PG8_SA(1, 1), a1 + hstep, voffA);
            PG8_WAIT_V(8); PG8_WAIT_L(0); PG8_BAR; PG8_MMA(0, 0, At, B0); PG8_MMA(0, 1, At, B1); PG8_BAR; PG8_SCHED;
            PG8_LDA(At, 0, 1); PG8_STAGE(PG8_SB(0, 0), b2, voffB); PG8_STAGE(PG8_SB(0, 1), b2 + hstep, voffB); PG8_STAGE(PG8_SA(0, 0), a2, voffA);
            PG8_WAIT_V(8); PG8_WAIT_L(0); PG8_BAR; PG8_MMA(1, 0, At, B0); PG8_MMA(1, 1, At, B1); PG8_BAR; PG8_SCHED;
            PG8_LDB(B0, 1, 0); PG8_LDB(B1, 1, 1); PG8_SCHED; PG8_LDA(At, 1, 0); PG8_STAGE(PG8_SA(0, 1), a2 + hstep, voffA);
            PG8_WAIT_V(8); PG8_WAIT_L(0); PG8_BAR; PG8_MMA(0, 0, At, B0); PG8_MMA(0, 1, At, B1); PG8_BAR; PG8_SCHED;
            PG8_LDA(At, 1, 1); PG8_STAGE(PG8_SB(1, 0), b3, voffB); PG8_STAGE(PG8_SB(1, 1), b3 + hstep, voffB); PG8_STAGE(PG8_SA(1, 0), a3, voffA);
            PG8_WAIT_V(8); PG8_WAIT_L(0); PG8_BAR; PG8_MMA(1, 0, At, B0); PG8_MMA(1, 1, At, B1); PG8_BAR; PG8_SCHED;
            } else {
            PG8_LDB(B0, 0, 0); PG8_SCHED; PG8_LDA(At, 0, 0); PG8_STAGE(PG8_SA(1, 1), a1 + hstep, voffA);
            PG8_WAIT_L(8); PG8_BAR; PG8_WAIT_L(0); PG8_MMA(0, 0, At, B0); PG8_BAR; PG8_SCHED;
            PG8_LDB(B1, 0, 1); PG8_STAGE(PG8_SB(0, 0), b2, voffB);
            PG8_BAR; PG8_WAIT_L(0); PG8_MMA(0, 1, At, B1); PG8_BAR;
            PG8_LDA(At, 0, 1); PG8_STAGE(PG8_SA(0, 0), a2, voffA);
            PG8_BAR; PG8_WAIT_L(0); PG8_MMA(1, 0, At, B0); PG8_BAR; PG8_SCHED;
            PG8_STAGE(PG8_SB(0, 1), b2 + hstep, voffB);
            PG8_WAIT_V(6); PG8_BAR; PG8_MMA(1, 1, At, B1); PG8_BAR;
            PG8_LDB(B0, 1, 0); PG8_SCHED; PG8_LDA(At, 1, 0); PG8_STAGE(PG8_SA(0, 1), a2 + hstep, voffA);
            PG8_WAIT_L(8); PG8_BAR; PG8_WAIT_L(0); PG8_MMA(0, 0, At, B0); PG8_BAR; PG8_SCHED;
            PG8_LDB(B1, 1, 1); PG8_STAGE(PG8_SB(1, 0), b3, voffB);
            PG8_BAR; PG8_WAIT_L(0); PG8_MMA(0, 1, At, B1); PG8_BAR;
            PG8_LDA(At, 1, 1); PG8_STAGE(PG8_SA(1, 0), a3, voffA);
            PG8_BAR; PG8_WAIT_L(0); PG8_MMA(1, 0, At, B0); PG8_BAR; PG8_SCHED;
            PG8_STAGE(PG8_SB(1, 1), b3 + hstep, voffB);
            PG8_WAIT_V(6); PG8_BAR; PG8_MMA(1, 1, At, B1); PG8_BAR;
            }
        }
        if constexpr (ALIGN_EPI) { if (wr == 0) PG8_BAR; }
#ifdef EPI_DUP
        if constexpr (!Epi::AFTER_DRAIN) { if (E.dup) { E(acc, cur, wr, wc, fr, fq); asm volatile("" ::: "memory"); } }
#endif
        if constexpr (!Epi::AFTER_DRAIN) { E(acc, cur, wr, wc, fr, fq); S.done(cur); }
        if (!has_next) break;
#pragma unroll
        for (int a = 0; a < 2; ++a)
#pragma unroll
            for (int b = 0; b < 2; ++b)
#pragma unroll
                for (int m = 0; m < 4; ++m)
#pragma unroll
                    for (int n = 0; n < 2; ++n) acc[a][b][m][n] = (f32x4){0.f, 0.f, 0.f, 0.f};
        cur = nxt; cA = nA; cB = nB; rc = rn; ++ui;
        if constexpr (ALIGN_EPI) { if (wr == 1) PG8_BAR; }
    }
    PG8_WAIT_V(0);
    if constexpr (!ALIGN_EPI) { if (wr == 0) PG8_BAR; }
    PG8_BAR;
    if constexpr (Epi::AFTER_DRAIN) { E.fused(acc, cur, wr, wc, fr, fq, lds, wid, lane); S.done(cur); }
#undef PG8_SA
#undef PG8_SB
#undef PG8_STAGE
#undef PG8_LDA
#undef PG8_LDB
#undef PG8_MMA
#undef PG8_WAIT_V
#undef PG8_WAIT_L
#undef PG8_BAR
#undef PG8_SCHED
}
}
#include <cmath>

constexpr int NWAVES = 8;
constexpr int NB = 8, SEQ = 4096, M = NB * SEQ, DM = 1024;
constexpr int IN_TOTAL = 5188, NIN = 5376;
constexpr int PA_LD = 1280;
constexpr int PA_Q = 0, PA_K = 512, PA_V = 640, PA_QI = 768, PA_KI = 1024, PA_WI = 1088;
constexpr int DFF = 2816, NUP = 2 * DFF;
constexpr float EPS = 1e-6f;
constexpr int TOPK = 256;

#ifndef MK_ONE_LAUNCH
#define MK_ONE_LAUNCH 1
#endif
constexpr int NPH = 11;

constexpr size_t MiB = 1u << 20;
constexpr size_t WS_CTL = 0, CTL_ZERO_BYTES = 64 * 1024;
constexpr size_t WS_WIN = 1 * MiB, WS_WOA = 12 * MiB, WS_WOB = 13 * MiB, WS_WOUT = 15 * MiB, WS_WUP = 17 * MiB, WS_WDN = 28 * MiB;
constexpr size_t WS_RINV1 = 34 * MiB, WS_SSQ2 = 35 * MiB;
constexpr size_t WS_XB = 40 * MiB;
constexpr size_t WS_ATTN = 40 * MiB;
constexpr size_t OUT_KV = 16 * MiB;
constexpr size_t OUT_ARN = 32 * MiB;
constexpr size_t WS_KI = 35 * MiB;
constexpr size_t WS_WI = 34 * MiB + 256 * 1024;
constexpr size_t WS_GAINS = 34 * MiB + 128 * 1024;
constexpr size_t WS_PA = 104 * MiB;
constexpr size_t WS_RX = 184 * MiB, WS_RGATE = 248 * MiB, WS_GA = 312 * MiB, WS_GB = 376 * MiB;
constexpr size_t WS_MERGED = 104 * MiB;
constexpr size_t WS_X1B = 312 * MiB;
constexpr size_t WS_RNN = 440 * MiB;
constexpr size_t WS_H = 40 * MiB;
constexpr size_t WS_HALO = 216 * MiB;
constexpr size_t WS_SCR = 224 * MiB;
constexpr size_t WS_END = 504 * MiB;
static_assert(WS_WIN + (size_t)NIN * 1024 * 2 <= WS_WOA && WS_WUP + (size_t)NUP * 1024 * 2 <= WS_WDN && WS_WDN + (size_t)1024 * DFF * 2 <= WS_RINV1, "weights map");
static_assert(WS_H + (size_t)M * DFF * 2 <= WS_HALO && WS_HALO + (size_t)128 * 4 * NUP * 2 <= WS_SCR && WS_SCR + (size_t)256 * 65536 * 2 <= WS_X1B, "ffn map");
constexpr int CW_BAR = 4096, CW_QUEUE = 64;

constexpr int RING_OFF = 0, RING_BYTES = 131072, XSLAB_OFF = 131072;
constexpr int PHASE_LDS = 163072;
constexpr int LDSCTL_OFF = PHASE_LDS, MISC_OFF = LDSCTL_OFF + 320;
constexpr int LDS_BYTES = 163840;
static_assert(MISC_OFF + 128 <= LDS_BYTES && LDS_BYTES <= 163840, "LDS map");
#define GAS __attribute__((address_space(1)))
#define LAS __attribute__((address_space(3)))
typedef unsigned short bf16;
typedef unsigned v4u __attribute__((ext_vector_type(4)));
typedef float f32x4 __attribute__((ext_vector_type(4)));
typedef short bf16x8 __attribute__((ext_vector_type(8)));
typedef GAS unsigned gu32;
typedef GAS unsigned long long gu64;
#define RLX_AGENT __ATOMIC_RELAXED, __HIP_MEMORY_SCOPE_AGENT
#define LDS_WAIT() asm volatile("s_waitcnt lgkmcnt(0)" ::: "memory")
#define VM_WAIT() asm volatile("s_waitcnt vmcnt(0)" ::: "memory")
__device__ __forceinline__ unsigned long long rt() { return __builtin_amdgcn_s_memrealtime(); }
__device__ __forceinline__ unsigned f2bf(float f) { unsigned u = __builtin_bit_cast(unsigned, f); return (u + 0x7fffu + ((u >> 16) & 1u)) >> 16; }
__device__ __forceinline__ unsigned pk2(float lo, float hi) { return f2bf(lo) | (f2bf(hi) << 16); }

#define XB_TMO      128
#define XB_XCNT(j)  (256  + 64 * (j))
#define XB_XSUB(j)  (1280 + 64 * (j))
#define XB_XGEN(j)  (2304 + 64 * (j))
#define XB_TOP      3328
#define XB_TOPGEN   3392
#define XCD_BAR_WORDS 3456
#define XB_SPIN_CAP (1u << 18)

__device__ __forceinline__ unsigned xb_ld(unsigned* p)              { return __hip_atomic_load(p, __ATOMIC_RELAXED, __HIP_MEMORY_SCOPE_AGENT); }
__device__ __forceinline__ unsigned xb_add(unsigned* p, unsigned v) { return __hip_atomic_fetch_add(p, v, __ATOMIC_RELAXED, __HIP_MEMORY_SCOPE_AGENT); }
__device__ __forceinline__ unsigned xb_xcc_id() { return (unsigned)__builtin_amdgcn_s_getreg((3 << 11) | 20) & 0xFu; }
#define XB_SPIN(cond, bar) do { unsigned _sp = 0; while (cond) { __builtin_amdgcn_s_sleep(1); \
    if ((++_sp & 255u) == 0u) { if (xb_ld(&(bar)[XB_TMO])) break; if (_sp > XB_SPIN_CAP) { atomicAdd(&(bar)[XB_TMO], 1u); break; } } } } while (0)

struct XcdBarrier {
    unsigned* bar; unsigned x;
    volatile LAS unsigned* st;
};

__device__ __forceinline__ XcdBarrier xcd_barrier_post(unsigned* bar, volatile LAS unsigned* st) {
    XcdBarrier b; b.bar = bar; b.x = xb_xcc_id(); b.st = st;
    if (threadIdx.x == 0) (void)xb_add(&bar[XB_XCNT(b.x)], 1u);
    return b;
}
__device__ __forceinline__ void xcd_barrier_complete(unsigned* bar, unsigned x, unsigned& nloc, unsigned& nx) {
    const unsigned G = gridDim.x * gridDim.y * gridDim.z;
    unsigned sum, cnt, mine, sp = 0u;
    for (;;) {
        sum = 0u; cnt = 0u; mine = 0u;
#pragma unroll
        for (unsigned j = 0; j < 16; ++j) { const unsigned c = xb_ld(&bar[XB_XCNT(j)]); sum += c; cnt += (c > 0u) ? 1u : 0u; mine = (j == x) ? c : mine; }
        if (sum == G) break;
        __builtin_amdgcn_s_sleep(1);
        if ((++sp & 255u) == 0u) { if (xb_ld(&bar[XB_TMO])) break; if (sp > XB_SPIN_CAP) { atomicAdd(&bar[XB_TMO], 1u); break; } }
    }
    nloc = mine > 0u ? mine : 1u; nx = cnt > 0u ? cnt : 1u;
}

__device__ __forceinline__ void xcd_barrier(const XcdBarrier& b) {
    asm volatile("s_waitcnt vmcnt(0)" ::: "memory");
    __syncthreads();
    if (threadIdx.x == 0) {
        unsigned* bar = b.bar;
        __builtin_amdgcn_s_waitcnt(0);
        unsigned nloc = b.st[0], nx = b.st[1];
        if (nloc == 0u) { xcd_barrier_complete(bar, b.x, nloc, nx); b.st[0] = nloc; b.st[1] = nx; }
        const unsigned old = xb_add(&bar[XB_XSUB(b.x)], 1u);
        const unsigned gen = old / nloc;
        if (old + 1u == (gen + 1u) * nloc) {
            __builtin_amdgcn_fence(__ATOMIC_RELEASE, "agent");
            asm volatile("s_waitcnt vmcnt(0)" ::: "memory");
            const unsigned og = xb_add(&bar[XB_TOP], 1u);
            const unsigned tg = og / nx;
            if (og + 1u == (tg + 1u) * nx) xb_add(&bar[XB_TOPGEN], 1u);
            else XB_SPIN(xb_ld(&bar[XB_TOPGEN]) == tg, bar);
            __builtin_amdgcn_fence(__ATOMIC_ACQUIRE, "agent");
            xb_add(&bar[XB_XGEN(b.x)], 1u);
            asm volatile("s_waitcnt vmcnt(0)" ::: "memory");
        } else {
            XB_SPIN(xb_ld(&bar[XB_XGEN(b.x)]) == gen, bar);
            __builtin_amdgcn_fence(__ATOMIC_ACQUIRE, "agent");
            asm volatile("s_waitcnt vmcnt(0)" ::: "memory");
        }
    }
    __syncthreads();
}

struct Frame {
    LAS unsigned char* lds;
    volatile LAS unsigned* MISC;
    gu32* ctl;
    int tid, lane, wave;
    int vcu, G;
    const float* in[21]; float* out; unsigned char* ws;
};
__device__ __forceinline__ float wave_sum(float v) {
#pragma unroll
    for (int o = 1; o < 64; o <<= 1) v += __shfl_xor(v, o);
    return v;
}
__device__ __forceinline__ int wave_sum_i(int v) {
#pragma unroll
    for (int o = 1; o < 64; o <<= 1) v += __shfl_xor(v, o);
    return v;
}
__device__ __forceinline__ float wave_max(float v) {
#pragma unroll
    for (int o = 1; o < 64; o <<= 1) v = fmaxf(v, __shfl_xor(v, o));
    return v;
}
__device__ __forceinline__ float bf2f(unsigned short h) { return __builtin_bit_cast(float, (unsigned)h << 16); }
__device__ __forceinline__ float bflo(unsigned u) { return __builtin_bit_cast(float, u << 16); }
__device__ __forceinline__ float bfhi(unsigned u) { return __builtin_bit_cast(float, u & 0xffff0000u); }
__device__ __forceinline__ float sigmoid_f(float x) { return 1.0f / (1.0f + __expf(-x)); }
__device__ __forceinline__ float gelu_tanh_f(float x) { const float u = 0.7978845608028654f * (x + 0.044715f * x * x * x); return 0.5f * x * (1.0f + tanhf(u)); }

enum { MAP_ID = 0, MAP_WIN = 1, MAP_WUP = 2 };
__device__ __forceinline__ int src_col(int kind, int n) {
    if (kind == MAP_WIN) {
        if (n >= 1280) return n - 188;
        const int pn = n >> 8, bj = (n >> 7) & 1, wc = (n >> 5) & 3, x = n & 31, H = 4 * pn + wc, d = 32 * bj + x;
        if (H < 17) return H * 64 + d;
        return (H == 17 && d < 4) ? 1088 + d : -1;
    }
    if (kind == MAP_WUP) { const int j = n >> 8, r = n & 255; return r < 128 ? j * 128 + r : DFF + j * 128 + (r - 128); }
    return n;
}
__device__ __forceinline__ void p0_transpose_item(const float* W, int K, int N, int NP, const float* gain, int kind, bf16* WT, int ldk, LAS float* scr, int item, int lane) {
    const int nblk = NP / 32, kb = item / nblk, nb = item % nblk, k0 = 64 * kb, n0 = 32 * nb;
    const int sc = src_col(kind, n0 + (lane & 31));
    float wv[32];
#pragma unroll
    for (int i = 0; i < 32; ++i) { const int kk = 2 * i + (lane >> 5); wv[i] = (sc >= 0) ? W[(size_t)(k0 + kk) * N + sc] : 0.f; }
#pragma unroll
    for (int i = 0; i < 32; ++i) { const int kk = 2 * i + (lane >> 5); float v = wv[i]; if (gain) v *= gain[k0 + kk]; scr[kk * 33 + (lane & 31)] = v; }
    LDS_WAIT(); asm volatile("" ::: "memory");
    const int c = lane & 7;
#pragma unroll
    for (int j = 0; j < 4; ++j) { const int n = (lane >> 3) + 8 * j; const LAS float* s = scr + (8 * c) * 33 + n;
        v4u o; o.x = pk2(s[0 * 33], s[1 * 33]); o.y = pk2(s[2 * 33], s[3 * 33]); o.z = pk2(s[4 * 33], s[5 * 33]); o.w = pk2(s[6 * 33], s[7 * 33]);
        *(GAS v4u*)(WT + (size_t)(n0 + n) * ldk + k0 + 8 * c) = o; }
    LDS_WAIT(); asm volatile("" ::: "memory");
}
__device__ __forceinline__ void p0_transposes(Frame& F, int first, int last, int wi, int nw) {
    LAS float* scr = (LAS float*)(F.lds + RING_OFF + F.wave * 16384);
    constexpr int I_IN = 16 * (NIN / 32), I_OA = 8 * 32, I_OB = 16 * 32, I_OUT = 16 * 32, I_UP = 16 * (NUP / 32);
    unsigned char* ws = F.ws;
    for (int it = first + wi; it < last; it += nw) {
        int r = it;
        if (r < I_IN) { p0_transpose_item(F.in[2], 1024, IN_TOTAL, NIN, F.in[1], MAP_WIN, (bf16*)(ws + WS_WIN), 1024, scr, r, F.lane); continue; } r -= I_IN;
        if (r < I_OA) { p0_transpose_item(F.in[13], 512, 1024, 1024, nullptr, MAP_ID, (bf16*)(ws + WS_WOA), 1536, scr, r, F.lane); continue; } r -= I_OA;
        if (r < I_OB) { p0_transpose_item(F.in[14], 1024, 1024, 1024, nullptr, MAP_ID, (bf16*)(ws + WS_WOA) + 512, 1536, scr, r, F.lane); continue; } r -= I_OB;
        if (r < I_OUT) { p0_transpose_item(F.in[15], 1024, 1024, 1024, nullptr, MAP_ID, (bf16*)(ws + WS_WOUT), 1024, scr, r, F.lane); continue; } r -= I_OUT;
        if (r < I_UP) { p0_transpose_item(F.in[17], 1024, NUP, NUP, F.in[16], MAP_WUP, (bf16*)(ws + WS_WUP), 1024, scr, r, F.lane); continue; } r -= I_UP;
        p0_transpose_item(F.in[20], DFF, 1024, 1024, nullptr, MAP_ID, (bf16*)(ws + WS_WDN), DFF, scr, r, F.lane);
    }
}
constexpr int P0_I_IN = 16 * (NIN / 32), P0_NITEMS = P0_I_IN + 8 * 32 + 16 * 32 + 16 * 32 + 16 * (NUP / 32) + (DFF / 64) * 32;
__device__ __forceinline__ bool p0_defer(int G) { return G == 256; }
__device__ __forceinline__ void p0_prologue(Frame& F) {
    const int gw = F.vcu * NWAVES + F.wave, NGW = F.G * NWAVES;
    unsigned char* ws = F.ws;
    p0_transposes(F, 0, p0_defer(F.G) ? P0_I_IN : P0_NITEMS, gw, NGW);
    if (F.vcu == 1 && F.wave == 0) {
        const float mq = wave_max(fabsf(F.in[3][F.lane])), mk = wave_max(fabsf(F.in[4][F.lane]));
        if (F.lane == 0) ((float*)(ws + WS_GAINS))[192] = 8.0f * mq * mk * 1.15f;
    }
    if (F.vcu == 0 && F.tid < 192) { float* gd = (float*)(ws + WS_GAINS); const int j = F.tid >> 6, d = F.tid & 63; const float v0 = F.in[3][d], v1 = F.in[4][d], v2 = F.in[5][d]; gd[F.tid] = j == 0 ? v0 : (j == 1 ? v1 : v2); }
    const float* x = F.in[0]; bf16* xb = (bf16*)(ws + WS_XB); float* rinv1 = (float*)(ws + WS_RINV1);
    for (int m0 = gw; m0 < M; m0 += 4 * NGW) {
        f32x4 v[4][4];
#pragma unroll
        for (int q = 0; q < 4; ++q) { const int m = m0 + q * NGW; const GAS f32x4* xr = (const GAS f32x4*)(x + (size_t)(m < M ? m : m0) * DM) + F.lane;
#pragma unroll
            for (int j = 0; j < 4; ++j) v[q][j] = xr[64 * j]; }
#pragma unroll
        for (int q = 0; q < 4; ++q) { const int m = m0 + q * NGW; if (m >= M) break;
            float s = 0.f;
#pragma unroll
            for (int j = 0; j < 4; ++j) s += (v[q][j].x * v[q][j].x + v[q][j].y * v[q][j].y) + (v[q][j].z * v[q][j].z + v[q][j].w * v[q][j].w);
            s = wave_sum(s);
            const float ri = 1.0f / sqrtf(s * (1.0f / DM) + EPS);
            GAS unsigned long long* o8 = (GAS unsigned long long*)(xb + (size_t)m * DM) + F.lane;
#pragma unroll
            for (int j = 0; j < 4; ++j) o8[64 * j] = (unsigned long long)pk2(v[q][j].x * ri, v[q][j].y * ri) | ((unsigned long long)pk2(v[q][j].z * ri, v[q][j].w * ri) << 32);
            if (F.lane == 0) rinv1[m] = sqrtf(s * (1.0f / DM) + EPS); }
    }
}

typedef float f32x16 __attribute__((ext_vector_type(16)));
typedef short v4i16_t __attribute__((ext_vector_type(4)));
__device__ __forceinline__ unsigned f2key(float f) { unsigned u = __builtin_bit_cast(unsigned, f); u = (u == 0x80000000u) ? 0u : u; return (u & 0x80000000u) ? ~u : (u | 0x80000000u); }
__device__ __forceinline__ unsigned lds_add_rtn(LAS unsigned* p, unsigned v) { return __hip_atomic_fetch_add(p, v, __ATOMIC_RELAXED, __HIP_MEMORY_SCOPE_WORKGROUP); }
__device__ __forceinline__ void lds_add(LAS unsigned* p, unsigned v) { (void)__hip_atomic_fetch_add(p, v, __ATOMIC_RELAXED, __HIP_MEMORY_SCOPE_WORKGROUP); }

__device__ __forceinline__ void slow_select(Frame& F, int qidx, LAS unsigned* keys, unsigned short* dst) {
    const int lane = F.lane, ksub = lane >> 3, chunk = lane & 7;
    const unsigned long long lt_mask = (lane == 0) ? 0ull : (~0ull >> (64 - lane));
    const bf16* PA = (const bf16*)(F.ws + WS_PA); const bf16* KI = (const bf16*)(F.ws + WS_KI); const float* WI = (const float*)(F.ws + WS_WI);
    const int b = qidx / SEQ, t = qidx % SEQ, n = t + 1;
    const bf16* qrow = PA + (size_t)qidx * PA_LD; const bf16* kbase = KI + (size_t)b * SEQ * 64;
    float qi[4][8];
#pragma unroll
    for (int h = 0; h < 4; ++h) { const v4u u = *(const GAS v4u*)(qrow + PA_QI + h * 64 + chunk * 8);
        qi[h][0] = bflo(u.x); qi[h][1] = bfhi(u.x); qi[h][2] = bflo(u.y); qi[h][3] = bfhi(u.y); qi[h][4] = bflo(u.z); qi[h][5] = bfhi(u.z); qi[h][6] = bflo(u.w); qi[h][7] = bfhi(u.w); }
    const f32x4 wv = *(const GAS f32x4*)(WI + (size_t)qidx * 4);
    for (int s0 = 0; s0 < n; s0 += 8) {
        const int s = s0 + ksub; const int sc = s < n ? s : t;
        const v4u u = *(const GAS v4u*)(kbase + (size_t)sc * 64 + chunk * 8);
        const float kf[8] = {bflo(u.x), bfhi(u.x), bflo(u.y), bfhi(u.y), bflo(u.z), bfhi(u.z), bflo(u.w), bfhi(u.w)};
        float a[4];
#pragma unroll
        for (int h = 0; h < 4; ++h) { float x = 0.f;
#pragma unroll
            for (int e = 0; e < 8; ++e) x += kf[e] * qi[h][e];
            x += __shfl_xor(x, 1); x += __shfl_xor(x, 2); x += __shfl_xor(x, 4); a[h] = x; }
        const float score = wv.x * fmaxf(a[0], 0.f) + wv.y * fmaxf(a[1], 0.f) + wv.z * fmaxf(a[2], 0.f) + wv.w * fmaxf(a[3], 0.f);
        if (chunk == 0 && s < n) keys[s] = f2key(score);
    }
    if (n > TOPK) {
        unsigned prefix = 0u;
        for (int bit = 31; bit >= 0; --bit) {
            const unsigned cand = prefix | (1u << bit);
            int cnt = 0;
            for (int s = lane; s < n; s += 64) cnt += (keys[s] >= cand) ? 1 : 0;
            cnt = wave_sum_i(cnt);
            if (cnt >= TOPK) prefix = cand;
        }
        const unsigned tau = prefix;
        int cgt = 0;
        for (int s = lane; s < n; s += 64) cgt += (keys[s] > tau) ? 1 : 0;
        cgt = wave_sum_i(cgt);
        const int need = TOPK - cgt;
        int base = 0, eqseen = 0;
        for (int s0 = 0; s0 < n; s0 += 64) {
            const int s = s0 + lane; const bool in = s < n; const unsigned k = in ? keys[s] : 0u;
            const bool gt = in && k > tau, eq = in && k == tau;
            const unsigned long long beq = __ballot(eq);
            const int rank_eq = eqseen + __popcll(beq & lt_mask);
            const bool take = gt || (eq && rank_eq < need);
            const unsigned long long bs = __ballot(take);
            if (take) dst[base + __popcll(bs & lt_mask)] = (unsigned short)s;
            base += __popcll(bs); eqseen += __popcll(beq);
        }
    } else {
        for (int j = lane; j < TOPK; j += 64) dst[j] = (unsigned short)(j < n ? j : t);
    }
}

constexpr int TK_ROW = 4112, TK_CROW = 4112, TK_CAP = 512;
constexpr int TK_SEL_OFF = 32 * 4112, TK_SM_OFF = PHASE_LDS - 1664;
static_assert(TK_SM_OFF + 1024 <= PHASE_LDS, "top-k LDS map");
__device__ __forceinline__ int crow16(int r, int hi) { return (r & 3) + 8 * (r >> 2) + 4 * hi; }

__device__ __forceinline__ float relu_asm(float x) { const int i = __builtin_bit_cast(int, x); return __builtin_bit_cast(float, i > 0 ? i : 0); }
__device__ __forceinline__ unsigned key_of(float sc) { const unsigned u = __builtin_bit_cast(unsigned, sc); return u ^ (((unsigned)((int)u >> 31)) | 0x80000000u); }
constexpr int TK_TRASH_OFF = TK_SM_OFF + 1024;
static_assert(TK_TRASH_OFF + 640 <= PHASE_LDS, "top-k LDS map");
constexpr int TK2_CAP = 768, TK2_KROW = TK2_CAP * 4 + 16, TK2_IROW = TK2_CAP * 2 + 8, TK2_IDX_OFF = 32 * TK2_KROW, TK2_TARGET = 470;
static_assert(TK2_IDX_OFF + 32 * TK2_IROW <= TK_SM_OFF, "top-k LDS map");
#ifndef TK_BALLOT_STEP
#define TK_BALLOT_STEP 1
#endif
#ifndef TK_PIPE
#define TK_PIPE 1
#endif
#ifndef TK_SPLIT_HEADS
#define TK_SPLIT_HEADS 1
#endif
#ifndef TK_SKEW
#define TK_SKEW 0
#endif
#ifndef TK_EXECSTORE
#define TK_EXECSTORE 0
#endif
#ifndef TK_FAST
#define TK_FAST 1
#endif
template <int CTRL> __device__ __forceinline__ unsigned dpp_mov0(unsigned x) { return (unsigned)__builtin_amdgcn_update_dpp(0, (int)x, CTRL, 0xF, 0xF, false); }
__device__ __forceinline__ unsigned wave_sum_dpp(unsigned x) {
    x += dpp_mov0<0xB1>(x); x += dpp_mov0<0x4E>(x); x += dpp_mov0<0x124>(x); x += dpp_mov0<0x128>(x);
    return (unsigned)__builtin_amdgcn_readlane((int)x, 0) + (unsigned)__builtin_amdgcn_readlane((int)x, 16) + (unsigned)__builtin_amdgcn_readlane((int)x, 32) + (unsigned)__builtin_amdgcn_readlane((int)x, 48);
}
__device__ __forceinline__ unsigned wave_max_dpp(unsigned x) {
    unsigned y;
    y = dpp_mov0<0xB1>(x); x = x > y ? x : y; y = dpp_mov0<0x4E>(x); x = x > y ? x : y; y = dpp_mov0<0x124>(x); x = x > y ? x : y; y = dpp_mov0<0x128>(x); x = x > y ? x : y;
    const unsigned a = (unsigned)__builtin_amdgcn_readlane((int)x, 0), b = (unsigned)__builtin_amdgcn_readlane((int)x, 16), c = (unsigned)__builtin_amdgcn_readlane((int)x, 32), d = (unsigned)__builtin_amdgcn_readlane((int)x, 48);
    const unsigned ab = a > b ? a : b, cd = c > d ? c : d; return ab > cd ? ab : cd;
}
__device__ __forceinline__ unsigned wave_excl_scan_dpp(unsigned c, int lane) {
    unsigned x = c;
    x += dpp_mov0<0x111>(x); x += dpp_mov0<0x112>(x); x += dpp_mov0<0x114>(x); x += dpp_mov0<0x118>(x);
    const unsigned t0 = (unsigned)__builtin_amdgcn_readlane((int)x, 15), t1 = (unsigned)__builtin_amdgcn_readlane((int)x, 31), t2 = (unsigned)__builtin_amdgcn_readlane((int)x, 47);
    const int row = lane >> 4;
    return x - c + (row >= 1 ? t0 : 0u) + (row >= 2 ? t1 : 0u) + (row >= 3 ? t2 : 0u);
}
__device__ __forceinline__ void tk_keys(unsigned (&keyv)[16], const pg8::bf16x8 (&a0)[4], const pg8::bf16x8 (&qf)[4][4], f32x4 wv) {
    const f32x16 z16 = (f32x16){0.f, 0.f, 0.f, 0.f, 0.f, 0.f, 0.f, 0.f, 0.f, 0.f, 0.f, 0.f, 0.f, 0.f, 0.f, 0.f};
    f32x16 accA, accB;
    float part[16];
    accA = __builtin_amdgcn_mfma_f32_32x32x16_bf16(a0[0], qf[0][0], z16, 0, 0, 0); accB = __builtin_amdgcn_mfma_f32_32x32x16_bf16(a0[0], qf[1][0], z16, 0, 0, 0);
#pragma unroll
    for (int ks = 1; ks < 4; ++ks) { accA = __builtin_amdgcn_mfma_f32_32x32x16_bf16(a0[ks], qf[0][ks], accA, 0, 0, 0); accB = __builtin_amdgcn_mfma_f32_32x32x16_bf16(a0[ks], qf[1][ks], accB, 0, 0, 0); }
#pragma unroll
    for (int r = 0; r < 16; ++r) { const float sc = __builtin_fmaf(wv.x, relu_asm(accA[r]), 0.0f); part[r] = __builtin_fmaf(wv.y, relu_asm(accB[r]), sc); }
    if (TK_SPLIT_HEADS) __builtin_amdgcn_sched_barrier(0);
    accA = __builtin_amdgcn_mfma_f32_32x32x16_bf16(a0[0], qf[2][0], z16, 0, 0, 0); accB = __builtin_amdgcn_mfma_f32_32x32x16_bf16(a0[0], qf[3][0], z16, 0, 0, 0);
#pragma unroll
    for (int ks = 1; ks < 4; ++ks) { accA = __builtin_amdgcn_mfma_f32_32x32x16_bf16(a0[ks], qf[2][ks], accA, 0, 0, 0); accB = __builtin_amdgcn_mfma_f32_32x32x16_bf16(a0[ks], qf[3][ks], accB, 0, 0, 0); }
#pragma unroll
    for (int r = 0; r < 16; ++r) { float sc = __builtin_fmaf(wv.z, relu_asm(accA[r]), part[r]); sc = __builtin_fmaf(wv.w, relu_asm(accB[r]), sc); keyv[r] = key_of(sc); }
}
template <int PASS, bool DIAG>
__device__ __forceinline__ void tk_consume(LAS unsigned char* L, const unsigned (&keyv)[16], int kt, int r32, int hi, int lane, unsigned bstar, LAS unsigned* hrow, LAS unsigned* sm, LAS unsigned short* selr) {
    if (PASS == 1) {
#pragma unroll
        for (int r = 0; r < 16; ++r) {
            const unsigned k = keyv[r];
            LAS unsigned* wp = (LAS unsigned*)((LAS unsigned char*)hrow + ((k >> 20) & 0xFFCu));
            const unsigned val = 1u << ((k >> 17) & 16u);
            if (DIAG) { if (crow16(r, hi) <= r32) lds_add(wp, val); } else lds_add(wp, val);
        }
    } else if (PASS == 3) {
        unsigned c = 0u; const unsigned thr = bstar << 20;
#pragma unroll
        for (int r = 0; r < 16; ++r) { const bool v = !DIAG || crow16(r, hi) <= r32; c += (v && keyv[r] >= thr) ? 1u : 0u; }
        unsigned pos = lds_add_rtn(sm + 128 + r32, c);
        LAS unsigned short* const trash16 = (LAS unsigned short*)(L + TK_TRASH_OFF) + lane;
        LAS unsigned* const trash32 = (LAS unsigned*)(L + TK_TRASH_OFF + 128) + lane;
        LAS unsigned* const keyr = (LAS unsigned*)(L + r32 * TK2_KROW);
        LAS unsigned short* const idxr = (LAS unsigned short*)(L + TK2_IDX_OFF + r32 * TK2_IROW);
#pragma unroll
        for (int r = 0; r < 16; ++r) { const unsigned s = (unsigned)(32 * kt + crow16(r, hi)); const bool v = !DIAG || crow16(r, hi) <= r32;
            const bool p = v && keyv[r] >= thr; const bool st = p && pos < (unsigned)TK2_CAP;
#if TK_EXECSTORE
            if (st) { keyr[pos] = keyv[r]; idxr[pos] = (unsigned short)s; } pos += p ? 1u : 0u; }
#else
            LAS unsigned* pk = st ? keyr + pos : trash32; *pk = keyv[r];
            LAS unsigned short* pi = st ? idxr + pos : trash16; *pi = (unsigned short)s; pos += p ? 1u : 0u; }
#endif
    } else {
        unsigned csel = 0u, ccand = 0u;
#pragma unroll
        for (int r = 0; r < 16; ++r) { const unsigned bin = keyv[r] >> 21; const bool v = !DIAG || crow16(r, hi) <= r32; csel += (v && bin > bstar) ? 1u : 0u; ccand += (v && bin == bstar) ? 1u : 0u; }
        unsigned psel = lds_add_rtn(sm + 96 + r32, csel);
        unsigned pcand = lds_add_rtn(sm + 128 + r32, ccand);
        LAS unsigned short* const trash16 = (LAS unsigned short*)(L + TK_TRASH_OFF) + lane;
        LAS unsigned long long* const trash64 = (LAS unsigned long long*)(L + TK_TRASH_OFF + 128) + lane;
        LAS unsigned long long* const candr = (LAS unsigned long long*)(L + r32 * TK_CROW);
#pragma unroll
        for (int r = 0; r < 16; ++r) { const unsigned bin = keyv[r] >> 21; const unsigned s = (unsigned)(32 * kt + crow16(r, hi)); const bool v = !DIAG || crow16(r, hi) <= r32;
            const bool isS = v && bin > bstar, isC = v && bin == bstar;
            LAS unsigned short* ps = (isS && psel < 256u) ? selr + psel : trash16; *ps = (unsigned short)s; psel += isS ? 1u : 0u;
            LAS unsigned long long* pc = (isC && pcand < (unsigned)TK_CAP) ? candr + pcand : trash64; *pc = ((unsigned long long)keyv[r] << 32) | s; pcand += isC ? 1u : 0u; }
    }
}
template <int PASS>
__device__ __forceinline__ void tk_pass(LAS unsigned char* L, const bf16* KIb, int ntiles, int wave, int r32, int hi, int lane, const pg8::bf16x8 (&qf)[4][4], f32x4 wv, unsigned bstar) {
    typedef pg8::bf16x8 bx8;
    const bf16* kp0 = KIb + (size_t)r32 * 64 + hi * 8;
    LAS unsigned* hrow = (LAS unsigned*)(L + r32 * TK_ROW);
    LAS unsigned* sm = (LAS unsigned*)(L + TK_SM_OFF);
    LAS unsigned short* selr = (LAS unsigned short*)(L + TK_SEL_OFF) + r32 * 256;
    bx8 a0[4], a1[4];
    if (TK_SKEW > 0 && wave >= 4) __builtin_amdgcn_s_sleep(TK_SKEW);
    int kt = wave;
    { const int k0 = kt < ntiles ? kt : 0;
#pragma unroll
      for (int ks = 0; ks < 4; ++ks) a0[ks] = *(const GAS bx8*)(kp0 + (size_t)k0 * 32 * 64 + ks * 16); }
    for (; kt < ntiles; kt += 8) {
        const int ktn = (kt + 8 < ntiles) ? kt + 8 : kt;
#pragma unroll
        for (int ks = 0; ks < 4; ++ks) a1[ks] = *(const GAS bx8*)(kp0 + (size_t)ktn * 32 * 64 + ks * 16);
        unsigned keyv[16];
        tk_keys(keyv, a0, qf, wv);
        if (kt == ntiles - 1) tk_consume<PASS, true>(L, keyv, kt, r32, hi, lane, bstar, hrow, sm, selr);
        else tk_consume<PASS, false>(L, keyv, kt, r32, hi, lane, bstar, hrow, sm, selr);
#pragma unroll
        for (int ks = 0; ks < 4; ++ks) a0[ks] = a1[ks];
    }
}

__device__ __forceinline__ void tk_mfma2(f32x16& accA, f32x16& accB, const pg8::bf16x8 (&a)[4], const pg8::bf16x8 (&qf)[4][4], int h0) {
    const f32x16 z16 = (f32x16){0.f, 0.f, 0.f, 0.f, 0.f, 0.f, 0.f, 0.f, 0.f, 0.f, 0.f, 0.f, 0.f, 0.f, 0.f, 0.f};
    accA = __builtin_amdgcn_mfma_f32_32x32x16_bf16(a[0], qf[h0][0], z16, 0, 0, 0); accB = __builtin_amdgcn_mfma_f32_32x32x16_bf16(a[0], qf[h0 + 1][0], z16, 0, 0, 0);
#pragma unroll
    for (int ks = 1; ks < 4; ++ks) { accA = __builtin_amdgcn_mfma_f32_32x32x16_bf16(a[ks], qf[h0][ks], accA, 0, 0, 0); accB = __builtin_amdgcn_mfma_f32_32x32x16_bf16(a[ks], qf[h0 + 1][ks], accB, 0, 0, 0); }
}
__device__ __forceinline__ void tk_pass_collect(LAS unsigned char* L, const bf16* KIb, int ntiles, int wave, int r32, int hi, int lane, const pg8::bf16x8 (&qf)[4][4], f32x4 wv, unsigned bstar) {
    typedef pg8::bf16x8 bx8;
    const bf16* kp0 = KIb + (size_t)r32 * 64 + hi * 8;
    LAS unsigned* hrow = (LAS unsigned*)(L + r32 * TK_ROW);
    LAS unsigned* sm = (LAS unsigned*)(L + TK_SM_OFF);
    LAS unsigned short* selr = (LAS unsigned short*)(L + TK_SEL_OFF) + r32 * 256;
    int kt = wave;
    if (kt >= ntiles) return;
    bx8 an[4], a2[4];
#pragma unroll
    for (int ks = 0; ks < 4; ++ks) an[ks] = *(const GAS bx8*)(kp0 + (size_t)kt * 32 * 64 + ks * 16);
    { const int k1 = kt + 8 < ntiles ? kt + 8 : kt;
#pragma unroll
      for (int ks = 0; ks < 4; ++ks) a2[ks] = *(const GAS bx8*)(kp0 + (size_t)k1 * 32 * 64 + ks * 16); }
    unsigned keyv[16];
    tk_keys(keyv, an, qf, wv);
#pragma unroll
    for (int ks = 0; ks < 4; ++ks) an[ks] = a2[ks];
    while (kt + 8 < ntiles) {
        f32x16 accA, accB;
        tk_mfma2(accA, accB, an, qf, 0);
        { const int k2 = kt + 16 < ntiles ? kt + 16 : kt + 8;
#pragma unroll
          for (int ks = 0; ks < 4; ++ks) a2[ks] = *(const GAS bx8*)(kp0 + (size_t)k2 * 32 * 64 + ks * 16); }
        __builtin_amdgcn_sched_barrier(0);
        tk_consume<3, false>(L, keyv, kt, r32, hi, lane, bstar, hrow, sm, selr);
        __builtin_amdgcn_sched_barrier(0);
        float part[16];
#pragma unroll
        for (int r = 0; r < 16; ++r) { const float sc = __builtin_fmaf(wv.x, relu_asm(accA[r]), 0.0f); part[r] = __builtin_fmaf(wv.y, relu_asm(accB[r]), sc); }
        __builtin_amdgcn_sched_barrier(0);
        tk_mfma2(accA, accB, an, qf, 2);
#pragma unroll
        for (int r = 0; r < 16; ++r) { float sc = __builtin_fmaf(wv.z, relu_asm(accA[r]), part[r]); sc = __builtin_fmaf(wv.w, relu_asm(accB[r]), sc); keyv[r] = key_of(sc); }
#pragma unroll
        for (int ks = 0; ks < 4; ++ks) an[ks] = a2[ks];
        kt += 8;
    }
    if (kt == ntiles - 1) tk_consume<3, true>(L, keyv, kt, r32, hi, lane, bstar, hrow, sm, selr);
    else tk_consume<3, false>(L, keyv, kt, r32, hi, lane, bstar, hrow, sm, selr);
}
template <int NJ>
__device__ __forceinline__ void tk2_select(LAS unsigned char* L, LAS unsigned* sm, int r, int m, int lane5, bool dry) {
        const LAS unsigned* keyr = (const LAS unsigned*)(L + r * TK2_KROW);
        const LAS unsigned short* idxr = (const LAS unsigned short*)(L + TK2_IDX_OFF + r * TK2_IROW);
        unsigned kr[NJ], ir[NJ];
#pragma unroll
        for (int j = 0; j < NJ; ++j) { const int i = lane5 + 64 * j; const unsigned kv = keyr[i]; ir[j] = (unsigned)idxr[i]; kr[j] = i < m ? kv : 0u; }
        unsigned tau = 0u, X = 0xFFFFu, gt_thr = 0u; bool eq_en = true;
        if (m > 256) {
            unsigned mx = kr[0];
#pragma unroll
            for (int j = 1; j < NJ; ++j) mx = mx > kr[j] ? mx : kr[j];
            mx = wave_max_dpp(mx);
            const unsigned lo0 = (unsigned)__builtin_amdgcn_readfirstlane((int)sm[r]) << 20;
            const unsigned dmax = mx - lo0; unsigned prefix = 0u, exact_ge = 0u;
            if (dmax != 0u) {
                for (int bit = 31 - __builtin_clz(dmax); bit >= 0; --bit) {
                    const unsigned d = prefix | (1u << bit);
                    if (d > dmax) continue;
                    const unsigned cand = lo0 + d;
#if TK_BALLOT_STEP
                    unsigned long long mk[NJ];
#pragma unroll
                    for (int j = 0; j < NJ; ++j) mk[j] = __ballot(kr[j] >= cand);
                    __builtin_amdgcn_sched_barrier(0);
                    unsigned cnt = 0u;
#pragma unroll
                    for (int j = 0; j < NJ; ++j) cnt += (unsigned)__popcll(mk[j]);
#else
                    unsigned c = 0u;
#pragma unroll
                    for (int j = 0; j < NJ; ++j) c += kr[j] >= cand ? 1u : 0u;
                    const unsigned cnt = wave_sum_dpp(c);
#endif
                    if (cnt == 256u) { exact_ge = cand; break; }
                    if (cnt > 256u) prefix = d;
                }
            }
            tau = lo0 + prefix;
            if (exact_ge != 0u) { gt_thr = exact_ge - 1u; eq_en = false; }
            else {
                gt_thr = tau;
                unsigned c2 = 0u;
#pragma unroll
                for (int j = 0; j < NJ; ++j) { const bool in = lane5 + 64 * j < m; c2 += (kr[j] > tau ? 1u : 0u) + ((kr[j] == tau) & in ? 0x10000u : 0u); }
                const unsigned t2 = wave_sum_dpp(c2);
                const int need_eq = 256 - (int)(t2 & 0xFFFFu), ceq = (int)(t2 >> 16);
                if (need_eq < ceq) {
                    unsigned xp = 0u;
                    for (int bit = 11; bit >= 0; --bit) {
                        const unsigned cand = xp | (1u << bit);
                        unsigned c = 0u;
#pragma unroll
                        for (int j = 0; j < NJ; ++j) { const bool in = lane5 + 64 * j < m; c += ((kr[j] == tau) & (ir[j] < cand) & in) ? 1u : 0u; }
                        if ((int)wave_sum_dpp(c) < need_eq) xp = cand;
                    }
                    X = xp;
                }
            }
        }
        LAS unsigned short* lst = (LAS unsigned short*)(L + (dry ? TK_TRASH_OFF + 128 : r * TK2_KROW));
        LAS unsigned short* const trash16 = (LAS unsigned short*)(L + TK_TRASH_OFF) + lane5;
        unsigned tk = 0u, nt = 0u;
#pragma unroll
        for (int j = 0; j < NJ; ++j) {
            const bool in = lane5 + 64 * j < m;
            const bool take = in & ((kr[j] > gt_thr) | (eq_en & (kr[j] == tau) & (ir[j] <= X)));
            tk |= take ? (1u << j) : 0u; nt += take ? 1u : 0u;
        }
        unsigned pos = wave_excl_scan_dpp(nt, lane5);
#pragma unroll
        for (int j = 0; j < NJ; ++j) {
            const bool take = (tk >> j) & 1u;
            LAS unsigned short* pw = (take & (pos < 256u)) ? lst + pos : trash16; *pw = (unsigned short)ir[j]; pos += take ? 1u : 0u;
        }
    }
__device__ __forceinline__ void p3_topk(Frame& F, int qrep) {
    typedef pg8::bf16x8 bx8;
    LAS unsigned char* L = F.lds;
    LAS unsigned* sm = (LAS unsigned*)(L + TK_SM_OFF);
    const int tid = F.tid, wave = F.wave;
    const bf16* PA = (const bf16*)(F.ws + WS_PA); const bf16* KI = (const bf16*)(F.ws + WS_KI); const float* WI = (const float*)(F.ws + WS_WI);
    unsigned short* SELG = (unsigned short*)F.out;
    constexpr int NUNITS = NB * 120;
#if TKPROBE == 21
    unsigned probe_steps = 0u;
#endif
    for (;;) {
        __syncthreads();
        if (tid == 0) sm[161] = __hip_atomic_fetch_add(F.ctl + CW_QUEUE + 64 * qrep, 1u, RLX_AGENT);
        __syncthreads();
        const int u = __builtin_amdgcn_readfirstlane((int)sm[161]);
#if TKPROBE == 21
        if (u >= NUNITS) { if (F.lane == 0) (void)__hip_atomic_fetch_add(F.ctl + CW_QUEUE + 32, probe_steps, RLX_AGENT); }
#endif
        if (u >= NUNITS) break;
        const int qb = 127 - (u >> 3), b = u & 7, q0 = qb * 32, ntiles = qb + 1;
        int lane_p = F.lane; asm volatile("" : "+v"(lane_p));
        const int r32 = lane_p & 31, hi = lane_p >> 5;
        const int t = q0 + r32;
        const bf16* KIb = KI + (size_t)b * SEQ * 64;
        bx8 qf[4][4];
        { const bf16* qrow = PA + (size_t)(b * SEQ + t) * PA_LD + PA_QI + hi * 8;
#pragma unroll
          for (int h = 0; h < 4; ++h)
#pragma unroll
              for (int ks = 0; ks < 4; ++ks) qf[h][ks] = *(const GAS bx8*)(qrow + h * 64 + ks * 16); }
        const f32x4 wv = *(const GAS f32x4*)(WI + (size_t)(b * SEQ + t) * 4);
#ifndef TKPROBE
#define TKPROBE 0
#endif
#if TK_FAST
        {
            const int ns = ntiles > 24 ? (ntiles - 1) >> 3 : 0;
            bx8 sa0[4];
            { const int j0 = wave < ns ? wave : 0;
              const bf16* kp0 = KIb + (size_t)r32 * 64 + hi * 8;
#pragma unroll
              for (int ks = 0; ks < 4; ++ks) sa0[ks] = *(const GAS bx8*)(kp0 + (size_t)(8 * j0 + 7) * 32 * 64 + ks * 16); }
            for (int rp11 = 0; rp11 < (TKPROBE == 11 ? 2 : 1); ++rp11) {
            if (ns > 0) {
                for (int i = tid; i < (32 * 4112) / 16; i += NWAVES * 64) *(LAS v4u*)(L + i * 16) = (v4u){0u, 0u, 0u, 0u};
            }
            if (tid < 32) sm[tid] = 0u;
            if ((tid >= 128 && tid < 160) || tid == 162) sm[tid] = 0u;
            __syncthreads();
            if (ns > 0) {
                LAS unsigned char* hrow8 = L + r32 * TK_ROW;
                if (wave < ns) { unsigned keyv[16]; tk_keys(keyv, sa0, qf, wv);
#pragma unroll
                    for (int r = 0; r < 16; ++r) { const unsigned k = keyv[r]; lds_add((LAS unsigned*)(hrow8 + ((k >> 20) & 0xFFCu)), 1u << ((k >> 17) & 24u)); } }
                __builtin_amdgcn_sched_barrier(0);
                if (wave + 8 < ns) { unsigned keyv[16]; bx8 sa1[4];
                    { const bf16* kp1 = KIb + (size_t)r32 * 64 + hi * 8 + (size_t)(8 * (wave + 8) + 7) * 32 * 64;
#pragma unroll
                      for (int ks = 0; ks < 4; ++ks) sa1[ks] = *(const GAS bx8*)(kp1 + ks * 16); }
                    tk_keys(keyv, sa1, qf, wv);
#pragma unroll
                    for (int r = 0; r < 16; ++r) { const unsigned k = keyv[r]; lds_add((LAS unsigned*)(hrow8 + ((k >> 20) & 0xFFCu)), 1u << ((k >> 17) & 24u)); } }
                __syncthreads();
                int lane = F.lane; asm volatile("" : "+v"(lane));
#pragma unroll 1
                for (int qq = 0; qq < 4; ++qq) {
                    const int r = wave * 4 + qq;
                    unsigned T = (unsigned)ceilf((float)(TK2_TARGET * 32 * ns) / (float)(q0 + r + 1)); T = T < 1u ? 1u : T;
                    const LAS unsigned char* hr = L + r * TK_ROW + (1008 - 16 * lane) * 4;
                    v4u w[4];
#pragma unroll
                    for (int i = 0; i < 4; ++i) w[i] = *(const LAS v4u*)(hr + i * 16);
                    unsigned tot = 0u;
#pragma unroll
                    for (int i = 0; i < 4; ++i) { tot = __builtin_amdgcn_sad_u8(w[i].x, 0u, tot); tot = __builtin_amdgcn_sad_u8(w[i].y, 0u, tot); tot = __builtin_amdgcn_sad_u8(w[i].z, 0u, tot); tot = __builtin_amdgcn_sad_u8(w[i].w, 0u, tot); }
                    unsigned incl = tot;
#pragma unroll
                    for (int o = 1; o < 64; o <<= 1) { const unsigned v = __shfl_up(incl, o); if (lane >= o) incl += v; }
                    const unsigned excl = incl - tot;
                    unsigned c = excl, fcw = 0u, xw = 0u; int fw = -1;
#pragma unroll
                    for (int wi = 15; wi >= 0; --wi) {
                        const unsigned x = (wi & 3) == 0 ? w[wi >> 2].x : ((wi & 3) == 1 ? w[wi >> 2].y : ((wi & 3) == 2 ? w[wi >> 2].z : w[wi >> 2].w));
                        const unsigned sx = __builtin_amdgcn_sad_u8(x, 0u, 0u);
                        if (fw < 0 && c + sx >= T) { fw = wi; fcw = c; xw = x; }
                        c += sx;
                    }
                    c = fcw; int fb = -1;
#pragma unroll
                    for (int by = 3; by >= 0; --by) { const unsigned cnt = (xw >> (8 * by)) & 0xFFu; if (fb < 0 && c + cnt >= T) fb = by; c += cnt; }
                    if (excl < T && incl >= T) sm[r] = (unsigned)(4 * (1008 - 16 * lane + fw) + (fb < 0 ? 0 : fb));
                }
                __syncthreads();
            }
            }
            for (int rp12 = 0; rp12 < (TKPROBE == 12 ? 2 : 1); ++rp12) {
            if (rp12) { if (tid >= 128 && tid < 160) sm[tid] = 0u; __syncthreads(); }
            if (TK_PIPE) tk_pass_collect(L, KIb, ntiles, wave, r32, hi, lane_p, qf, wv, sm[r32]); else tk_pass<3>(L, KIb, ntiles, wave, r32, hi, lane_p, qf, wv, sm[r32]);
            __syncthreads();
            }
            {
                int lane5 = F.lane; asm volatile("" : "+v"(lane5));
#pragma unroll 1
                for (int qq5 = 0; qq5 < (TKPROBE == 13 ? 8 : 4); ++qq5) {
                    const int qq = qq5 & 3;
                    const int r = wave * 4 + qq;
                    const int m = (int)sm[128 + r];
                    if (m < 256 || m > TK2_CAP) { if (lane5 == 0) (void)__hip_atomic_fetch_or(sm + 162, 1u, __ATOMIC_RELAXED, __HIP_MEMORY_SCOPE_WORKGROUP); continue; }
                    const bool dry = TKPROBE == 13 && qq5 < 4;
                    if (m <= 576) tk2_select<9>(L, sm, r, m, lane5, dry); else tk2_select<12>(L, sm, r, m, lane5, dry);
}
            }
            __syncthreads();
            if (sm[162] == 0u) {
                int tid6 = F.tid; asm volatile("" : "+v"(tid6)); const int r = tid6 >> 4, c16 = (tid6 & 15) * 16;
                const LAS unsigned short* src = (const LAS unsigned short*)(L + r * TK2_KROW) + c16;
                const v4u v0 = *(const LAS v4u*)src, v1 = *(const LAS v4u*)(src + 8);
                unsigned short* dst = SELG + (size_t)(b * SEQ + q0 + r) * 256 + c16;
                *(GAS v4u*)dst = v0; *(GAS v4u*)(dst + 8) = v1;
                continue;
            }
#if TKPROBE == 9
            if (tid == 0) (void)__hip_atomic_fetch_add(F.ctl + CW_QUEUE + 32, 1u, RLX_AGENT);
#endif
        }
#endif

        for (int rep1 = 0; rep1 < (TKPROBE == 1 ? 2 : 1); ++rep1) {
        __syncthreads();
        for (int i = tid; i < (32 * 4112) / 16; i += NWAVES * 64) *(LAS v4u*)(L + i * 16) = (v4u){0u, 0u, 0u, 0u};
        if (tid >= 96 && tid < 161) sm[tid] = 0u;
        __syncthreads();
        tk_pass<1>(L, KIb, ntiles, wave, r32, hi, lane_p, qf, wv, 0u);
        __syncthreads();
        }
        int lane = F.lane; asm volatile("" : "+v"(lane));
#pragma unroll 1
        for (int qq3 = 0; qq3 < (TKPROBE == 2 ? 8 : 4); ++qq3) {
            const int qq = qq3 & 3; const int r = wave * 4 + qq;
            const LAS unsigned char* hr = L + r * TK_ROW + (1008 - 16 * lane) * 4;
            v4u w[4];
#pragma unroll
            for (int i = 0; i < 4; ++i) w[i] = *(const LAS v4u*)(hr + i * 16);
            unsigned tot = 0u;
#pragma unroll
            for (int i = 0; i < 4; ++i) { tot += (w[i].x & 0xffffu) + (w[i].x >> 16); tot += (w[i].y & 0xffffu) + (w[i].y >> 16); tot += (w[i].z & 0xffffu) + (w[i].z >> 16); tot += (w[i].w & 0xffffu) + (w[i].w >> 16); }
            unsigned incl = tot;
#pragma unroll
            for (int o = 1; o < 64; o <<= 1) { const unsigned v = __shfl_up(incl, o); if (lane >= o) incl += v; }
            const unsigned excl = incl - tot;
            unsigned c = excl; int fb = -1; unsigned fc = 0u, fm = 0u;
#pragma unroll
            for (int wi = 15; wi >= 0; --wi) {
                const unsigned x = (wi & 3) == 0 ? w[wi >> 2].x : ((wi & 3) == 1 ? w[wi >> 2].y : ((wi & 3) == 2 ? w[wi >> 2].z : w[wi >> 2].w));
                const int bin0 = 2 * (1008 - 16 * lane + wi);
                unsigned cnt = x >> 16;
                if (fb < 0 && c + cnt >= 256u) { fb = bin0 + 1; fc = c; fm = cnt; }
                c += cnt; cnt = x & 0xffffu;
                if (fb < 0 && c + cnt >= 256u) { fb = bin0; fc = c; fm = cnt; }
                c += cnt;
            }
            if (excl < 256u && incl >= 256u) { sm[r] = (unsigned)fb; sm[32 + r] = fc; sm[64 + r] = fm; if (fm > (unsigned)TK_CAP) (void)__hip_atomic_fetch_or(sm + 160, 1u << r, __ATOMIC_RELAXED, __HIP_MEMORY_SCOPE_WORKGROUP); }
        }
        __syncthreads();
        for (int rep2 = 0; rep2 < (TKPROBE == 3 ? 2 : 1); ++rep2) {
        if (rep2) { if (tid >= 96 && tid < 160) sm[tid] = 0u; __syncthreads(); }
        tk_pass<2>(L, KIb, ntiles, wave, r32, hi, lane_p, qf, wv, sm[r32]);
        __syncthreads();
        }
        int lane5 = F.lane; asm volatile("" : "+v"(lane5));
        const unsigned long long lt_mask = (lane5 == 0) ? 0ull : (~0ull >> (64 - lane5));
#pragma unroll 1
        for (int qq5 = 0; qq5 < (TKPROBE == 4 ? 8 : 4); ++qq5) {
            const int qq = qq5 & 3; const int r = wave * 4 + qq;
            const unsigned m0 = sm[128 + r]; const int m = (int)(m0 < (unsigned)TK_CAP ? m0 : (unsigned)TK_CAP);
            const int cab = (int)sm[32 + r], need2 = 256 - cab; const unsigned bst = sm[r];
            if (m0 > (unsigned)TK_CAP) continue;
            const LAS unsigned long long* cd = (const LAS unsigned long long*)(L + r * TK_CROW);
            LAS unsigned short* selr = (LAS unsigned short*)(L + TK_SEL_OFF) + r * 256;
            unsigned kr[8], ir[8];
#pragma unroll
            for (int j = 0; j < 8; ++j) { const int i = lane5 + 64 * j; const unsigned long long e = i < m ? cd[i] : 0ull; kr[j] = (unsigned)(e >> 32); ir[j] = (unsigned)e & 0xFFFFu; }
            unsigned tau = 0u, X = 0xFFFFu, exact_ge = 0u;
            if (need2 < m) {
                unsigned prefix = bst << 21;
                for (int bit = 20; bit >= 0; --bit) {
                    const unsigned cand = prefix | (1u << bit);
                    int cnt = 0;
#pragma unroll
                    for (int j = 0; j < 8; ++j) cnt += __popcll(__ballot(kr[j] >= cand));
                    if (cnt == need2) { exact_ge = cand; break; }
                    if (cnt > need2) prefix = cand;
                }
                tau = prefix;
                int cgt = 0, ceq = 0;
#pragma unroll
                for (int j = 0; j < 8; ++j) { cgt += __popcll(__ballot(kr[j] > tau)); ceq += __popcll(__ballot(kr[j] == tau && lane5 + 64 * j < m)); }
                const int need_eq = need2 - cgt;
                if (exact_ge == 0u && need_eq < ceq) {
                    unsigned xp = 0u;
                    for (int bit = 11; bit >= 0; --bit) {
                        const unsigned cand = xp | (1u << bit);
                        int cnt = 0;
#pragma unroll
                        for (int j = 0; j < 8; ++j) cnt += __popcll(__ballot(kr[j] == tau && ir[j] < cand && lane5 + 64 * j < m));
                        if (cnt < need_eq) xp = cand;
                    }
                    X = xp;
                }
            }
            int base = cab;
#pragma unroll
            for (int j = 0; j < 8; ++j) {
                const bool in = lane5 + 64 * j < m;
                const bool take = in && (need2 >= m || (exact_ge != 0u ? kr[j] >= exact_ge : (kr[j] > tau || (kr[j] == tau && ir[j] <= X))));
                const unsigned long long bs = __ballot(take);
                const int pos = base + __popcll(bs & lt_mask);
                if (take && pos < 256) selr[pos] = (unsigned short)ir[j];
                base += __popcll(bs);
            }
        }
        __syncthreads();
        { int tid6 = F.tid; asm volatile("" : "+v"(tid6)); const int r = tid6 >> 4, c16 = (tid6 & 15) * 16;
          const LAS unsigned short* src = (const LAS unsigned short*)(L + TK_SEL_OFF) + r * 256 + c16;
          const v4u v0 = *(const LAS v4u*)src, v1 = *(const LAS v4u*)(src + 8);
          unsigned short* dst = SELG + (size_t)(b * SEQ + q0 + r) * 256 + c16;
          *(GAS v4u*)dst = v0; *(GAS v4u*)(dst + 8) = v1; }
        const unsigned slowmask = sm[160];
        if (slowmask) {
            asm volatile("s_waitcnt vmcnt(0)" ::: "memory"); __syncthreads();
            for (int r = wave; r < 32; r += 8) if ((slowmask >> r) & 1u) slow_select(F, b * SEQ + q0 + r, (LAS unsigned*)(L + wave * 16384), SELG + (size_t)(b * SEQ + q0 + r) * 256);
        }
    }
}

constexpr int AT_WAVE_LDS = 17408;
static_assert(8 * AT_WAVE_LDS <= PHASE_LDS, "attention LDS map");
typedef float f32x2_t __attribute__((ext_vector_type(2)));
template <bool HI> __device__ __forceinline__ unsigned fp8x2_to_bf16x2(int w) { const f32x2_t f = __builtin_amdgcn_cvt_pk_f32_fp8(w, HI);
    return pg8::cvt_pk_bf16(f.x, f.y); }
__device__ __forceinline__ void p4_attn(Frame& F) {
    typedef pg8::bf16x8 bx8;
    const int lane = F.lane, n16 = lane & 15, kg = lane >> 4;
    LAS unsigned char* wl = F.lds + F.wave * AT_WAVE_LDS;
    LAS unsigned short* sl = (LAS unsigned short*)(wl + 16384);
    const bf16* PA = (const bf16*)(F.ws + WS_PA); const unsigned char* KV = (const unsigned char*)F.out + OUT_KV; bf16* ATT = (bf16*)((unsigned char*)F.out + OUT_ARN);
    const unsigned short* SELG = (const unsigned short*)F.out;
    const int gw = F.vcu * NWAVES + F.wave, NGW = F.G * NWAVES;
    const int nq_per = (M + NGW - 1) / NGW;
    const float c2 = 0.125f * 1.4426950408889634f;
    const float mref = ((const float*)(F.ws + WS_GAINS))[192] * 8.0f; const float nmc = -mref * (0.125f * 1.4426950408889634f);
    const int trow = 4 * kg + (n16 >> 2), tx = trow & 7;
    const int trbase = trow * 256 + (n16 & 3) * 8;
    const int vkey = lane >> 3, c8 = lane & 7;
    unsigned long long lnext = 0ull;
    if (gw < M && (gw % SEQ) >= TOPK) lnext = *(const GAS unsigned long long*)(SELG + (size_t)gw * 256 + lane * 4);
#pragma unroll 1
    for (int it = 0; it < nq_per; ++it) {
        int qidx;
        if (NGW == 2048) { const int b_ = it >> 1; const int t_ = (it & 1) ? (SEQ - 1 - gw) : gw; qidx = b_ * SEQ + t_; }
        else { qidx = gw + it * NGW; if (qidx >= M) break; }
        int qn = M;
        if (it + 1 < nq_per) { if (NGW == 2048) { const int b_ = (it + 1) >> 1; const int t_ = ((it + 1) & 1) ? (SEQ - 1 - gw) : gw; qn = b_ * SEQ + t_; } else qn = gw + (it + 1) * NGW; }
        const bool qn_list = qn < M && (qn % SEQ) >= TOPK;
        const int b = qidx / SEQ, t = qidx % SEQ, cnt = (t + 1 < TOPK) ? t + 1 : TOPK;
        const GAS unsigned char* kvb = (const GAS unsigned char*)(KV + (size_t)b * SEQ * 256);
        if (t >= TOPK) { *(LAS unsigned long long*)(sl + lane * 4) = lnext; }
        else {
#pragma unroll
            for (int i = 0; i < 4; ++i) { const int j = lane * 4 + i; sl[j] = (unsigned short)(j <= t ? j : t); }
        }
        asm volatile("" ::: "memory");
        v4u vr[2][4];
#pragma unroll
        for (int c = 0; c < 2; ++c)
#pragma unroll
            for (int i = 0; i < 4; ++i) { const unsigned off = (unsigned)sl[32 * c + 8 * i + vkey] * 256u + 128u + (unsigned)c8 * 16u; vr[c][i] = *(const GAS v4u*)(kvb + off); }
        long qb[4];
        { long q0 = 0, q1 = 0;
          if (n16 < 8) { const v4u ua = *(const GAS v4u*)(PA + (size_t)qidx * PA_LD + n16 * 64 + kg * 16), ub = *(const GAS v4u*)(PA + (size_t)qidx * PA_LD + n16 * 64 + kg * 16 + 8);
              int w0 = __builtin_amdgcn_cvt_pk_fp8_f32(bflo(ua.x), bfhi(ua.x), 0, false); w0 = __builtin_amdgcn_cvt_pk_fp8_f32(bflo(ua.y), bfhi(ua.y), w0, true);
              int w1 = __builtin_amdgcn_cvt_pk_fp8_f32(bflo(ua.z), bfhi(ua.z), 0, false); w1 = __builtin_amdgcn_cvt_pk_fp8_f32(bflo(ua.w), bfhi(ua.w), w1, true);
              int w2 = __builtin_amdgcn_cvt_pk_fp8_f32(bflo(ub.x), bfhi(ub.x), 0, false); w2 = __builtin_amdgcn_cvt_pk_fp8_f32(bflo(ub.y), bfhi(ub.y), w2, true);
              int w3 = __builtin_amdgcn_cvt_pk_fp8_f32(bflo(ub.z), bfhi(ub.z), 0, false); w3 = __builtin_amdgcn_cvt_pk_fp8_f32(bflo(ub.w), bfhi(ub.w), w3, true);
              q0 = (long)((unsigned long long)(unsigned)w0 | ((unsigned long long)(unsigned)w1 << 32)); q1 = (long)((unsigned long long)(unsigned)w2 | ((unsigned long long)(unsigned)w3 << 32)); }
          const bool g1 = (n16 >> 2) == 1;
          qb[0] = g1 ? 0 : q0; qb[1] = g1 ? 0 : q1; qb[2] = g1 ? q0 : 0; qb[3] = g1 ? q1 : 0; }
        v4u ka[8][2];
#pragma unroll
        for (int T = 0; T < 7; ++T) { const unsigned off = (unsigned)sl[16 * T + n16] * 256u + (unsigned)kg * 16u;
            ka[T][0] = *(const GAS v4u*)(kvb + off); ka[T][1] = *(const GAS v4u*)(kvb + off + 64); }
        float sum = 0.f;
        bx8 pfr[8];
#pragma unroll
        for (int KS = 0; KS < 8; ++KS) {
            v4u pw;
#pragma unroll
            for (int half = 0; half < 2; ++half) { const int T = 2 * KS + half;
                asm volatile("" ::: "memory");
                if (T + 7 < 16) { const unsigned off = (unsigned)sl[16 * (T + 7) + n16] * 256u + (unsigned)kg * 16u;
                    ka[(T + 7) & 7][0] = *(const GAS v4u*)(kvb + off); ka[(T + 7) & 7][1] = *(const GAS v4u*)(kvb + off + 64); }
                f32x4 s = (f32x4){0.f, 0.f, 0.f, 0.f};
#pragma unroll
                for (int g = 0; g < 2; ++g) { const v4u kk = ka[T & 7][g];
                    const long a0 = (long)((unsigned long long)kk.x | ((unsigned long long)kk.y << 32)), a1 = (long)((unsigned long long)kk.z | ((unsigned long long)kk.w << 32));
                    s = __builtin_amdgcn_mfma_f32_16x16x32_fp8_fp8(a0, qb[2 * g], s, 0, 0, 0);
                    s = __builtin_amdgcn_mfma_f32_16x16x32_fp8_fp8(a1, qb[2 * g + 1], s, 0, 0, 0); }
                float pv4[4];
#pragma unroll
                for (int r = 0; r < 4; ++r) pv4[r] = __builtin_amdgcn_exp2f(__builtin_fmaf(s[r], c2, nmc));
                if (16 * T + 16 > cnt) {
#pragma unroll
                    for (int r = 0; r < 4; ++r) pv4[r] = (16 * T + 4 * kg + r < cnt) ? pv4[r] : 0.f; }
#pragma unroll
                for (int r = 0; r < 4; ++r) sum += pv4[r];
                if (half == 0) { pw.x = pg8::cvt_pk_bf16(pv4[0], pv4[1]); pw.y = pg8::cvt_pk_bf16(pv4[2], pv4[3]); } else { pw.z = pg8::cvt_pk_bf16(pv4[0], pv4[1]); pw.w = pg8::cvt_pk_bf16(pv4[2], pv4[3]); }
            }
            pfr[KS] = __builtin_bit_cast(bx8, pw); asm volatile("" : "+v"(pfr[KS]));
        }
        sum += __shfl_xor(sum, 16); sum += __shfl_xor(sum, 32);
        asm volatile("" ::: "memory");
        f32x4 O[8];
#pragma unroll
        for (int i = 0; i < 8; ++i) O[i] = (f32x4){0.f, 0.f, 0.f, 0.f};
#pragma unroll
        for (int KS = 0; KS < 8; ++KS) {
            LAS unsigned char* buf = wl + (KS & 1) * 8192;
            asm volatile("" ::: "memory");
#pragma unroll
            for (int i = 0; i < 4; ++i) { const int rowl = 8 * i + vkey; const v4u w = vr[KS & 1][i];
                v4u lo, hi4;
                lo.x = fp8x2_to_bf16x2<false>((int)w.x); lo.y = fp8x2_to_bf16x2<true>((int)w.x); lo.z = fp8x2_to_bf16x2<false>((int)w.y); lo.w = fp8x2_to_bf16x2<true>((int)w.y);
                hi4.x = fp8x2_to_bf16x2<false>((int)w.z); hi4.y = fp8x2_to_bf16x2<true>((int)w.z); hi4.z = fp8x2_to_bf16x2<false>((int)w.w); hi4.w = fp8x2_to_bf16x2<true>((int)w.w);
                LAS unsigned char* rp = buf + rowl * 256 + ((c8 * 32) ^ ((rowl & 7) << 5));
                *(LAS v4u*)rp = lo; *(LAS v4u*)(rp + 16) = hi4; }
            if (KS + 2 < 8) {
#pragma unroll
                for (int i = 0; i < 4; ++i) { const unsigned off = (unsigned)sl[32 * (KS + 2) + 8 * i + vkey] * 256u + 128u + (unsigned)c8 * 16u; vr[KS & 1][i] = *(const GAS v4u*)(kvb + off); }
            }
            if (KS == 5 && qn_list) lnext = *(const GAS unsigned long long*)(SELG + (size_t)qn * 256 + lane * 4);
            const bx8 pf = pfr[KS];
#pragma unroll
            for (int gd = 0; gd < 8; ++gd) {
                const LAS unsigned char* p0 = buf + trbase + ((gd ^ tx) << 5);
                const v4i16_t lo = __builtin_amdgcn_ds_read_tr16_b64_v4i16((LAS v4i16_t*)p0);
                const v4i16_t hi4 = __builtin_amdgcn_ds_read_tr16_b64_v4i16((LAS v4i16_t*)(p0 + 4096));
                const bx8 vf = (bx8){lo[0], lo[1], lo[2], lo[3], hi4[0], hi4[1], hi4[2], hi4[3]};
                O[gd] = __builtin_amdgcn_mfma_f32_16x16x32_bf16(pf, vf, O[gd], 0, 0, 0);
            }
        }
        float inv[4];
#pragma unroll
        for (int r = 0; r < 4; ++r) inv[r] = 1.0f / __shfl(sum, (4 * kg + r) & 15);
        if (kg < 2) {
            bf16* orow = ATT + (size_t)qidx * 1536 + (4 * kg) * 64 + n16;
#pragma unroll
            for (int db = 0; db < 4; ++db)
#pragma unroll
                for (int r = 0; r < 4; ++r) { const float v = (kg == 0 ? O[db][r] : O[4 + db][r]) * inv[r]; orow[r * 64 + db * 16] = (bf16)f2bf(v); }
        }
    }
}
constexpr int RG_WT_PITCH = 144;
constexpr int RG_WA_OFF = 0, RG_WX_OFF = 32 * RG_WT_PITCH, RG_XCB_OFF = 2 * 32 * RG_WT_PITCH, RG_XF_OFF = RG_XCB_OFF + 128 * RG_WT_PITCH, RG_CARR_OFF = RG_XF_OFF + 128 * 256;
constexpr int RG_STG_OFF = RG_CARR_OFF + 2 * 8 * 2 * 32 * 4, RG_STG_WAVE = 24 * 128 + 1024 + 1024;
static_assert(RG_STG_OFF + 8 * RG_STG_WAVE <= PHASE_LDS, "rg-lru LDS map");
__device__ __forceinline__ float fast_sigmoid(float x) { return __builtin_amdgcn_rcpf(1.0f + __builtin_amdgcn_exp2f(-1.4426950408889634f * x)); }
__device__ __forceinline__ void p4_rglru(Frame& F) {
    typedef pg8::bf16x8 bx8;
    const int tid = F.tid, lane = F.lane, wave = F.wave, n16 = lane & 15, kg = lane >> 4;
    LAS unsigned char* L = F.lds;
    LAS float* Xf = (LAS float*)(L + RG_XF_OFF); LAS float* carr = (LAS float*)(L + RG_CARR_OFF);
    const bf16* RX = (const bf16*)(F.ws + WS_RX); const bf16* RG = (const bf16*)(F.ws + WS_RGATE); bf16* RNN = (bf16*)((unsigned char*)F.out + OUT_ARN) + 512;
    const float* conv_w = F.in[6]; const float* conv_b = F.in[7]; const float* rg_wa = F.in[8]; const float* rg_ba = F.in[9]; const float* rg_wx = F.in[10]; const float* rg_bx = F.in[11]; const float* lam = F.in[12];
    for (int task = F.vcu; task < NB * 32; task += F.G) {
        const int b = task >> 5, nb = (task >> 1) & 15, hf = task & 1, c0 = nb * 64, e0 = 32 * hf;
        __syncthreads();
        for (int i = tid; i < 2048; i += NWAVES * 64) { const int d = i >> 5, e = i & 31;
            *(LAS bf16*)(L + RG_WA_OFF + e * RG_WT_PITCH + d * 2) = (bf16)f2bf(rg_wa[(size_t)nb * 4096 + d * 64 + e0 + e]);
            *(LAS bf16*)(L + RG_WX_OFF + e * RG_WT_PITCH + d * 2) = (bf16)f2bf(rg_wx[(size_t)nb * 4096 + d * 64 + e0 + e]); }
        const int c = c0 + lane;
        const float cw0 = conv_w[c], cw1 = conv_w[1024 + c], cw2 = conv_w[2048 + c], cw3 = conv_w[3072 + c], cb = conv_b[c];
        float bav[2], bxv[2], lsl[2];
#pragma unroll
        for (int j = 0; j < 2; ++j) { const int ce = c0 + e0 + 16 * j + n16; bav[j] = rg_ba[ce]; bxv[j] = rg_bx[ce]; lsl[j] = -8.0f * 1.4426950408889634f * log1pf(__expf(-lam[ce])); }
        float hst[2] = {0.f, 0.f};
        __syncthreads();
        LAS unsigned char* stg = L + RG_STG_OFF + wave * RG_STG_WAVE;
        const int xr_row = lane >> 3, xr_c8 = lane & 7, gt_tok = lane >> 2, gt_c8 = lane & 3;
        v4u xq[3][3], gq[3];
#pragma unroll
        for (int pc = 0; pc < 3; ++pc) { const int t0 = pc * 128 + wave * 16; const size_t rowb = (size_t)b * SEQ + t0;
#pragma unroll
            for (int i = 0; i < 3; ++i) { const int ri = 8 * i + xr_row, t = t0 - 3 + ri; xq[pc][i] = (v4u){0u, 0u, 0u, 0u};
                if (ri < 19 && t >= 0) xq[pc][i] = *(const GAS v4u*)(RX + (rowb - 3 + ri) * 1024 + c0 + xr_c8 * 8); }
            gq[pc] = *(const GAS v4u*)(RG + (rowb + gt_tok) * 1024 + c0 + e0 + gt_c8 * 8); }
#pragma unroll 1
        for (int ch = 0; ch < SEQ / 128; ++ch) {
            const int t0 = ch * 128 + wave * 16;
            const size_t rowb = (size_t)b * SEQ + t0;
#pragma unroll
            for (int i = 0; i < 3; ++i) *(LAS v4u*)(stg + (8 * i + xr_row) * 128 + xr_c8 * 16) = xq[0][i];
            *(LAS v4u*)(stg + 24 * 128 + gt_tok * 64 + gt_c8 * 16) = gq[0];
#pragma unroll
            for (int i = 0; i < 3; ++i) { xq[0][i] = xq[1][i]; xq[1][i] = xq[2][i]; }
            gq[0] = gq[1]; gq[1] = gq[2];
            if (ch + 3 < SEQ / 128) {
#pragma unroll
                for (int i = 0; i < 3; ++i) { const int ri = 8 * i + xr_row; if (ri < 19) xq[2][i] = *(const GAS v4u*)(RX + (rowb + 384 - 3 + ri) * 1024 + c0 + xr_c8 * 8); }
                gq[2] = *(const GAS v4u*)(RG + (rowb + 384 + gt_tok) * 1024 + c0 + e0 + gt_c8 * 8);
            }
            asm volatile("s_waitcnt lgkmcnt(0)" ::: "memory");
            float xv[19];
#pragma unroll
            for (int i = 0; i < 19; ++i) xv[i] = bf2f(*(const LAS unsigned short*)(stg + i * 128 + lane * 2));
#pragma unroll
            for (int i = 0; i < 16; ++i) { const float x = cb + cw0 * xv[i] + cw1 * xv[i + 1] + cw2 * xv[i + 2] + cw3 * xv[i + 3];
                Xf[(wave * 16 + i) * 64 + lane] = x; *(LAS bf16*)(L + RG_XCB_OFF + (wave * 16 + i) * RG_WT_PITCH + lane * 2) = (bf16)f2bf(x); }
            float gcur[2][4];
#pragma unroll
            for (int j = 0; j < 2; ++j)
#pragma unroll
                for (int r = 0; r < 4; ++r) gcur[j][r] = bf2f(*(const LAS unsigned short*)(stg + 24 * 128 + (4 * kg + r) * 64 + (16 * j + n16) * 2));
            asm volatile("s_waitcnt lgkmcnt(0)" ::: "memory");
            bx8 af[2];
#pragma unroll
            for (int ks = 0; ks < 2; ++ks) af[ks] = *(const LAS bx8*)(L + RG_XCB_OFF + (wave * 16 + n16) * RG_WT_PITCH + (32 * ks + 8 * kg) * 2);
            float av[2][4], bv[2][4], Pl[2], Hl[2];
#pragma unroll
            for (int j = 0; j < 2; ++j) {
                f32x4 cr = (f32x4){0.f, 0.f, 0.f, 0.f}, ci = (f32x4){0.f, 0.f, 0.f, 0.f};
#pragma unroll
                for (int ks = 0; ks < 2; ++ks) {
                    const bx8 wa_f = *(const LAS bx8*)(L + RG_WA_OFF + (16 * j + n16) * RG_WT_PITCH + (32 * ks + 8 * kg) * 2);
                    const bx8 wx_f = *(const LAS bx8*)(L + RG_WX_OFF + (16 * j + n16) * RG_WT_PITCH + (32 * ks + 8 * kg) * 2);
                    cr = __builtin_amdgcn_mfma_f32_16x16x32_bf16(af[ks], wa_f, cr, 0, 0, 0);
                    ci = __builtin_amdgcn_mfma_f32_16x16x32_bf16(af[ks], wx_f, ci, 0, 0, 0);
                }
                float p = 1.f, h = 0.f;
#pragma unroll
                for (int r = 0; r < 4; ++r) {
                    const float rr = fast_sigmoid(cr[r] + bav[j]), ig = fast_sigmoid(ci[r] + bxv[j]);
                    const float l2 = rr * lsl[j];
                    const float a = __builtin_amdgcn_exp2f(l2);
                    const float x2 = l2 * 1.3862943611198906f;
                    const float oma = x2 > -0.0625f ? -x2 * (1.0f + x2 * (0.5f + x2 * (0.16666667f + x2 * 0.041666668f))) : 1.0f - a * a;
                    const float xcv = Xf[(wave * 16 + 4 * kg + r) * 64 + e0 + 16 * j + n16];
                    const float bb = __builtin_amdgcn_sqrtf(oma) * (ig * xcv);
                    av[j][r] = a; bv[j][r] = bb; h = a * h + bb; p *= a;
                }
                Pl[j] = p; Hl[j] = h;
            }
            float Pe[2], He[2];
#pragma unroll
            for (int j = 0; j < 2; ++j) {
                float P = Pl[j], H = Hl[j];
                { const float p1 = __shfl_up(P, 16), h1 = __shfl_up(H, 16); if (kg >= 1) { H = P * h1 + H; P = P * p1; } }
                { const float p2 = __shfl_up(P, 32), h2 = __shfl_up(H, 32); if (kg >= 2) { H = P * h2 + H; P = P * p2; } }
                const float pe = __shfl_up(P, 16), he = __shfl_up(H, 16);
                Pe[j] = kg >= 1 ? pe : 1.f; He[j] = kg >= 1 ? he : 0.f;
                if (kg == 3) { LAS float* cw_ = carr + (ch & 1) * 512 + wave * 64 + j * 32; cw_[n16] = P; cw_[16 + n16] = H; }
            }
            __syncthreads();
#pragma unroll
            for (int j = 0; j < 2; ++j) {
                const LAS float* cr_ = carr + (ch & 1) * 512 + j * 32;
                float cin = 0.f, cc = hst[j];
#pragma unroll
                for (int w2 = 0; w2 < 8; ++w2) { if (w2 == wave) cin = cc; cc = cr_[w2 * 64 + n16] * cc + cr_[w2 * 64 + 16 + n16]; }
                hst[j] = cc;
                float h = Pe[j] * cin + He[j];
#pragma unroll
                for (int r = 0; r < 4; ++r) { h = av[j][r] * h + bv[j][r];
                    const float g = gcur[j][r]; const float u = 0.7978845608028654f * (g + 0.044715f * g * g * g);
                    *(LAS bf16*)(stg + 24 * 128 + 1024 + (4 * kg + r) * 64 + (16 * j + n16) * 2) = (bf16)f2bf(h * (g * fast_sigmoid(2.0f * u))); }
            }
            asm volatile("s_waitcnt lgkmcnt(0)" ::: "memory");
            { const v4u o = *(const LAS v4u*)(stg + 24 * 128 + 1024 + gt_tok * 64 + gt_c8 * 16);
              *(GAS v4u*)(RNN + (rowb + gt_tok) * 1536 + c0 + e0 + gt_c8 * 8) = o; }
        }
    }
}

constexpr int RG2_XCB_OFF = 2 * 32 * RG_WT_PITCH, RG2_XF_OFF = RG2_XCB_OFF + 256 * RG_WT_PITCH, RG2_CARR_OFF = RG2_XF_OFF + 256 * 128;
constexpr int RG2_STG_OFF = RG2_CARR_OFF + 2 * 8 * 2 * 32 * 4, RG2_STG_WAVE = 35 * 128 + 2048 + 2048;
static_assert(RG2_STG_OFF + 8 * RG2_STG_WAVE <= PHASE_LDS, "rg-lru LDS map");
__device__ __forceinline__ unsigned rg_cvt_pk(float lo, float hi) { unsigned r; asm("v_cvt_pk_bf16_f32 %0, %1, %2" : "=v"(r) : "v"(lo), "v"(hi)); return r; }
__device__ __forceinline__ void p4_rglru2(Frame& F) {
    typedef pg8::bf16x8 bx8;
    const int tid = F.tid, lane = F.lane, wave = F.wave, n16 = lane & 15, kg = lane >> 4;
    LAS unsigned char* L = F.lds;
    LAS float* Xf = (LAS float*)(L + RG2_XF_OFF); LAS float* carr = (LAS float*)(L + RG2_CARR_OFF);
    const bf16* RX = (const bf16*)(F.ws + WS_RX); const bf16* RG = (const bf16*)(F.ws + WS_RGATE); bf16* RNN = (bf16*)((unsigned char*)F.out + OUT_ARN) + 512;
    const float* conv_w = F.in[6]; const float* conv_b = F.in[7]; const float* rg_wa = F.in[8]; const float* rg_ba = F.in[9]; const float* rg_wx = F.in[10]; const float* rg_bx = F.in[11]; const float* lam = F.in[12];
    for (int task = F.vcu; task < NB * 32; task += F.G) {
        const int b = task >> 5, nb = (task >> 1) & 15, hf = task & 1, c0 = nb * 64, e0 = 32 * hf;
        __syncthreads();
        for (int i = tid; i < 2048; i += NWAVES * 64) { const int d = i >> 5, e = i & 31;
            *(LAS bf16*)(L + RG_WA_OFF + e * RG_WT_PITCH + d * 2) = (bf16)f2bf(rg_wa[(size_t)nb * 4096 + d * 64 + e0 + e]);
            *(LAS bf16*)(L + RG_WX_OFF + e * RG_WT_PITCH + d * 2) = (bf16)f2bf(rg_wx[(size_t)nb * 4096 + d * 64 + e0 + e]); }
        const int c = c0 + lane;
        const float cw0 = conv_w[c], cw1 = conv_w[1024 + c], cw2 = conv_w[2048 + c], cw3 = conv_w[3072 + c], cb = conv_b[c];
        const bool mine = (lane >> 5) == hf;
        float bav[2], bxv[2], lsl[2];
#pragma unroll
        for (int j = 0; j < 2; ++j) { const int ce = c0 + e0 + 16 * j + n16; bav[j] = rg_ba[ce]; bxv[j] = rg_bx[ce]; lsl[j] = -8.0f * 1.4426950408889634f * log1pf(__expf(-lam[ce])); }
        float hst[2] = {0.f, 0.f};
        const float nba[2] = {-1.4426950408889634f * bav[0], -1.4426950408889634f * bav[1]}, nbx[2] = {-1.4426950408889634f * bxv[0], -1.4426950408889634f * bxv[1]};
        __syncthreads();
        LAS unsigned char* stg = L + RG2_STG_OFF + wave * RG2_STG_WAVE;
        LAS float* xf_w = Xf + (wave * 32) * 32 + (lane & 31); LAS unsigned char* xcb_w = L + RG2_XCB_OFF + (wave * 32) * RG_WT_PITCH + lane * 2;
        asm volatile("" : "+v"(xf_w), "+v"(xcb_w));
        const int xr_row = lane >> 3, xr_c8 = lane & 7, gt_tok = lane >> 2, gt_c8 = lane & 3;
        v4u xq[2][5], gq[2][2];
        const GAS unsigned char* rxb = (const GAS unsigned char*)(RX + (size_t)b * SEQ * 1024 + c0); const GAS unsigned char* rgb = (const GAS unsigned char*)(RG + (size_t)b * SEQ * 1024 + c0 + e0);
        GAS unsigned char* rnb = (GAS unsigned char*)(RNN + (size_t)b * SEQ * 1536 + c0 + e0);
        const unsigned xoff = (unsigned)(xr_row * 1024 + xr_c8 * 8) * 2u, goff = (unsigned)(gt_tok * 1024 + gt_c8 * 8) * 2u, ooff = (unsigned)(gt_tok * 1536 + gt_c8 * 8) * 2u;
#pragma unroll
        for (int pc = 0; pc < 2; ++pc) { const int t0 = pc * 256 + wave * 32;
#pragma unroll
            for (int i = 0; i < 5; ++i) { const int ri = 8 * i + xr_row, t = t0 - 3 + ri; xq[pc][i] = (v4u){0u, 0u, 0u, 0u};
                if (ri < 35 && t >= 0) xq[pc][i] = *(const GAS v4u*)(rxb + (unsigned)((t0 - 3 + 8 * i) * 2048 + (int)xoff)); }
#pragma unroll
            for (int i = 0; i < 2; ++i) gq[pc][i] = *(const GAS v4u*)(rgb + (unsigned)((t0 + 16 * i) * 2048 + (int)goff)); }
#pragma unroll 1
        for (int ch = 0; ch < SEQ / 256; ++ch) {
            const int t0 = ch * 256 + wave * 32;
#pragma unroll
            for (int i = 0; i < 5; ++i) { if (8 * i + xr_row < 35) *(LAS v4u*)(stg + (8 * i + xr_row) * 128 + xr_c8 * 16) = xq[0][i]; }
#pragma unroll
            for (int i = 0; i < 2; ++i) *(LAS v4u*)(stg + 35 * 128 + (16 * i + gt_tok) * 64 + gt_c8 * 16) = gq[0][i];
#pragma unroll
            for (int i = 0; i < 5; ++i) xq[0][i] = xq[1][i];
            gq[0][0] = gq[1][0]; gq[0][1] = gq[1][1];
            if (ch + 2 < SEQ / 256) {
#pragma unroll
                for (int i = 0; i < 5; ++i) { const int ri = 8 * i + xr_row; if (ri < 35) xq[1][i] = *(const GAS v4u*)(rxb + (unsigned)((t0 + 512 - 3 + 8 * i) * 2048 + (int)xoff)); }
#pragma unroll
                for (int i = 0; i < 2; ++i) gq[1][i] = *(const GAS v4u*)(rgb + (unsigned)((t0 + 512 + 16 * i) * 2048 + (int)goff));
            }
            asm volatile("s_waitcnt lgkmcnt(0)" ::: "memory");
            { float xv[35];
#pragma unroll
              for (int i = 0; i < 35; ++i) xv[i] = bf2f(*(const LAS unsigned short*)(stg + i * 128 + lane * 2));
              float xo[32];
#pragma unroll
              for (int i = 0; i < 32; i += 2) { xo[i] = cb + cw0 * xv[i] + cw1 * xv[i + 1] + cw2 * xv[i + 2] + cw3 * xv[i + 3]; xo[i + 1] = cb + cw0 * xv[i + 1] + cw1 * xv[i + 2] + cw2 * xv[i + 3] + cw3 * xv[i + 4];
                  const unsigned pk = pg8::cvt_pk_bf16(xo[i], xo[i + 1]);
                  *(LAS bf16*)(xcb_w + i * RG_WT_PITCH) = (bf16)(pk & 0xFFFFu); *(LAS bf16*)(xcb_w + (i + 1) * RG_WT_PITCH) = (bf16)(pk >> 16); }
              if (mine) {
#pragma unroll
                  for (int i = 0; i < 32; ++i) xf_w[i * 32] = xo[i]; } }
            float gcur[2][2][4];
#pragma unroll
            for (int s = 0; s < 2; ++s)
#pragma unroll
                for (int j = 0; j < 2; ++j)
#pragma unroll
                    for (int r = 0; r < 4; ++r) gcur[s][j][r] = bf2f(*(const LAS unsigned short*)(stg + 35 * 128 + (16 * s + 4 * kg + r) * 64 + (16 * j + n16) * 2));
            asm volatile("s_waitcnt lgkmcnt(0)" ::: "memory");
            float av[2][2][4], bv[2][2][4], Pe[2][2], He[2][2], Pt[2][2], Ht[2][2];
#pragma unroll
            for (int s = 0; s < 2; ++s) {
                bx8 af[2];
#pragma unroll
                for (int ks = 0; ks < 2; ++ks) af[ks] = *(const LAS bx8*)(L + RG2_XCB_OFF + (wave * 32 + 16 * s + n16) * RG_WT_PITCH + (32 * ks + 8 * kg) * 2);
#pragma unroll
                for (int j = 0; j < 2; ++j) {
                    f32x4 cr = (f32x4){0.f, 0.f, 0.f, 0.f}, ci = (f32x4){0.f, 0.f, 0.f, 0.f};
#pragma unroll
                    for (int ks = 0; ks < 2; ++ks) {
                        const bx8 wa_f = *(const LAS bx8*)(L + RG_WA_OFF + (16 * j + n16) * RG_WT_PITCH + (32 * ks + 8 * kg) * 2);
                        const bx8 wx_f = *(const LAS bx8*)(L + RG_WX_OFF + (16 * j + n16) * RG_WT_PITCH + (32 * ks + 8 * kg) * 2);
                        cr = __builtin_amdgcn_mfma_f32_16x16x32_bf16(af[ks], wa_f, cr, 0, 0, 0);
                        ci = __builtin_amdgcn_mfma_f32_16x16x32_bf16(af[ks], wx_f, ci, 0, 0, 0);
                    }
                    float p = 1.f, h = 0.f;
#pragma unroll
                    for (int r = 0; r < 4; ++r) {
                        const float rr = __builtin_amdgcn_rcpf(1.0f + __builtin_amdgcn_exp2f(__builtin_fmaf(cr[r], -1.4426950408889634f, nba[j]))), ig = __builtin_amdgcn_rcpf(1.0f + __builtin_amdgcn_exp2f(__builtin_fmaf(ci[r], -1.4426950408889634f, nbx[j])));
                        const float l2 = rr * lsl[j];
                        const float a = __builtin_amdgcn_exp2f(l2);
                        const float oma = __builtin_fmaf(-a, a, 1.0f);
                        const float xcv = Xf[(wave * 32 + 16 * s + 4 * kg + r) * 32 + 16 * j + n16];
                        const float bb = __builtin_amdgcn_sqrtf(oma) * (ig * xcv);
                        av[s][j][r] = a; bv[s][j][r] = bb; h = a * h + bb; p *= a;
                    }
                    float P = p, H = h;
                    { const float p1 = __shfl_up(P, 16), h1 = __shfl_up(H, 16); if (kg >= 1) { H = P * h1 + H; P = P * p1; } }
                    { const float p2 = __shfl_up(P, 32), h2 = __shfl_up(H, 32); if (kg >= 2) { H = P * h2 + H; P = P * p2; } }
                    const float pe = __shfl_up(P, 16), he = __shfl_up(H, 16);
                    Pe[s][j] = kg >= 1 ? pe : 1.f; He[s][j] = kg >= 1 ? he : 0.f;
                    Pt[s][j] = __shfl(P, 48 + n16); Ht[s][j] = __shfl(H, 48 + n16);
                }
            }
#pragma unroll
            for (int j = 0; j < 2; ++j)
                if (kg == 3) { LAS float* cw_ = carr + (ch & 1) * 512 + wave * 64 + j * 32; cw_[n16] = Pt[1][j] * Pt[0][j]; cw_[16 + n16] = Pt[1][j] * Ht[0][j] + Ht[1][j]; }
            __syncthreads();
#pragma unroll
            for (int j = 0; j < 2; ++j) {
                const LAS float* cr_ = carr + (ch & 1) * 512 + j * 32;
                float cin = 0.f, cc = hst[j];
#pragma unroll
                for (int w2 = 0; w2 < 8; ++w2) { if (w2 == wave) cin = cc; cc = cr_[w2 * 64 + n16] * cc + cr_[w2 * 64 + 16 + n16]; }
                hst[j] = cc;
#pragma unroll
                for (int s = 0; s < 2; ++s) {
                    const float sin_ = s == 0 ? cin : Pt[0][j] * cin + Ht[0][j];
                    float h = Pe[s][j] * sin_ + He[s][j];
#pragma unroll
                    for (int r = 0; r < 4; ++r) { h = av[s][j][r] * h + bv[s][j][r];
                        const float g = gcur[s][j][r];
#if GATE_GELU
                        *(LAS bf16*)(stg + 35 * 128 + 2048 + (16 * s + 4 * kg + r) * 64 + (16 * j + n16) * 2) = (bf16)f2bf(h * g); }
#else
                        const float e2 = g * __builtin_fmaf(g * g, -2.0f * 0.7978845608028654f * 1.4426950408889634f * 0.044715f, -2.0f * 0.7978845608028654f * 1.4426950408889634f);
                        *(LAS bf16*)(stg + 35 * 128 + 2048 + (16 * s + 4 * kg + r) * 64 + (16 * j + n16) * 2) = (bf16)f2bf((h * g) * __builtin_amdgcn_rcpf(1.0f + __builtin_amdgcn_exp2f(e2))); }
#endif
                }
            }
            asm volatile("s_waitcnt lgkmcnt(0)" ::: "memory");
#pragma unroll
            for (int i = 0; i < 2; ++i) { const v4u o = *(const LAS v4u*)(stg + 35 * 128 + 2048 + (16 * i + gt_tok) * 64 + gt_c8 * 16);
              *(GAS v4u*)(rnb + (unsigned)((t0 + 16 * i) * 3072 + (int)ooff)) = o; }
        }
    }
}
__device__ __forceinline__ void p_fixup_items(Frame& F, int first, int last, int gt, int NGT);
__device__ __forceinline__ void p_fixup(Frame& F) {
    const bf16* HALO = (const bf16*)(F.ws + WS_HALO); bf16* H = (bf16*)(F.ws + WS_H);
    const float* fw = F.in[18]; const float* fb = F.in[19];
    p_fixup_items(F, 0, (M / 256) * (DFF / 4), F.vcu * (NWAVES * 64) + F.tid, F.G * NWAVES * 64);
}
__device__ __forceinline__ void p_fixup_items(Frame& F, int first, int last, int gt, int NGT) {
    const bf16* HALO = (const bf16*)(F.ws + WS_HALO); bf16* H = (bf16*)(F.ws + WS_H);
    const float* fw = F.in[18]; const float* fb = F.in[19];
    for (int it = first + gt; it < last; it += NGT) {
        const int pm = it / (DFF / 4), c = (it % (DFF / 4)) * 4;
        const int col = (c >> 7) * 256 + (c & 127);
        const bool hasprev = (pm % (SEQ / 256)) != 0;
        f32x4 u[4][2];
#pragma unroll
        for (int r = 0; r < 4; ++r)
#pragma unroll
            for (int gv = 0; gv < 2; ++gv) {
                u[r][gv] = (f32x4){0.f, 0.f, 0.f, 0.f};
                unsigned long long raw = 0ull;
                if (r >= 2) raw = *(const GAS unsigned long long*)(HALO + ((size_t)pm * 4 + (r - 2)) * NUP + col + gv * 128);
                else if (hasprev) raw = *(const GAS unsigned long long*)(HALO + ((size_t)(pm - 1) * 4 + 2 + r) * NUP + col + gv * 128);
                u[r][gv] = (f32x4){bflo((unsigned)raw), bfhi((unsigned)raw), bflo((unsigned)(raw >> 32)), bfhi((unsigned)(raw >> 32))};
            }
        f32x4 w[3][2], bb[2];
#pragma unroll
        for (int gv = 0; gv < 2; ++gv) { bb[gv] = *(const GAS f32x4*)(fb + gv * DFF + c);
#pragma unroll
            for (int j = 0; j < 3; ++j) w[j][gv] = *(const GAS f32x4*)(fw + (size_t)j * NUP + gv * DFF + c); }
#pragma unroll
        for (int r = 0; r < 2; ++r) {
            const f32x4 yg = bb[0] + w[0][0] * u[r][0] + w[1][0] * u[r + 1][0] + w[2][0] * u[r + 2][0];
            const f32x4 yv = bb[1] + w[0][1] * u[r][1] + w[1][1] * u[r + 1][1] + w[2][1] * u[r + 2][1];
            float hh[4];
#pragma unroll
            for (int i = 0; i < 4; ++i) hh[i] = yg[i] * sigmoid_f(yg[i]) * yv[i];
            *(GAS unsigned long long*)(H + (size_t)(pm * 256 + r) * DFF + c) = (unsigned long long)pk2(hh[0], hh[1]) | ((unsigned long long)pk2(hh[2], hh[3]) << 32);
        }
    }
}
#ifndef STAG_IN
#define STAG_IN 5
#endif
#ifndef STAG_XCD
#define STAG_XCD 0
#endif
#ifndef STAG_N
#define STAG_N 3
#endif
#ifndef STAG_UP
#define STAG_UP 5
#endif
__device__ __forceinline__ void phase_stagger(Frame& F, int us) {
    const int g = STAG_XCD ? ((int)blockIdx.x & (STAG_XCD - 1)) : (((int)blockIdx.x >> 3) & 3);
    if (us > 0 && g) {
        if (F.tid == 0) { const unsigned long long t0 = wall_clock64(), dt = (unsigned long long)(g * us) * 100ull; while (wall_clock64() - t0 < dt) __builtin_amdgcn_s_sleep(4); }
        __syncthreads();
    }
}
struct Args { const float* in[21]; float* out; unsigned char* ws; int ph_lo, ph_hi, li, pad; };
static_assert(sizeof(Args) == 23 * 8 + 16, "Args has no padding");
__global__ void __launch_bounds__(NWAVES * 64, 2) mk_fwd(Args args) {
    extern __shared__ __attribute__((aligned(16))) unsigned char lds[];
    Frame F;
    F.lds = (LAS unsigned char*)lds;
    F.MISC = (volatile LAS unsigned*)(F.lds + MISC_OFF);
    F.tid = threadIdx.x; F.lane = F.tid & 63; F.wave = __builtin_amdgcn_readfirstlane(F.tid >> 6);
    F.G = gridDim.x; { const int bx = blockIdx.x; F.vcu = (F.G % 8 == 0) ? (bx % 8) * (F.G / 8) + bx / 8 : bx; }
    F.ws = args.ws; F.out = args.out; F.ctl = (gu32*)(args.ws + WS_CTL);
#pragma unroll
    for (int i = 0; i < 21; ++i) F.in[i] = args.in[i];
    for (int u = F.tid; u < (LDS_BYTES - LDSCTL_OFF) / 4; u += NWAVES * 64) ((LAS unsigned*)(F.lds + LDSCTL_OFF))[u] = 0u;
    __syncthreads();
    XcdBarrier bar; bar.bar = (unsigned*)(F.ctl + CW_BAR) + args.li * XCD_BAR_WORDS; bar.x = 0; bar.st = nullptr;
    if (MK_ONE_LAUNCH) bar = xcd_barrier_post((unsigned*)(F.ctl + CW_BAR) + args.li * XCD_BAR_WORDS, F.MISC + 8);
#define GRID_BAR() do { if (MK_ONE_LAUNCH) xcd_barrier(bar); } while (0)
    const int lo = args.ph_lo, hi = args.ph_hi;
#ifndef PHASE_MASK
#define PHASE_MASK 0x1FFFF
#endif
#define IN(k) ((((PHASE_MASK) >> (k)) & 1) && lo <= (k) && (k) < hi)
#define BOTH(k) (IN(k) && IN((k) + 1))
    unsigned char* ws = args.ws;
    typedef pg8::bf16_t pbf;

    if (IN(0)) { p0_prologue(F); if (BOTH(0)) GRID_BAR(); }

    if (IN(1)) {
        pg8::Gemm g{(const pbf*)(ws + WS_XB), (const pbf*)(ws + WS_WIN), M, NIN, 1024}; pg8::StaticOrder S; S.init(M, NIN, F.G, (int)blockIdx.x);
        pg8::EpiIn E{(pbf*)(ws + WS_PA), (pbf*)(ws + WS_RX), (size_t)(WS_RGATE - WS_RX) / 2, (const float*)(ws + WS_RINV1), (unsigned char*)F.out + OUT_KV, (pbf*)(ws + WS_KI), (float*)(ws + WS_WI), (const float*)(ws + WS_GAINS)};
        phase_stagger(F, STAG_IN);
        pg8::gemm_phase<pg8::EpiIn, pg8::StaticOrder, true, true>(F.lds + RING_OFF, g, S, E);
        if (p0_defer(F.G) && blockIdx.x >= 128) p0_transposes(F, P0_I_IN, P0_NITEMS, ((int)blockIdx.x - 128) * NWAVES + F.wave, 128 * NWAVES);
        if (BOTH(1)) GRID_BAR();
    }
#ifndef RG_V2
#define RG_V2 1
#endif
    if (IN(3)) { if (RG_V2) p4_rglru2(F); else p4_rglru(F); }
    if (IN(4)) { p3_topk(F, args.li); if (BOTH(4)) GRID_BAR(); }
#if TKPROBE == 9
    if (F.vcu == 0 && F.tid == 0) { const unsigned nfb = __hip_atomic_load(F.ctl + CW_QUEUE + 32, RLX_AGENT); const unsigned long long t0 = wall_clock64(); while (wall_clock64() - t0 < (unsigned long long)nfb * 100ull) __builtin_amdgcn_s_sleep(8); }
#endif
#if TKPROBE == 21
    if (F.vcu == 0 && F.tid == 0) { const unsigned nfb = __hip_atomic_load(F.ctl + CW_QUEUE + 32, RLX_AGENT); const unsigned long long t0 = wall_clock64(); while (wall_clock64() - t0 < (unsigned long long)(nfb >> 10) * 100ull) __builtin_amdgcn_s_sleep(8); }
#endif
    if (IN(5)) { p4_attn(F); if (BOTH(5)) GRID_BAR(); }
    if (IN(6)) {
        pg8::Gemm g{(const pbf*)((unsigned char*)F.out + OUT_ARN), (const pbf*)(ws + WS_WOA), M, 1024, 1536}; pg8::StaticOrder S; S.init(M, 1024, F.G, (int)blockIdx.x);
        pg8::EpiMerge E{(pbf*)(ws + WS_MERGED), (const unsigned char*)(ws + WS_GA), (const unsigned char*)(ws + WS_GB)};
        phase_stagger(F, STAG_N);
        pg8::gemm_phase<pg8::EpiMerge, pg8::StaticOrder, true, true>(F.lds + RING_OFF, g, S, E);
        if (BOTH(6)) GRID_BAR();
    }
    if (IN(7)) {
        pg8::Gemm g{(const pbf*)(ws + WS_MERGED), (const pbf*)(ws + WS_WOUT), M, 1024, 1024}; pg8::StaticOrder S; S.init(M, 1024, F.G, (int)blockIdx.x);
        pg8::EpiRes E{(const pbf*)(ws + WS_XB), (const float*)(ws + WS_RINV1), (pbf*)(ws + WS_X1B), (float*)(ws + WS_SSQ2)};
        phase_stagger(F, STAG_N);
        pg8::gemm_phase<pg8::EpiRes, pg8::StaticOrder, true, true>(F.lds + RING_OFF, g, S, E);
        if (BOTH(7)) GRID_BAR();
    }
    if (IN(8)) {
        pg8::Gemm g{(const pbf*)(ws + WS_X1B), (const pbf*)(ws + WS_WUP), M, NUP, 1024}; pg8::StaticOrder S; S.init(M, NUP, F.G, (int)blockIdx.x);
#ifndef UP_INREG
#define UP_INREG 1
#endif
#if UP_INREG
        pg8::EpiUpR E{(pbf*)(ws + WS_H), (pbf*)(ws + WS_HALO), (const float*)(ws + WS_SSQ2), F.in[18], F.in[19], F.lds + XSLAB_OFF, DFF};
        phase_stagger(F, STAG_UP);
        pg8::gemm_phase<pg8::EpiUpR, pg8::StaticOrder, true, true>(F.lds + RING_OFF, g, S, E);
#else
        pg8::EpiUp E{(pbf*)(ws + WS_H), (pbf*)(ws + WS_HALO), (pbf*)(ws + WS_SCR) + (size_t)blockIdx.x * 65536, (const float*)(ws + WS_SSQ2), F.in[18], F.in[19], DFF};
        pg8::gemm_phase<pg8::EpiUp, pg8::StaticOrder, true, true>(F.lds + RING_OFF, g, S, E);
#endif
        if (BOTH(8)) GRID_BAR();
    }
#ifndef FIXUP_FOLD
#define FIXUP_FOLD 0
#endif
    if (!FIXUP_FOLD && IN(9)) { p_fixup(F); if (BOTH(9)) GRID_BAR(); }
    if (IN(10)) {
        pg8::Gemm g{(const pbf*)(ws + WS_H), (const pbf*)(ws + WS_WDN), M, 1024, DFF}; pg8::StaticOrder S; S.init(M, 1024, F.G, (int)blockIdx.x);
        pg8::EpiAcc E{(const pbf*)(ws + WS_X1B), F.out};
        if (FIXUP_FOLD) {
            const int nun = (128 * 4 + F.G - 1) / F.G;
            for (int i = 0; i < nun; ++i) { pg8::Unit uu; uu.pm = 0; uu.pn = 0; const bool has = S.next(i, uu); const int pmv = has ? uu.pm : -1;
                if (pmv >= 0) p_fixup_items(F, pmv * (DFF / 4), (pmv + 1) * (DFF / 4), F.tid, NWAVES * 64); }
            asm volatile("s_waitcnt vmcnt(0)" ::: "memory"); __builtin_amdgcn_fence(__ATOMIC_RELEASE, "workgroup"); __syncthreads();
        }
        phase_stagger(F, STAG_N);
        pg8::gemm_phase<pg8::EpiAcc, pg8::StaticOrder, true, true>(F.lds + RING_OFF, g, S, E);
    }
#undef IN
#undef BOTH
}

extern "C" void kernel_launch(void* const* d_in, const int* in_sizes, int n_in, void* d_out, int out_size, void* d_ws, size_t ws_size, hipStream_t stream) {
    static int grid = 0;
    if (grid == 0) {
        if (n_in != 21 || out_size != M * DM || ws_size < WS_END) { fprintf(stderr, "kernel_launch: unexpected shapes: n_in %d out %d ws %zu (need %zu)\n", n_in, out_size, ws_size, (size_t)WS_END); grid = -1; return; }
        int dev = 0, cus = 0;
        if (hipGetDevice(&dev) != hipSuccess || hipDeviceGetAttribute(&cus, hipDeviceAttributeMultiprocessorCount, dev) != hipSuccess) { grid = -1; return; }
        if (hipFuncSetAttribute((const void*)mk_fwd, hipFuncAttributeMaxDynamicSharedMemorySize, LDS_BYTES) != hipSuccess) { fprintf(stderr, "kernel_launch: hipFuncSetAttribute failed\n"); grid = -1; return; }
        (void)hipGetLastError();
        grid = cus;
    }
    if (grid < 0) return;
    if (hipMemsetAsync((char*)d_ws + WS_CTL, 0, CTL_ZERO_BYTES, stream) != hipSuccess) return;
    Args a{};
    for (int i = 0; i < 21; ++i) a.in[i] = (const float*)d_in[i];
    a.out = (float*)d_out; a.ws = (unsigned char*)d_ws;
#if MK_ONE_LAUNCH && defined(PROBE_DUP_LO)
    a.ph_lo = 0; a.ph_hi = PROBE_DUP_HI + 1; a.li = 0; hipLaunchKernelGGL(mk_fwd, dim3(grid), dim3(NWAVES * 64), LDS_BYTES, stream, a);
    a.ph_lo = PROBE_DUP_LO; a.ph_hi = PROBE_DUP_HI + 1; a.li = 1; hipLaunchKernelGGL(mk_fwd, dim3(grid), dim3(NWAVES * 64), LDS_BYTES, stream, a);
    if (PROBE_DUP_HI + 1 < NPH) { a.ph_lo = PROBE_DUP_HI + 1; a.ph_hi = NPH; a.li = 2; hipLaunchKernelGGL(mk_fwd, dim3(grid), dim3(NWAVES * 64), LDS_BYTES, stream, a); }
#elif MK_ONE_LAUNCH
    a.ph_lo = 0; a.ph_hi = NPH;
    hipLaunchKernelGGL(mk_fwd, dim3(grid), dim3(NWAVES * 64), LDS_BYTES, stream, a);
#else
    for (int p = 0; p < NPH; ++p) { a.ph_lo = p; a.ph_hi = p + 1; hipLaunchKernelGGL(mk_fwd, dim3(grid), dim3(NWAVES * 64), LDS_BYTES, stream, a); }
#endif
}
```

```cpp
#define STAG_IN 0
#define STAG_UP 0
#define STAG_N 0
#define PG8_KROT 0
#define P0_HALF 1
#include <hip/hip_runtime.h>
#include <cstdio>
#include <cstdint>
#ifndef PG8_KROT
#define PG8_KROT 1
#endif
#ifndef PG8_WGM
#define PG8_WGM 8
#endif
namespace pg8 {
#define PG8_LAS __attribute__((address_space(3)))
typedef unsigned short bf16_t;
typedef short bf16x8 __attribute__((ext_vector_type(8)));
typedef float f32x4 __attribute__((ext_vector_type(4)));
typedef unsigned u32x4 __attribute__((ext_vector_type(4)));
constexpr int BM = 256, BK = 64, HALF = 128, HTB = HALF * BK * 2  , STAGE_BYTES = 8 * HTB, NXCD = 8, WGM = PG8_WGM;

__host__ __device__ __forceinline__ int lds_byte(int r, int c) { const int st = (r >> 4) * 2 + (c >> 5), rr = r & 15, cc = c & 31, ob = rr * 64 + cc * 2; return st * 1024 + (ob ^ (((ob >> 9) & 1) << 5)); }
__host__ __device__ __forceinline__ void stage_rc(int b, int& R, int& C) { const int st = b / 1024, sb = b % 1024, swz = sb ^ (((sb >> 9) & 1) << 5); R = (st >> 1) * 16 + swz / 64; C = (st & 1) * 32 + (swz % 64) / 2; }
__host__ __device__ __forceinline__ int perm32(int rho) { const int n = rho >> 4, i = rho & 15; return 8 * (i >> 2) + 4 * n + (i & 3); }

struct Unit { int pm, pn; };
struct Gemm { const bf16_t* A; const bf16_t* Bt; int M, N, K; };

struct StaticOrder {
    int nM, nN, nwg, G, c;
    __host__ __device__ void init(int M, int N, int G_, int c_) { nM = M / BM; nN = N / BM; nwg = nM * nN; G = G_; c = c_; }
    __host__ __device__ __forceinline__ bool next(int i, Unit& u) const {
        const long L = (long)i * G + c; if (L >= nwg) return false;
        int wgid = (int)L; { const int q = nwg / NXCD, r = nwg % NXCD, xcd = wgid % NXCD, off = wgid / NXCD; wgid = (xcd < r ? xcd * (q + 1) : r * (q + 1) + (xcd - r) * q) + off; }
        const int nig = WGM * nN, gid = wgid / nig, fm = gid * WGM, gsz = (nM - fm) < WGM ? (nM - fm) : WGM;
        u.pm = fm + ((wgid % nig) % gsz); u.pn = (wgid % nig) / gsz; return true;
    }
    __device__ __forceinline__ void a_ready(const Unit&) const {}
    __device__ __forceinline__ void done(const Unit&) const {}
};

typedef __bf16 pg8_bf2 __attribute__((ext_vector_type(2)));
typedef float pg8_f2 __attribute__((ext_vector_type(2)));
__device__ __forceinline__ unsigned cvt_pk_bf16(float lo, float hi) { return __builtin_bit_cast(unsigned, __builtin_convertvector((pg8_f2){lo, hi}, pg8_bf2)); }
__device__ __forceinline__ unsigned cvt_pk_bf16_av(float lo, float hi) { unsigned r; asm volatile("v_cvt_pk_bf16_f32 %0, %1, %2" : "=v"(r) : "v"(lo), "v"(hi)); return r; }
typedef float f32x2 __attribute__((ext_vector_type(2)));
__device__ __forceinline__ f32x2 gelu_pk(f32x2 v) {
    const f32x2 av = __builtin_elementwise_abs(v), d = av * 0.2316418882f + 1.0f;
    f32x2 t; t.x = __builtin_amdgcn_rcpf(d.x); t.y = __builtin_amdgcn_rcpf(d.y);
    f32x2 q = t * 0.5307027145f + (-0.7265760135f); q = q * t + 0.7107068705f; q = q * t + (-0.142248368f); q = q * t + 0.127414796f; q = q * t;
    const f32x2 s = (v * v) * (-0.72134752044f);
    f32x2 e; e.x = __builtin_amdgcn_exp2f(s.x); e.y = __builtin_amdgcn_exp2f(s.y);
    const f32x2 m = v * (q * e), r = v - m;
    f32x2 o; o.x = v.x < 0.f ? m.x : r.x; o.y = v.y < 0.f ? m.y : r.y; return o;
}

template <int ACT  > struct EpiBf16 {
    static constexpr int MIDK = 0; static constexpr bool PERM = true, AFTER_DRAIN = false; static_assert(ACT == 0 || ACT == 1, "EpiBf16: ACT is 0 (none) or 1 (gelu_pk)");
    bf16_t* O; int ldc; const float* bias; int split_cols; size_t split_stride; float scale0;
    __device__ __forceinline__ void operator()(const f32x4 (&acc)[2][2][4][2], const Unit& u, int wr, int wc, int fr, int fq) const {
        const int row0 = u.pm * BM + wr * 64 + fr; int colt = u.pn * BM; bf16_t* base = O;
        float sc = 1.f; if (split_cols) { const int t = colt / split_cols; base += (size_t)t * split_stride; colt -= t * split_cols; if (t == 0) sc = scale0; }
        const int col0 = colt + wc * 32 + 8 * fq, bcol0 = u.pn * BM + wc * 32 + 8 * fq;
        f32x4 bv[2][2];
#pragma unroll
        for (int bj = 0; bj < 2; ++bj)
#pragma unroll
            for (int n = 0; n < 2; ++n) bv[bj][n] = bias ? *(const f32x4*)(bias + bcol0 + bj * HALF + 4 * n) : (f32x4){0.f, 0.f, 0.f, 0.f};
#pragma unroll
        for (int ai = 0; ai < 2; ++ai)
#pragma unroll
            for (int m = 0; m < 4; ++m) { bf16_t* rowp = base + (size_t)(row0 + ai * HALF + m * 16) * ldc + col0;
#pragma unroll
                for (int bj = 0; bj < 2; ++bj) { f32x4 v0 = acc[ai][bj][m][0] + bv[bj][0], v1 = acc[ai][bj][m][1] + bv[bj][1];
                    if (ACT == 1) { f32x2 a = gelu_pk((f32x2){v0[0], v0[1]}), b = gelu_pk((f32x2){v0[2], v0[3]}), c = gelu_pk((f32x2){v1[0], v1[1]}), d = gelu_pk((f32x2){v1[2], v1[3]});
                        v0 = (f32x4){a.x, a.y, b.x, b.y}; v1 = (f32x4){c.x, c.y, d.x, d.y}; }
                    v0 = v0 * sc; v1 = v1 * sc; u32x4 w; w.x = cvt_pk_bf16(v0[0], v0[1]); w.y = cvt_pk_bf16(v0[2], v0[3]); w.z = cvt_pk_bf16(v1[0], v1[1]); w.w = cvt_pk_bf16(v1[2], v1[3]);
                    *(u32x4*)(rowp + bj * HALF) = w; } }
    }
};

#ifndef UP_APERM
#define UP_APERM 1
#endif
#ifndef UP_SCHEDBAR
#define UP_SCHEDBAR 1
#endif
#ifndef UP_WREG
#define UP_WREG 1
#endif
#ifndef WT_ST
#define WT_ST 0
#endif
#if WT_ST
#define WT16(p, v) do { const u32x4 v_ = (v); const void* p_ = (const void*)(p); asm volatile("global_store_dwordx4 %0, %1, off sc1\n\ts_nop 1" :: "v"(p_), "v"(v_) : "memory"); } while (0)
#define WT16F(p, v) do { const f32x4 v_ = (v); const void* p_ = (const void*)(p); asm volatile("global_store_dwordx4 %0, %1, off sc1\n\ts_nop 1" :: "v"(p_), "v"(v_) : "memory"); } while (0)
#define WT8(p, v) do { const u32x2v v_ = (v); const void* p_ = (const void*)(p); asm volatile("global_store_dwordx2 %0, %1, off sc1\n\ts_nop 1" :: "v"(p_), "v"(v_) : "memory"); } while (0)
#else
#define WT16(p, v) (*(u32x4*)(p) = (v))
#define WT16F(p, v) (*(f32x4*)(p) = (v))
#define WT8(p, v) (*(u32x2v*)(p) = (v))
#endif
#ifndef OUT_NT
#define OUT_NT 0
#endif
#if OUT_NT
#define OUT_STORE(p, v) __builtin_nontemporal_store((v), (p))
#else
#define OUT_STORE(p, v) (*(p) = (v))
#endif
#ifndef IN_NT
#define IN_NT 0
#endif
#if IN_NT
#define IN_STORE(p, v) __builtin_nontemporal_store((v), (p))
#else
#define IN_STORE(p, v) (*(p) = (v))
#endif
#ifndef UP_PRE
#define UP_PRE 1
#endif
#ifndef GATE_GELU
#define GATE_GELU 0
#endif
#ifndef GATES_U8
#define GATES_U8 1
#endif
#ifndef MERGE_DEPTH
#define MERGE_DEPTH 3
#endif
#ifndef EPIDUP_IN
#define EPIDUP_IN 0
#endif
#ifndef EPIDUP_MERGE
#define EPIDUP_MERGE 0
#endif
#ifndef EPIDUP_RES
#define EPIDUP_RES 0
#endif
#ifndef EPIDUP_ACC
#define EPIDUP_ACC 0
#endif
#ifndef EPIDUP_UP
#define EPIDUP_UP 0
#endif

__device__ __forceinline__ float bf_lo(unsigned u) { return __builtin_bit_cast(float, u << 16); }
__device__ __forceinline__ float bf_hi(unsigned u) { return __builtin_bit_cast(float, u & 0xffff0000u); }
__device__ __forceinline__ float sigmoidf_(float x) { return __builtin_amdgcn_rcpf(1.0f + __expf(-x)); }

struct EpiIn {
    static constexpr bool APERM = false;
    static constexpr bool PRE = false;
    static constexpr int dup = EPIDUP_IN;
    static constexpr int MIDK = 0; static constexpr bool PERM = true, AFTER_DRAIN = false;
    bf16_t* PA; bf16_t* SEC; size_t sec_stride; const float* rinv; unsigned char* KV; bf16_t* KI; float* WI; const float* gains;
    __device__ __forceinline__ void operator()(const f32x4 (&acc)[2][2][4][2], const Unit& u, int wr, int wc, int fr, int fq) const {
        typedef unsigned u32x2v __attribute__((ext_vector_type(2)));
        asm volatile("" : "+v"(fr), "+v"(fq));
        const int row0 = u.pm * BM + wr * 64 + fr;
        if (u.pn >= 5) {
            const int s = (u.pn - 5) >> 2; bf16_t* base = SEC + (size_t)s * sec_stride; const int col0 = ((u.pn - 5) & 3) * 256 + wc * 32 + 8 * fq;
            if (GATES_U8 && s >= 2) {
                unsigned char* b8 = (unsigned char*)base;
#pragma unroll
                for (int ai = 0; ai < 2; ++ai)
#pragma unroll
                    for (int m = 0; m < 4; ++m) { const int row = row0 + ai * HALF + m * 16; unsigned char* rowp = b8 + (size_t)row * 1024 + col0;
#pragma unroll
                        for (int bj = 0; bj < 2; ++bj) { u32x2v w; w.x = 0u; w.y = 0u;
#pragma unroll
                            for (int i = 0; i < 4; ++i) { w.x = __builtin_amdgcn_cvt_pk_u8_f32(255.0f * sigmoidf_(acc[ai][bj][m][0][i]), i, w.x); w.y = __builtin_amdgcn_cvt_pk_u8_f32(255.0f * sigmoidf_(acc[ai][bj][m][1][i]), i, w.y); }
                            WT8((rowp + bj * HALF), w); } }
                return;
            }
            const bool gel = GATE_GELU && s == 1;
#pragma unroll
            for (int ai = 0; ai < 2; ++ai)
#pragma unroll
                for (int m = 0; m < 4; ++m) { const int row = row0 + ai * HALF + m * 16; bf16_t* rowp = base + (size_t)row * 1024 + col0;
#pragma unroll
                    for (int bj = 0; bj < 2; ++bj) { f32x4 v0 = acc[ai][bj][m][0], v1 = acc[ai][bj][m][1];
                        if (gel) {
#pragma unroll
                            for (int i = 0; i < 4; ++i) { const float g0 = v0[i], g1 = v1[i]; v0[i] = g0 * sigmoidf_(1.5957691216057308f * (g0 + 0.044715f * g0 * g0 * g0)); v1[i] = g1 * sigmoidf_(1.5957691216057308f * (g1 + 0.044715f * g1 * g1 * g1)); } }
                        u32x4 w; w.x = cvt_pk_bf16(v0[0], v0[1]); w.y = cvt_pk_bf16(v0[2], v0[3]); w.z = cvt_pk_bf16(v1[0], v1[1]); w.w = cvt_pk_bf16(v1[2], v1[3]);
                        WT16((rowp + bj * HALF), w); } }
            return;
        }
        const int H = 4 * u.pn + wc;
        if (H >= 18) return;
        const bool donorm = (H < 10) || (H == 16);
        const float* gp = gains + (H < 8 ? 0 : (H < 10 ? 64 : 128));
        f32x4 g[2][2];
#pragma unroll
        for (int bj = 0; bj < 2; ++bj)
#pragma unroll
            for (int n = 0; n < 2; ++n) g[bj][n] = donorm ? *(const f32x4*)(gp + 32 * bj + 8 * fq + 4 * n) : (f32x4){1.f, 1.f, 1.f, 1.f};
        const float post = (H >= 12 && H < 16) ? 0.125f : (H == 17 ? 0.5f : 1.0f);
#pragma unroll
        for (int ai = 0; ai < 2; ++ai)
#pragma unroll
            for (int m = 0; m < 4; ++m) { const int row = row0 + ai * HALF + m * 16;
                f32x4 v[2][2]; float ss = 0.f;
#pragma unroll
                for (int bj = 0; bj < 2; ++bj)
#pragma unroll
                    for (int n = 0; n < 2; ++n) { v[bj][n] = acc[ai][bj][m][n]; ss += (v[bj][n][0] * v[bj][n][0] + v[bj][n][1] * v[bj][n][1]) + (v[bj][n][2] * v[bj][n][2] + v[bj][n][3] * v[bj][n][3]); }
                ss += __shfl_xor(ss, 16); ss += __shfl_xor(ss, 32);
                const float sc = donorm ? 1.0f / sqrtf(ss * (1.0f / 64.0f) + 1e-6f) : post;
#pragma unroll
                for (int bj = 0; bj < 2; ++bj)
#pragma unroll
                    for (int n = 0; n < 2; ++n) v[bj][n] = v[bj][n] * sc * g[bj][n];
                if (H < 8 || (H >= 12 && H < 16)) {
                    bf16_t* rowp = PA + (size_t)row * 1280 + 64 * H + 8 * fq;
#pragma unroll
                    for (int bj = 0; bj < 2; ++bj) { u32x4 w; w.x = cvt_pk_bf16(v[bj][0][0], v[bj][0][1]); w.y = cvt_pk_bf16(v[bj][0][2], v[bj][0][3]); w.z = cvt_pk_bf16(v[bj][1][0], v[bj][1][1]); w.w = cvt_pk_bf16(v[bj][1][2], v[bj][1][3]);
                        *(u32x4*)(rowp + 32 * bj) = w; }
                } else if (H < 12) {
                    unsigned char* rowp = KV + (size_t)row * 256 + 64 * (H - 8) + 8 * fq;
#pragma unroll
                    for (int bj = 0; bj < 2; ++bj) { int w0 = __builtin_amdgcn_cvt_pk_fp8_f32(v[bj][0][0], v[bj][0][1], 0, false); w0 = __builtin_amdgcn_cvt_pk_fp8_f32(v[bj][0][2], v[bj][0][3], w0, true);
                        int w1 = __builtin_amdgcn_cvt_pk_fp8_f32(v[bj][1][0], v[bj][1][1], 0, false); w1 = __builtin_amdgcn_cvt_pk_fp8_f32(v[bj][1][2], v[bj][1][3], w1, true);
                        u32x2v w; w.x = (unsigned)w0; w.y = (unsigned)w1; *(u32x2v*)(rowp + 32 * bj) = w; }
                } else if (H == 16) {
                    bf16_t* rowp = KI + (size_t)row * 64 + 8 * fq;
#pragma unroll
                    for (int bj = 0; bj < 2; ++bj) { u32x4 w; w.x = cvt_pk_bf16(v[bj][0][0], v[bj][0][1]); w.y = cvt_pk_bf16(v[bj][0][2], v[bj][0][3]); w.z = cvt_pk_bf16(v[bj][1][0], v[bj][1][1]); w.w = cvt_pk_bf16(v[bj][1][2], v[bj][1][3]);
                        *(u32x4*)(rowp + 32 * bj) = w; }
                } else {
                    if (fq == 0) *(f32x4*)(WI + (size_t)row * 4) = v[0][0];
                }
            }
    }
};
struct EpiPlain {
    static constexpr bool APERM = false;
    static constexpr bool PRE = false;
    static constexpr int dup = 0;
    static constexpr int MIDK = 0; static constexpr bool PERM = true, AFTER_DRAIN = false;
    bf16_t* O; int ldc;
    __device__ __forceinline__ void operator()(const f32x4 (&acc)[2][2][4][2], const Unit& u, int wr, int wc, int fr, int fq) const {
        const int row0 = u.pm * BM + wr * 64 + fr, col0 = u.pn * BM + wc * 32 + 8 * fq;
#pragma unroll
        for (int ai = 0; ai < 2; ++ai)
#pragma unroll
            for (int m = 0; m < 4; ++m) { bf16_t* rowp = O + (size_t)(row0 + ai * HALF + m * 16) * ldc + col0;
#pragma unroll
                for (int bj = 0; bj < 2; ++bj) { const f32x4 v0 = acc[ai][bj][m][0], v1 = acc[ai][bj][m][1];
                    u32x4 w; w.x = cvt_pk_bf16(v0[0], v0[1]); w.y = cvt_pk_bf16(v0[2], v0[3]); w.z = cvt_pk_bf16(v1[0], v1[1]); w.w = cvt_pk_bf16(v1[2], v1[3]);
                    *(u32x4*)(rowp + bj * HALF) = w; } }
    }
};
template <int MODE> struct EpiGate {
    static constexpr bool APERM = false;
    static constexpr bool PRE = false;
    static constexpr int dup = 0;
    static constexpr int MIDK = 0; static constexpr bool PERM = true, AFTER_DRAIN = false;
    bf16_t* O; const bf16_t* G;
    __device__ __forceinline__ void operator()(const f32x4 (&acc)[2][2][4][2], const Unit& u, int wr, int wc, int fr, int fq) const {
        const int row0 = u.pm * BM + wr * 64 + fr, col0 = u.pn * BM + wc * 32 + 8 * fq;
#pragma unroll
        for (int ai = 0; ai < 2; ++ai)
#pragma unroll
            for (int m = 0; m < 4; ++m) { const size_t off = (size_t)(row0 + ai * HALF + m * 16) * 1024 + col0;
#pragma unroll
                for (int bj = 0; bj < 2; ++bj) { const u32x4 g = *(const u32x4*)(G + off + bj * HALF);
                    const f32x4 a0 = acc[ai][bj][m][0], a1 = acc[ai][bj][m][1];
                    float r[8];
                    r[0] = sigmoidf_(bf_lo(g.x)) * a0[0]; r[1] = sigmoidf_(bf_hi(g.x)) * a0[1]; r[2] = sigmoidf_(bf_lo(g.y)) * a0[2]; r[3] = sigmoidf_(bf_hi(g.y)) * a0[3];
                    r[4] = sigmoidf_(bf_lo(g.z)) * a1[0]; r[5] = sigmoidf_(bf_hi(g.z)) * a1[1]; r[6] = sigmoidf_(bf_lo(g.w)) * a1[2]; r[7] = sigmoidf_(bf_hi(g.w)) * a1[3];
                    if (MODE == 1) { const u32x4 p = *(const u32x4*)(O + off + bj * HALF);
                        r[0] += bf_lo(p.x); r[1] += bf_hi(p.x); r[2] += bf_lo(p.y); r[3] += bf_hi(p.y); r[4] += bf_lo(p.z); r[5] += bf_hi(p.z); r[6] += bf_lo(p.w); r[7] += bf_hi(p.w); }
                    u32x4 w; w.x = cvt_pk_bf16(r[0], r[1]); w.y = cvt_pk_bf16(r[2], r[3]); w.z = cvt_pk_bf16(r[4], r[5]); w.w = cvt_pk_bf16(r[6], r[7]);
                    *(u32x4*)(O + off + bj * HALF) = w; } }
    }
};
struct EpiMerge {
    static constexpr bool APERM = false;
    static constexpr bool PRE = false;
    static constexpr int dup = EPIDUP_MERGE;
    static constexpr int MIDK = 8; static constexpr bool PERM = true, AFTER_DRAIN = false;
    bf16_t* O; const unsigned char* GA; const unsigned char* GB;
    static __device__ __forceinline__ float ub(unsigned w, int i) { return (float)((w >> (8 * i)) & 0xFFu); }
    __device__ __forceinline__ void mid(f32x4 (&acc)[2][2][4][2], const Unit& u, int wr, int wc, int fr, int fq) const {
        typedef unsigned u32x2v __attribute__((ext_vector_type(2)));
        asm volatile("" : "+v"(fr), "+v"(fq));
        const int row0 = u.pm * BM + wr * 64 + fr, col0 = u.pn * BM + wc * 32 + 8 * fq;
        u32x2v ra[MERGE_DEPTH + 1][2], rb[MERGE_DEPTH + 1][2];
#pragma unroll
        for (int g = 0; g < MERGE_DEPTH; ++g) { const size_t off = (size_t)(row0 + (g >> 2) * HALF + (g & 3) * 16) * 1024 + col0;
#pragma unroll
            for (int bj = 0; bj < 2; ++bj) { ra[g][bj] = *(const u32x2v*)(GA + off + bj * HALF); rb[g][bj] = *(const u32x2v*)(GB + off + bj * HALF); } }
#pragma unroll
        for (int g = 0; g < 8; ++g) { const int ai = g >> 2, m = g & 3, sl = g % (MERGE_DEPTH + 1);
            asm volatile("" ::: "memory");
            if (g + MERGE_DEPTH < 8) { const int g2 = g + MERGE_DEPTH, s2 = g2 % (MERGE_DEPTH + 1); const size_t off = (size_t)(row0 + (g2 >> 2) * HALF + (g2 & 3) * 16) * 1024 + col0;
#pragma unroll
                for (int bj = 0; bj < 2; ++bj) { ra[s2][bj] = *(const u32x2v*)(GA + off + bj * HALF); rb[s2][bj] = *(const u32x2v*)(GB + off + bj * HALF); } }
            asm volatile("" ::: "memory");
#pragma unroll
            for (int bj = 0; bj < 2; ++bj) { const u32x2v a = ra[sl][bj], b = rb[sl][bj];
#pragma unroll
                for (int i = 0; i < 4; ++i) { acc[ai][bj][m][0][i] *= ub(a.x, i) * __builtin_amdgcn_rcpf(fmaxf(ub(b.x, i), 1.0f)); acc[ai][bj][m][1][i] *= ub(a.y, i) * __builtin_amdgcn_rcpf(fmaxf(ub(b.y, i), 1.0f)); } } }
    }
    __device__ __forceinline__ void operator()(const f32x4 (&acc)[2][2][4][2], const Unit& u, int wr, int wc, int fr, int fq) const {
        typedef unsigned u32x2v __attribute__((ext_vector_type(2)));
        const int row0 = u.pm * BM + wr * 64 + fr, col0 = u.pn * BM + wc * 32 + 8 * fq;
        u32x2v gq[2][4][2];
#pragma unroll
        for (int ai = 0; ai < 2; ++ai)
#pragma unroll
            for (int m = 0; m < 4; ++m)
#pragma unroll
                for (int bj = 0; bj < 2; ++bj) gq[ai][m][bj] = *(const u32x2v*)(GB + (size_t)(row0 + ai * HALF + m * 16) * 1024 + col0 + bj * HALF);
#pragma unroll
        for (int ai = 0; ai < 2; ++ai)
#pragma unroll
            for (int m = 0; m < 4; ++m) { const size_t off = (size_t)(row0 + ai * HALF + m * 16) * 1024 + col0;
#pragma unroll
                for (int bj = 0; bj < 2; ++bj) { const u32x2v g = gq[ai][m][bj];
                    const f32x4 a0 = acc[ai][bj][m][0], a1 = acc[ai][bj][m][1];
                    float r[8];
#pragma unroll
                    for (int i = 0; i < 4; ++i) { r[i] = fmaxf(ub(g.x, i), 1.0f) * (1.0f / 255.0f) * a0[i]; r[4 + i] = fmaxf(ub(g.y, i), 1.0f) * (1.0f / 255.0f) * a1[i]; }
                    u32x4 w; w.x = cvt_pk_bf16(r[0], r[1]); w.y = cvt_pk_bf16(r[2], r[3]); w.z = cvt_pk_bf16(r[4], r[5]); w.w = cvt_pk_bf16(r[6], r[7]);
                    WT16((O + off + bj * HALF), w); } }
    }
};
struct EpiRes {
    static constexpr bool APERM = false;
    static constexpr bool PRE = false;
    static constexpr int dup = EPIDUP_RES;
    static constexpr int MIDK = 0; static constexpr bool PERM = true, AFTER_DRAIN = false;
    const bf16_t* X; const float* RMS; bf16_t* XB; float* SSQ;
    __device__ __forceinline__ void operator()(const f32x4 (&acc)[2][2][4][2], const Unit& u, int wr, int wc, int fr, int fq) const {
        const int row0 = u.pm * BM + wr * 64 + fr, col0 = u.pn * BM + wc * 32 + 8 * fq;
        float rmq[2][4];
#pragma unroll
        for (int ai = 0; ai < 2; ++ai)
#pragma unroll
            for (int m = 0; m < 4; ++m) rmq[ai][m] = RMS[row0 + ai * HALF + m * 16];
        u32x4 xq[2][4][2];
#pragma unroll
        for (int m = 0; m < 4; ++m)
#pragma unroll
            for (int bj = 0; bj < 2; ++bj) xq[0][m][bj] = *(const u32x4*)(X + (size_t)(row0 + m * 16) * 1024 + col0 + bj * HALF);
        u32x4 wres[2][4][2]; float sres[2][4];
#pragma unroll
        for (int ai = 0; ai < 2; ++ai)
#pragma unroll
            for (int m = 0; m < 4; ++m) { float s = 0.f; const float rm = rmq[ai][m];
                if (ai == 0) {
#pragma unroll
                    for (int bj = 0; bj < 2; ++bj) xq[1][m][bj] = *(const u32x4*)(X + (size_t)(row0 + HALF + m * 16) * 1024 + col0 + bj * HALF); }
#pragma unroll
                for (int bj = 0; bj < 2; ++bj) { const u32x4 xr = xq[ai][m][bj];
                    const f32x4 x0 = (f32x4){bf_lo(xr.x), bf_hi(xr.x), bf_lo(xr.y), bf_hi(xr.y)}, x1 = (f32x4){bf_lo(xr.z), bf_hi(xr.z), bf_lo(xr.w), bf_hi(xr.w)};
                    const f32x4 o0 = x0 * rm + acc[ai][bj][m][0], o1 = x1 * rm + acc[ai][bj][m][1];
                    s += (o0[0] * o0[0] + o0[1] * o0[1]) + (o0[2] * o0[2] + o0[3] * o0[3]); s += (o1[0] * o1[0] + o1[1] * o1[1]) + (o1[2] * o1[2] + o1[3] * o1[3]);
                    u32x4 w; w.x = cvt_pk_bf16(o0[0], o0[1]); w.y = cvt_pk_bf16(o0[2], o0[3]); w.z = cvt_pk_bf16(o1[0], o1[1]); w.w = cvt_pk_bf16(o1[2], o1[3]); wres[ai][m][bj] = w; }
                s += __shfl_xor(s, 16); s += __shfl_xor(s, 32);
                sres[ai][m] = s; }
#pragma unroll
        for (int ai = 0; ai < 2; ++ai)
#pragma unroll
            for (int m = 0; m < 4; ++m) { const int row = row0 + ai * HALF + m * 16; const size_t off = (size_t)row * 1024 + col0;
#pragma unroll
                for (int bj = 0; bj < 2; ++bj) WT16((XB + off + bj * HALF), wres[ai][m][bj]);
                if (fq == 0) SSQ[(size_t)row * 16 + u.pn * 4 + wc] = sres[ai][m]; }
    }
};
struct EpiAcc {
    static constexpr bool APERM = false;
    static constexpr bool PRE = false;
    static constexpr int dup = EPIDUP_ACC;
    static constexpr int MIDK = 0; static constexpr bool PERM = true, AFTER_DRAIN = false;
    const bf16_t* XB; float* OUT;
    __device__ __forceinline__ void operator()(const f32x4 (&acc)[2][2][4][2], const Unit& u, int wr, int wc, int fr, int fq) const {
        const int row0 = u.pm * BM + wr * 64 + fr, col0 = u.pn * BM + wc * 32 + 8 * fq;
        u32x4 xr[2][4][2];
#pragma unroll
        for (int m = 0; m < 4; ++m)
#pragma unroll
            for (int bj = 0; bj < 2; ++bj) xr[0][m][bj] = *(const u32x4*)(XB + (size_t)(row0 + m * 16) * 1024 + col0 + bj * HALF);
        f32x4 o[2][4][2][2];
#pragma unroll
        for (int ai = 0; ai < 2; ++ai)
#pragma unroll
            for (int m = 0; m < 4; ++m) {
                if (ai == 0) {
#pragma unroll
                    for (int bj = 0; bj < 2; ++bj) xr[1][m][bj] = *(const u32x4*)(XB + (size_t)(row0 + HALF + m * 16) * 1024 + col0 + bj * HALF); }
#pragma unroll
                for (int bj = 0; bj < 2; ++bj) { const u32x4 xb = xr[ai][m][bj];
                    const f32x4 x0 = (f32x4){bf_lo(xb.x), bf_hi(xb.x), bf_lo(xb.y), bf_hi(xb.y)}, x1 = (f32x4){bf_lo(xb.z), bf_hi(xb.z), bf_lo(xb.w), bf_hi(xb.w)};
                    o[ai][m][bj][0] = x0 + acc[ai][bj][m][0]; o[ai][m][bj][1] = x1 + acc[ai][bj][m][1]; } }
#pragma unroll
        for (int ai = 0; ai < 2; ++ai)
#pragma unroll
            for (int m = 0; m < 4; ++m) { const size_t off = (size_t)(row0 + ai * HALF + m * 16) * 1024 + col0;
#pragma unroll
                for (int bj = 0; bj < 2; ++bj) { WT16F((OUT + off + bj * HALF), o[ai][m][bj][0]); WT16F((OUT + off + bj * HALF + 4), o[ai][m][bj][1]); } }
    }
};
struct EpiUp {
    static constexpr bool APERM = false;
    static constexpr bool PRE = false;
    static constexpr int dup = 0;
    static constexpr int MIDK = 0; static constexpr bool PERM = true, AFTER_DRAIN = false;
    bf16_t* H; bf16_t* HALO; bf16_t* SCR; const float* SSQ; const float* fw; const float* fb; int dff;
    __device__ __forceinline__ void operator()(const f32x4 (&acc)[2][2][4][2], const Unit& u, int wr, int wc, int fr, int fq) const {
        const int nup = 2 * dff;
        {
            const int col0 = wc * 32 + 8 * fq;
#pragma unroll
            for (int ai = 0; ai < 2; ++ai)
#pragma unroll
                for (int m = 0; m < 4; ++m) { asm volatile("" ::: "memory"); const int rl = ai * HALF + wr * 64 + m * 16 + fr; const int row = u.pm * BM + rl; float ss = 0.f;
#pragma unroll
                    for (int q = 0; q < 4; ++q) { const f32x4 p = *(const f32x4*)(SSQ + (size_t)row * 16 + q * 4); ss += (p[0] + p[1]) + (p[2] + p[3]); }
                    const float ri = 1.0f / sqrtf(ss * (1.0f / 1024.0f) + 1e-6f);
#pragma unroll
                    for (int bj = 0; bj < 2; ++bj) { const f32x4 v0 = acc[ai][bj][m][0] * ri, v1 = acc[ai][bj][m][1] * ri;
                        u32x4 w; w.x = cvt_pk_bf16(v0[0], v0[1]); w.y = cvt_pk_bf16(v0[2], v0[3]); w.z = cvt_pk_bf16(v1[0], v1[1]); w.w = cvt_pk_bf16(v1[2], v1[3]);
                        *(u32x4*)(SCR + rl * 256 + bj * HALF + col0) = w; } }
        }
        asm volatile("s_waitcnt vmcnt(0) lgkmcnt(0)" ::: "memory"); __builtin_amdgcn_s_barrier(); asm volatile("" ::: "memory");
        {
            int tid = threadIdx.x; asm volatile("" : "+v"(tid));
            const int cg8 = (tid & 15) * 8, rg = tid >> 4, r0 = rg * 8;
            const int ch = u.pn * 128 + cg8;
            float wgt[3][2][8], bia[2][8];
#pragma unroll
            for (int gv = 0; gv < 2; ++gv) {
#pragma unroll
                for (int h4 = 0; h4 < 2; ++h4) { const f32x4 b4 = *(const f32x4*)(fb + gv * dff + ch + 4 * h4);
#pragma unroll
                    for (int i = 0; i < 4; ++i) bia[gv][4 * h4 + i] = b4[i];
#pragma unroll
                    for (int j = 0; j < 3; ++j) { const f32x4 w4 = *(const f32x4*)(fw + (size_t)j * nup + gv * dff + ch + 4 * h4);
#pragma unroll
                        for (int i = 0; i < 4; ++i) wgt[j][gv][4 * h4 + i] = w4[i]; } }
            }
            float p2[2][8], p1[2][8];
#pragma unroll
            for (int gv = 0; gv < 2; ++gv)
#pragma unroll
                for (int i = 0; i < 8; ++i) { p2[gv][i] = 0.f; p1[gv][i] = 0.f; }
            if (rg > 0) {
#pragma unroll
                for (int gv = 0; gv < 2; ++gv) { const u32x4 a = __builtin_nontemporal_load((const u32x4*)(SCR + (r0 - 2) * 256 + gv * HALF + cg8)), b = __builtin_nontemporal_load((const u32x4*)(SCR + (r0 - 1) * 256 + gv * HALF + cg8));
                    p2[gv][0] = bf_lo(a.x); p2[gv][1] = bf_hi(a.x); p2[gv][2] = bf_lo(a.y); p2[gv][3] = bf_hi(a.y); p2[gv][4] = bf_lo(a.z); p2[gv][5] = bf_hi(a.z); p2[gv][6] = bf_lo(a.w); p2[gv][7] = bf_hi(a.w);
                    p1[gv][0] = bf_lo(b.x); p1[gv][1] = bf_hi(b.x); p1[gv][2] = bf_lo(b.y); p1[gv][3] = bf_hi(b.y); p1[gv][4] = bf_lo(b.z); p1[gv][5] = bf_hi(b.z); p1[gv][6] = bf_lo(b.w); p1[gv][7] = bf_hi(b.w); }
            }
#pragma unroll
            for (int k = 0; k < 8; ++k) {
                const int rl = r0 + k;
                u32x4 raw[2]; float c[2][8];
#pragma unroll
                for (int gv = 0; gv < 2; ++gv) { raw[gv] = __builtin_nontemporal_load((const u32x4*)(SCR + rl * 256 + gv * HALF + cg8));
                    c[gv][0] = bf_lo(raw[gv].x); c[gv][1] = bf_hi(raw[gv].x); c[gv][2] = bf_lo(raw[gv].y); c[gv][3] = bf_hi(raw[gv].y); c[gv][4] = bf_lo(raw[gv].z); c[gv][5] = bf_hi(raw[gv].z); c[gv][6] = bf_lo(raw[gv].w); c[gv][7] = bf_hi(raw[gv].w); }
                if (rl < 2 || rl >= 254) {
                    bf16_t* hp = HALO + ((size_t)u.pm * 4 + (rl < 2 ? rl : rl - 252)) * nup + u.pn * BM + cg8;
                    *(u32x4*)hp = raw[0]; *(u32x4*)(hp + HALF) = raw[1]; }
                float hh[8];
#pragma unroll
                for (int i = 0; i < 8; ++i) {
                    const float yg = bia[0][i] + wgt[0][0][i] * p2[0][i] + wgt[1][0][i] * p1[0][i] + wgt[2][0][i] * c[0][i];
                    const float yv = bia[1][i] + wgt[0][1][i] * p2[1][i] + wgt[1][1][i] * p1[1][i] + wgt[2][1][i] * c[1][i];
                    hh[i] = yg * sigmoidf_(yg) * yv;
                    p2[0][i] = p1[0][i]; p1[0][i] = c[0][i]; p2[1][i] = p1[1][i]; p1[1][i] = c[1][i];
                }
                if (rl >= 2) { u32x4 w; w.x = cvt_pk_bf16(hh[0], hh[1]); w.y = cvt_pk_bf16(hh[2], hh[3]); w.z = cvt_pk_bf16(hh[4], hh[5]); w.w = cvt_pk_bf16(hh[6], hh[7]);
                    *(u32x4*)(H + (size_t)(u.pm * BM + rl) * dff + ch) = w; }
            }
        }
    }
};
__device__ __forceinline__ float dpp_shr1(float oldv, float src) { return __builtin_bit_cast(float, __builtin_amdgcn_update_dpp(__builtin_bit_cast(int, oldv), __builtin_bit_cast(int, src), 0x111, 0xf, 0xf, false)); }
__device__ __forceinline__ float dpp_shr2(float oldv, float src) { return __builtin_bit_cast(float, __builtin_amdgcn_update_dpp(__builtin_bit_cast(int, oldv), __builtin_bit_cast(int, src), 0x112, 0xf, 0xf, false)); }
__device__ __forceinline__ float dpp_shl15(float src) { return __builtin_bit_cast(float, __builtin_amdgcn_update_dpp(0, __builtin_bit_cast(int, src), 0x10F, 0xf, 0xf, false)); }
__device__ __forceinline__ float dpp_shl14(float src) { return __builtin_bit_cast(float, __builtin_amdgcn_update_dpp(0, __builtin_bit_cast(int, src), 0x10E, 0xf, 0xf, false)); }
struct EpiUpR {
    static constexpr bool APERM = UP_APERM;
    static constexpr bool PRE = UP_PRE;
    static constexpr int dup = EPIDUP_UP;
    static constexpr int MIDK = 0; static constexpr bool PERM = true, AFTER_DRAIN = false;
    bf16_t* H; bf16_t* HALO; const float* SSQ; const float* fw; const float* fb; PG8_LAS unsigned char* xl; int dff;
    __device__ __forceinline__ void pre(const Unit& u) const {
        int tid = threadIdx.x; asm volatile("" : "+v"(tid));
        const int w = __builtin_amdgcn_readfirstlane(tid >> 6);
        if (w < 4) {
            const int nup = 2 * dff;
            const int e = tid * 4, kgv = e >> 7, k = kgv >> 1, gv = kgv & 1, c = e & 127;
            const float* src = (k < 3 ? fw + (size_t)k * nup : fb) + gv * dff + u.pn * 128 + c;
            __builtin_amdgcn_global_load_lds((const unsigned*)src, (PG8_LAS unsigned*)(xl + 8192 + w * 1024), 16, 0, 0);
            const float* sp = SSQ + (size_t)(u.pm * BM + tid) * 16;
#pragma unroll
            for (int q = 0; q < 4; ++q) __builtin_amdgcn_global_load_lds((const unsigned*)(sp + q * 4), (PG8_LAS unsigned*)(xl + 13312 + q * 4096 + w * 1024), 16, 0, 0);
        }
    }
    __device__ __forceinline__ void operator()(f32x4 (&acc)[2][2][4][2], const Unit& u, int wr, int wc, int fr, int fq) const {
        typedef unsigned u32x2v __attribute__((ext_vector_type(2)));
        asm volatile("" : "+v"(fr), "+v"(fq));
        const int nup = 2 * dff;
        const int colt = wc * 32 + 8 * fq;
        const int ch0 = u.pn * 128 + colt;
        const int row0 = u.pm * BM + wr * 64 + fr;
        PG8_LAS float* slab = (PG8_LAS float*)xl;
        PG8_LAS float* wl = (PG8_LAS float*)(xl + 8192);
        PG8_LAS float* rl = (PG8_LAS float*)(xl + 12288);
        if (PRE) {
            asm volatile("s_waitcnt vmcnt(16)" ::: "memory"); __builtin_amdgcn_s_barrier(); asm volatile("" ::: "memory");
            int tid = threadIdx.x; asm volatile("" : "+v"(tid));
            if (tid < 256) { const PG8_LAS f32x4* sq = (const PG8_LAS f32x4*)(xl + 13312);
                const f32x4 ps = (sq[tid] + sq[256 + tid]) + (sq[512 + tid] + sq[768 + tid]);
                rl[tid] = __builtin_amdgcn_rsqf(((ps[0] + ps[1]) + (ps[2] + ps[3])) * (1.0f / 1024.0f) + 1e-6f); }
        } else {
            int tid = threadIdx.x; asm volatile("" : "+v"(tid));
            if (tid < 256) { const int e = tid * 4, kgv = e >> 7, k = kgv >> 1, gv = kgv & 1, c = e & 127;
                const float* src = (k < 3 ? fw + (size_t)k * nup : fb) + gv * dff + u.pn * 128 + c;
                *(PG8_LAS f32x4*)(wl + e) = *(const f32x4*)src;
                const int row = u.pm * BM + tid; const f32x4 p0 = *(const f32x4*)(SSQ + (size_t)row * 16), p1 = *(const f32x4*)(SSQ + (size_t)row * 16 + 4), p2 = *(const f32x4*)(SSQ + (size_t)row * 16 + 8), p3 = *(const f32x4*)(SSQ + (size_t)row * 16 + 12);
                const f32x4 ps = (p0 + p1) + (p2 + p3);
                rl[tid] = __builtin_amdgcn_rsqf(((ps[0] + ps[1]) + (ps[2] + ps[3])) * (1.0f / 1024.0f) + 1e-6f); }
        }
        asm volatile("s_waitcnt lgkmcnt(0)" ::: "memory"); __builtin_amdgcn_s_barrier(); asm volatile("" ::: "memory");
#pragma unroll
        for (int ai = 0; ai < 2; ++ai)
#pragma unroll
            for (int m = 0; m < 4; ++m) { const float ri = rl[wr * 64 + ai * HALF + (APERM ? 4 * fr + m : fr + m * 16)];
#pragma unroll
                for (int bj = 0; bj < 2; ++bj)
#pragma unroll
                    for (int n = 0; n < 2; ++n) acc[ai][bj][m][n] = acc[ai][bj][m][n] * ri; }
#if UP_APERM
        if (fr == 15) {
#pragma unroll
            for (int ai = 0; ai < 2; ++ai)
#pragma unroll
                for (int q = 0; q < 2; ++q)
#pragma unroll
                    for (int bj = 0; bj < 2; ++bj)
#pragma unroll
                        for (int n = 0; n < 2; ++n) *(PG8_LAS f32x4*)(slab + ((2 * ai + wr) * 2 + q) * 256 + bj * HALF + colt + 4 * n) = acc[ai][bj][2 + q][n];
            if (wr == 1) {
#pragma unroll
                for (int q = 0; q < 2; ++q)
#pragma unroll
                    for (int bj = 0; bj < 2; ++bj) { const f32x4 v0 = acc[1][bj][2 + q][0], v1 = acc[1][bj][2 + q][1];
                        u32x4 w; w.x = cvt_pk_bf16(v0[0], v0[1]); w.y = cvt_pk_bf16(v0[2], v0[3]); w.z = cvt_pk_bf16(v1[0], v1[1]); w.w = cvt_pk_bf16(v1[2], v1[3]);
                        *(u32x4*)(HALO + ((size_t)u.pm * 4 + 2 + q) * nup + u.pn * BM + bj * HALF + colt) = w; }
            }
        }
        if (fr == 0 && wr == 0) {
#pragma unroll
            for (int q = 0; q < 2; ++q)
#pragma unroll
                for (int bj = 0; bj < 2; ++bj) { const f32x4 v0 = acc[0][bj][q][0], v1 = acc[0][bj][q][1];
                    u32x4 w; w.x = cvt_pk_bf16(v0[0], v0[1]); w.y = cvt_pk_bf16(v0[2], v0[3]); w.z = cvt_pk_bf16(v1[0], v1[1]); w.w = cvt_pk_bf16(v1[2], v1[3]);
                    *(u32x4*)(HALO + ((size_t)u.pm * 4 + q) * nup + u.pn * BM + bj * HALF + colt) = w; }
        }
        asm volatile("s_waitcnt lgkmcnt(0)" ::: "memory"); __builtin_amdgcn_s_barrier(); asm volatile("" ::: "memory");
        int fr3 = fr; asm volatile("" : "+v"(fr3));
        const int row3 = u.pm * BM + wr * 64 + 4 * fr3;
        f32x4 wq[2][2][4];
#pragma unroll
        for (int n = 0; n < 2; ++n)
#pragma unroll
            for (int gv = 0; gv < 2; ++gv)
#pragma unroll
                for (int k = 0; k < 4; ++k) wq[n][gv][k] = *(const PG8_LAS f32x4*)(wl + colt + 4 * n + 256 * k + gv * 128);
#pragma unroll
        for (int ai = 0; ai < 2; ++ai) {
            const int blk = 2 * ai + wr;
            f32x4 hv[4][2];
#pragma unroll
            for (int n = 0; n < 2; ++n) {
                f32x4 y[2][4];
#pragma unroll
                for (int gv = 0; gv < 2; ++gv) {
                    const f32x4 w0 = wq[n][gv][0], w1 = wq[n][gv][1], w2 = wq[n][gv][2], bb = wq[n][gv][3];
                    f32x4 p1 = (f32x4){0.f, 0.f, 0.f, 0.f}, p2 = p1;
                    if (blk > 0) { const PG8_LAS float* sp = slab + ((blk - 1) * 2) * 256 + gv * HALF + colt + 4 * n; p2 = *(const PG8_LAS f32x4*)sp; p1 = *(const PG8_LAS f32x4*)(sp + 256); }
                    const f32x4 a0 = acc[ai][gv][0][n], a1 = acc[ai][gv][1][n], a2 = acc[ai][gv][2][n], a3 = acc[ai][gv][3][n];
                    f32x4 m1, m2;
#pragma unroll
                    for (int i = 0; i < 4; ++i) { m1[i] = dpp_shr1(p1[i], a3[i]); m2[i] = dpp_shr1(p2[i], a2[i]); }
                    y[gv][0] = ((bb + w0 * m2) + w1 * m1) + w2 * a0;
                    y[gv][1] = ((bb + w0 * m1) + w1 * a0) + w2 * a1;
                    y[gv][2] = ((bb + w0 * a0) + w1 * a1) + w2 * a2;
                    y[gv][3] = ((bb + w0 * a1) + w1 * a2) + w2 * a3;
                }
#pragma unroll
                for (int m = 0; m < 4; ++m)
#pragma unroll
                    for (int i = 0; i < 4; ++i) hv[m][n][i] = y[0][m][i] * sigmoidf_(y[0][m][i]) * y[1][m][i];
            }
#pragma unroll
            for (int m = 0; m < 4; ++m) {
                if (!(blk == 0 && fr3 == 0 && m < 2)) { u32x4 w; w.x = cvt_pk_bf16(hv[m][0][0], hv[m][0][1]); w.y = cvt_pk_bf16(hv[m][0][2], hv[m][0][3]); w.z = cvt_pk_bf16(hv[m][1][0], hv[m][1][1]); w.w = cvt_pk_bf16(hv[m][1][2], hv[m][1][3]);
                    WT16((H + (size_t)(row3 + ai * HALF + m) * dff + ch0), w); }
            }
        }
#else
        if (fr >= 14) {
#pragma unroll
            for (int ai = 0; ai < 2; ++ai)
#pragma unroll
                for (int bj = 0; bj < 2; ++bj)
#pragma unroll
                    for (int n = 0; n < 2; ++n) *(PG8_LAS f32x4*)(slab + ((2 * ai + wr) * 2 + (fr - 14)) * 256 + bj * HALF + colt + 4 * n) = acc[ai][bj][3][n];
            if (wr == 1) {
#pragma unroll
                for (int bj = 0; bj < 2; ++bj) { const f32x4 v0 = acc[1][bj][3][0], v1 = acc[1][bj][3][1];
                    u32x4 w; w.x = cvt_pk_bf16(v0[0], v0[1]); w.y = cvt_pk_bf16(v0[2], v0[3]); w.z = cvt_pk_bf16(v1[0], v1[1]); w.w = cvt_pk_bf16(v1[2], v1[3]);
                    *(u32x4*)(HALO + ((size_t)u.pm * 4 + 2 + (fr - 14)) * nup + u.pn * BM + bj * HALF + colt) = w; }
            }
        }
        if (fr < 2 && wr == 0) {
#pragma unroll
            for (int bj = 0; bj < 2; ++bj) { const f32x4 v0 = acc[0][bj][0][0], v1 = acc[0][bj][0][1];
                u32x4 w; w.x = cvt_pk_bf16(v0[0], v0[1]); w.y = cvt_pk_bf16(v0[2], v0[3]); w.z = cvt_pk_bf16(v1[0], v1[1]); w.w = cvt_pk_bf16(v1[2], v1[3]);
                *(u32x4*)(HALO + ((size_t)u.pm * 4 + fr) * nup + u.pn * BM + bj * HALF + colt) = w; }
        }
        asm volatile("s_waitcnt lgkmcnt(0)" ::: "memory"); __builtin_amdgcn_s_barrier(); asm volatile("" ::: "memory");
        int fr3 = fr; asm volatile("" : "+v"(fr3));
        const int row3 = u.pm * BM + wr * 64 + fr3;
#if UP_WREG
        f32x4 wq[2][2][4];
#pragma unroll
        for (int n = 0; n < 2; ++n)
#pragma unroll
            for (int gv = 0; gv < 2; ++gv)
#pragma unroll
                for (int k = 0; k < 4; ++k) wq[n][gv][k] = *(const PG8_LAS f32x4*)(wl + colt + 4 * n + 256 * k + gv * 128);
#endif
#pragma unroll
        for (int ai = 0; ai < 2; ++ai) {
            const int blk = 2 * ai + wr;
#pragma unroll
            for (int m = 3; m >= 0; --m) {
                f32x4 hv[2];
#pragma unroll
                for (int n = 0; n < 2; ++n) {
                    if (UP_SCHEDBAR) asm volatile("" ::: "memory");
                    const PG8_LAS float* wp = wl + colt + 4 * n;
                    f32x4 yg, yv;
#pragma unroll
                    for (int gv = 0; gv < 2; ++gv) {
#if UP_WREG
                        const f32x4 w0 = wq[n][gv][0], w1 = wq[n][gv][1], w2 = wq[n][gv][2], bb = wq[n][gv][3]; (void)wp;
#else
                        const f32x4 w0 = *(const PG8_LAS f32x4*)(wp + gv * 128), w1 = *(const PG8_LAS f32x4*)(wp + 256 + gv * 128), w2 = *(const PG8_LAS f32x4*)(wp + 512 + gv * 128), bb = *(const PG8_LAS f32x4*)(wp + 768 + gv * 128);
#endif
                        const f32x4 cc = acc[ai][gv][m][n];
                        f32x4 o1 = (f32x4){0.f, 0.f, 0.f, 0.f}, o2 = o1;
                        if (m > 0) { const f32x4 pp = acc[ai][gv][m - 1][n];
#pragma unroll
                            for (int i = 0; i < 4; ++i) { o1[i] = dpp_shl15(pp[i]); o2[i] = dpp_shl14(pp[i]); } }
                        else if (blk > 0) { const PG8_LAS float* sp = slab + ((blk - 1) * 2) * 256 + gv * HALF + colt + 4 * n; const int r2 = (fr3 == 0) ? 0 : 256;
                            o1 = *(const PG8_LAS f32x4*)(sp + 256); o2 = *(const PG8_LAS f32x4*)(sp + r2); }
                        f32x4 x1v, x2v;
#pragma unroll
                        for (int i = 0; i < 4; ++i) { x1v[i] = dpp_shr1(o1[i], cc[i]); x2v[i] = dpp_shr2(o2[i], cc[i]); }
                        const f32x4 y = ((bb + w0 * x2v) + w1 * x1v) + w2 * cc;
                        if (gv == 0) yg = y; else yv = y;
                        if (UP_SCHEDBAR) __builtin_amdgcn_sched_barrier(0);
                    }
#pragma unroll
                    for (int i = 0; i < 4; ++i) hv[n][i] = yg[i] * sigmoidf_(yg[i]) * yv[i];
                }
                if (!(blk == 0 && m == 0 && fr3 < 2)) { u32x4 w; w.x = cvt_pk_bf16(hv[0][0], hv[0][1]); w.y = cvt_pk_bf16(hv[0][2], hv[0][3]); w.z = cvt_pk_bf16(hv[1][0], hv[1][1]); w.w = cvt_pk_bf16(hv[1][2], hv[1][3]);
                    WT16((H + (size_t)(row3 + ai * HALF + m * 16) * dff + ch0), w); }
            }
        }
#endif
    }
};
template <class Epi, class Sched, bool ALIGN_EPI = false, bool SP2 = false>
__device__ __forceinline__ void gemm_phase(PG8_LAS unsigned char* lds, const Gemm g, const Sched& S, const Epi& E) {
    const int tid = threadIdx.x, wid = __builtin_amdgcn_readfirstlane(tid >> 6), lane = tid & 63, wr = wid >> 2, wc = wid & 3, fr = lane & 15, fq = lane >> 4;
    const int K = g.K, nt = K / BK;
    auto krot = [&](const Unit& u) -> int { return (Epi::MIDK > 0 || !PG8_KROT) ? 0 : 2 * ((u.pm + 2 * u.pn) % (nt >> 1)); };
    unsigned voffA[2], voffB[2];
#pragma unroll
    for (int i = 0; i < 2; ++i) { int R, C; stage_rc(tid * 16 + i * 8192, R, C); const int Rb = Epi::PERM ? ((R & ~31) + perm32(R & 31)) : R;
        const int Ra = Epi::APERM ? ((R & ~63) + 4 * (R & 15) + ((R >> 4) & 3)) : R;
        voffA[i] = (unsigned)(Ra * K + C) * 2u; voffB[i] = (unsigned)(Rb * K + C) * 2u; }
    const size_t kstep = (size_t)(BK * 2);
    const size_t hstep = (size_t)HALF * K * 2;
    const size_t tstep = 2 * hstep;
    const unsigned ldsw = (unsigned)wid * 1024u;
    const int aoff = lds_byte(wr * 64 + fr, fq * 8), boff = lds_byte(wc * 32 + fr, fq * 8);
#define PG8_SA(b, h) (((b) * 2 + (h)) * HTB)
#define PG8_SB(b, h) ((4 + (b) * 2 + (h)) * HTB)
#define PG8_STAGE(bufoff, gbase, voff) do { _Pragma("unroll") for (int _i = 0; _i < 2; ++_i) \
        __builtin_amdgcn_global_load_lds((const unsigned*)((const char*)(gbase) + (voff)[_i]), (PG8_LAS unsigned*)(lds + (bufoff) + ldsw + _i * 8192), 16, 0, 0); } while (0)
#define PG8_LDA(dst, b, h) do { _Pragma("unroll") for (int m = 0; m < 4; ++m) _Pragma("unroll") for (int k = 0; k < 2; ++k) dst[m][k] = *(const PG8_LAS bf16x8*)(lds + PG8_SA(b, h) + aoff + m * 2048 + k * 1024); } while (0)
#define PG8_LDB(dst, b, h) do { _Pragma("unroll") for (int n = 0; n < 2; ++n) _Pragma("unroll") for (int k = 0; k < 2; ++k) dst[n][k] = *(const PG8_LAS bf16x8*)(lds + PG8_SB(b, h) + boff + n * 2048 + k * 1024); } while (0)
#define PG8_MMA(ai, bj, At, Bt) do { __builtin_amdgcn_s_setprio(1); _Pragma("unroll") for (int m = 0; m < 4; ++m) _Pragma("unroll") for (int n = 0; n < 2; ++n) _Pragma("unroll") for (int k = 0; k < 2; ++k) \
        acc[ai][bj][m][n] = __builtin_amdgcn_mfma_f32_16x16x32_bf16(Bt[n][k], At[m][k], acc[ai][bj][m][n], 0, 0, 0); __builtin_amdgcn_s_setprio(0); } while (0)
#define PG8_WAIT_V(n) asm volatile("s_waitcnt vmcnt(" #n ")" ::: "memory")
#define PG8_WAIT_L(n) asm volatile("s_waitcnt lgkmcnt(" #n ")" ::: "memory")
#define PG8_BAR __builtin_amdgcn_s_barrier()
#define PG8_SCHED __builtin_amdgcn_sched_barrier(0)
    Unit cur, nxt; int ui = 0;
    if (!S.next(0, cur)) return;
    f32x4 acc[2][2][4][2];
#pragma unroll
    for (int a = 0; a < 2; ++a)
#pragma unroll
        for (int b = 0; b < 2; ++b)
#pragma unroll
            for (int m = 0; m < 4; ++m)
#pragma unroll
                for (int n = 0; n < 2; ++n) acc[a][b][m][n] = (f32x4){0.f, 0.f, 0.f, 0.f};
    bf16x8 At[4][2], B0[2][2], B1[2][2];
    const char* cA = (const char*)g.A + (size_t)cur.pm * tstep; const char* cB = (const char*)g.Bt + (size_t)cur.pn * tstep;
    S.a_ready(cur);
    int rc = krot(cur);
    { const char* cA0 = cA; const char* cB0 = cB; cA = cA0 + (size_t)rc * kstep; cB = cB0 + (size_t)rc * kstep;
    if constexpr (SP2) {
        PG8_STAGE(PG8_SB(0, 0), cB, voffB); PG8_STAGE(PG8_SB(0, 1), cB + hstep, voffB); PG8_STAGE(PG8_SA(0, 0), cA, voffA); PG8_STAGE(PG8_SA(0, 1), cA + hstep, voffA);
        if (wr == 1) PG8_BAR;
        PG8_WAIT_V(2); PG8_BAR;
        PG8_STAGE(PG8_SB(1, 0), cB + kstep, voffB); PG8_STAGE(PG8_SA(1, 0), cA + kstep, voffA); PG8_STAGE(PG8_SB(1, 1), cB + hstep + kstep, voffB);
        PG8_WAIT_V(6); PG8_BAR;
    } else {
        PG8_STAGE(PG8_SB(0, 0), cB, voffB); PG8_STAGE(PG8_SA(0, 0), cA, voffA); PG8_STAGE(PG8_SB(0, 1), cB + hstep, voffB); PG8_STAGE(PG8_SA(0, 1), cA + hstep, voffA);
        if (wr == 1) PG8_BAR;
        PG8_WAIT_V(4); PG8_BAR;
        PG8_STAGE(PG8_SB(1, 0), cB + kstep, voffB); PG8_STAGE(PG8_SA(1, 0), cA + kstep, voffA); PG8_STAGE(PG8_SB(1, 1), cB + hstep + kstep, voffB);
        PG8_WAIT_V(6); PG8_BAR;
    }
      cA = cA0; cB = cB0; }
    for (;;) {
        const bool has_next = S.next(ui + 1, nxt);
        const char* nA = has_next ? (const char*)g.A + (size_t)nxt.pm * tstep : cA; const char* nB = has_next ? (const char*)g.Bt + (size_t)nxt.pn * tstep : cB;
        const int rn = has_next ? krot(nxt) : rc;
        for (int t = 0; t < nt; t += 2) {
            const bool last = (t == nt - 2);
            int kt = t + rc; kt = kt >= nt ? kt - nt : kt; int kt2 = kt + 2; kt2 = kt2 >= nt ? kt2 - nt : kt2;
            const char* a1 = cA + (size_t)(kt + 1) * kstep;
            const char* a2 = last ? nA + (size_t)rn * kstep : cA + (size_t)kt2 * kstep; const char* b2 = last ? nB + (size_t)rn * kstep : cB + (size_t)kt2 * kstep;
            const char* a3 = a2 + kstep; const char* b3 = b2 + kstep;
            if (last && has_next) S.a_ready(nxt);
            if constexpr (Epi::PRE) { if (last) E.pre(cur); }
            if constexpr (Epi::MIDK > 0) { if (t == Epi::MIDK) E.mid(acc, cur, wr, wc, fr, fq); }
            if constexpr (SP2) {
            PG8_LDB(B0, 0, 0); PG8_LDB(B1, 0, 1); PG8_SCHED; PG8_LDA(At, 0, 0); PG8_STAGE(PG8_SA(1, 1), a1 + hstep, voffA);
            PG8_WAIT_V(8); PG8_WAIT_L(0); PG8_BAR; PG8_MMA(0, 0, At, B0); PG8_MMA(0, 1, At, B1); PG8_BAR; PG8_SCHED;
            PG8_LDA(At, 0, 1); PG8_STAGE(PG8_SB(0, 0), b2, voffB); PG8_STAGE(PG8_SB(0, 1), b2 + hstep, voffB); PG8_STAGE(PG8_SA(0, 0), a2, voffA);
            PG8_WAIT_V(8); PG8_WAIT_L(0); PG8_BAR; PG8_MMA(1, 0, At, B0); PG8_MMA(1, 1, At, B1); PG8_BAR; PG8_SCHED;
            PG8_LDB(B0, 1, 0); PG8_LDB(B1, 1, 1); PG8_SCHED; PG8_LDA(At, 1, 0); PG8_STAGE(PG8_SA(0, 1), a2 + hstep, voffA);
            PG8_WAIT_V(8); PG8_WAIT_L(0); PG8_BAR; PG8_MMA(0, 0, At, B0); PG8_MMA(0, 1, At, B1); PG8_BAR; PG8_SCHED;
            PG8_LDA(At, 1, 1); PG8_STAGE(PG8_SB(1, 0), b3, voffB); PG8_STAGE(PG8_SB(1, 1), b3 + hstep, voffB); PG8_STAGE(PG8_SA(1, 0), a3, voffA);
            PG8_WAIT_V(8); PG8_WAIT_L(0); PG8_BAR; PG8_MMA(1, 0, At, B0); PG8_MMA(1, 1, At, B1); PG8_BAR; PG8_SCHED;
            } else {
            PG8_LDB(B0, 0, 0); PG8_SCHED; PG8_LDA(At, 0, 0); PG8_STAGE(PG8_SA(1, 1), a1 + hstep, voffA);
            PG8_WAIT_L(8); PG8_BAR; PG8_WAIT_L(0); PG8_MMA(0, 0, At, B0); PG8_BAR; PG8_SCHED;
            PG8_LDB(B1, 0, 1); PG8_STAGE(PG8_SB(0, 0), b2, voffB);
            PG8_BAR; PG8_WAIT_L(0); PG8_MMA(0, 1, At, B1); PG8_BAR;
            PG8_LDA(At, 0, 1); PG8_STAGE(PG8_SA(0, 0), a2, voffA);
            PG8_BAR; PG8_WAIT_L(0); PG8_MMA(1, 0, At, B0); PG8_BAR; PG8_SCHED;
            PG8_STAGE(PG8_SB(0, 1), b2 + hstep, voffB);
            PG8_WAIT_V(6); PG8_BAR; PG8_MMA(1, 1, At, B1); PG8_BAR;
            PG8_LDB(B0, 1, 0); PG8_SCHED; PG8_LDA(At, 1, 0); PG8_STAGE(PG8_SA(0, 1), a2 + hstep, voffA);
            PG8_WAIT_L(8); PG8_BAR; PG8_WAIT_L(0); PG8_MMA(0, 0, At, B0); PG8_BAR; PG8_SCHED;
            PG8_LDB(B1, 1, 1); PG8_STAGE(PG8_SB(1, 0), b3, voffB);
            PG8_BAR; PG8_WAIT_L(0); PG8_MMA(0, 1, At, B1); PG8_BAR;
            PG8_LDA(At, 1, 1); PG8_STAGE(PG8_SA(1, 0), a3, voffA);
            PG8_BAR; PG8_WAIT_L(0); PG8_MMA(1, 0, At, B0); PG8_BAR; PG8_SCHED;
            PG8_STAGE(PG8_SB(1, 1), b3 + hstep, voffB);
            PG8_WAIT_V(6); PG8_BAR; PG8_MMA(1, 1, At, B1); PG8_BAR;
            }
        }
        if constexpr (ALIGN_EPI) { if (wr == 0) PG8_BAR; }
#ifdef EPI_DUP
        if constexpr (!Epi::AFTER_DRAIN) { if (E.dup) { E(acc, cur, wr, wc, fr, fq); asm volatile("" ::: "memory"); } }
#endif
        if constexpr (!Epi::AFTER_DRAIN) { E(acc, cur, wr, wc, fr, fq); S.done(cur); }
        if (!has_next) break;
#pragma unroll
        for (int a = 0; a < 2; ++a)
#pragma unroll
            for (int b = 0; b < 2; ++b)
#pragma unroll
                for (int m = 0; m < 4; ++m)
#pragma unroll
                    for (int n = 0; n < 2; ++n) acc[a][b][m][n] = (f32x4){0.f, 0.f, 0.f, 0.f};
        cur = nxt; cA = nA; cB = nB; rc = rn; ++ui;
        if constexpr (ALIGN_EPI) { if (wr == 1) PG8_BAR; }
    }
    PG8_WAIT_V(0);
    if constexpr (!ALIGN_EPI) { if (wr == 0) PG8_BAR; }
    PG8_BAR;
    if constexpr (Epi::AFTER_DRAIN) { E.fused(acc, cur, wr, wc, fr, fq, lds, wid, lane); S.done(cur); }
#undef PG8_SA
#undef PG8_SB
#undef PG8_STAGE
#undef PG8_LDA
#undef PG8_LDB
#undef PG8_MMA
#undef PG8_WAIT_V
#undef PG8_WAIT_L
#undef PG8_BAR
#undef PG8_SCHED
}
}
#include <cmath>

constexpr int NWAVES = 8;
constexpr int NB = 8, SEQ = 4096, M = NB * SEQ, DM = 1024;
constexpr int IN_TOTAL = 5188, NIN = 5376;
constexpr int PA_LD = 1280;
constexpr int PA_Q = 0, PA_K = 512, PA_V = 640, PA_QI = 768, PA_KI = 1024, PA_WI = 1088;
constexpr int DFF = 2816, NUP = 2 * DFF;
constexpr float EPS = 1e-6f;
constexpr int TOPK = 256;

#ifndef MK_ONE_LAUNCH
#define MK_ONE_LAUNCH 1
#endif
constexpr int NPH = 11;

constexpr size_t MiB = 1u << 20;
constexpr size_t WS_CTL = 0, CTL_ZERO_BYTES = 64 * 1024;
constexpr size_t WS_WIN = 1 * MiB, WS_WOA = 12 * MiB, WS_WOB = 13 * MiB, WS_WOUT = 15 * MiB, WS_WUP = 17 * MiB, WS_WDN = 28 * MiB;
constexpr size_t WS_RINV1 = 34 * MiB, WS_SSQ2 = 35 * MiB;
constexpr size_t WS_XB = 40 * MiB;
constexpr size_t WS_ATTN = 40 * MiB;
constexpr size_t OUT_KV = 16 * MiB;
constexpr size_t OUT_ARN = 32 * MiB;
constexpr size_t WS_KI = 35 * MiB;
constexpr size_t WS_WI = 34 * MiB + 256 * 1024;
constexpr size_t WS_GAINS = 34 * MiB + 128 * 1024;
constexpr size_t WS_PA = 104 * MiB;
constexpr size_t WS_RX = 184 * MiB, WS_RGATE = 248 * MiB, WS_GA = 312 * MiB, WS_GB = 376 * MiB;
constexpr size_t WS_MERGED = 104 * MiB;
constexpr size_t WS_X1B = 312 * MiB;
constexpr size_t WS_RNN = 440 * MiB;
constexpr size_t WS_H = 40 * MiB;
constexpr size_t WS_HALO = 216 * MiB;
constexpr size_t WS_SCR = 224 * MiB;
constexpr size_t WS_END = 504 * MiB;
static_assert(WS_WIN + (size_t)NIN * 1024 * 2 <= WS_WOA && WS_WUP + (size_t)NUP * 1024 * 2 <= WS_WDN && WS_WDN + (size_t)1024 * DFF * 2 <= WS_RINV1, "weights map");
static_assert(WS_H + (size_t)M * DFF * 2 <= WS_HALO && WS_HALO + (size_t)128 * 4 * NUP * 2 <= WS_SCR && WS_SCR + (size_t)256 * 65536 * 2 <= WS_X1B, "ffn map");
constexpr int CW_BAR = 4096, CW_QUEUE = 64;

constexpr int RING_OFF = 0, RING_BYTES = 131072, XSLAB_OFF = 131072;
constexpr int PHASE_LDS = 163072;
constexpr int LDSCTL_OFF = PHASE_LDS, MISC_OFF = LDSCTL_OFF + 320;
constexpr int LDS_BYTES = 163840;
static_assert(MISC_OFF + 128 <= LDS_BYTES && LDS_BYTES <= 163840, "LDS map");
#define GAS __attribute__((address_space(1)))
#define LAS __attribute__((address_space(3)))
typedef unsigned short bf16;
typedef unsigned v4u __attribute__((ext_vector_type(4)));
typedef float f32x4 __attribute__((ext_vector_type(4)));
typedef short bf16x8 __attribute__((ext_vector_type(8)));
typedef GAS unsigned gu32;
typedef GAS unsigned long long gu64;
#define RLX_AGENT __ATOMIC_RELAXED, __HIP_MEMORY_SCOPE_AGENT
#define LDS_WAIT() asm volatile("s_waitcnt lgkmcnt(0)" ::: "memory")
#define VM_WAIT() asm volatile("s_waitcnt vmcnt(0)" ::: "memory")
__device__ __forceinline__ unsigned long long rt() { return __builtin_amdgcn_s_memrealtime(); }
__device__ __forceinline__ unsigned f2bf(float f) { unsigned u = __builtin_bit_cast(unsigned, f); return (u + 0x7fffu + ((u >> 16) & 1u)) >> 16; }
__device__ __forceinline__ unsigned f2bf_hw(float f) { return (unsigned)__builtin_bit_cast(unsigned short, (__bf16)f); }
__device__ __forceinline__ unsigned pk2(float lo, float hi) { return f2bf(lo) | (f2bf(hi) << 16); }

#define XB_TMO      128
#define XB_XCNT(j)  (256  + 64 * (j))
#define XB_XSUB(j)  (1280 + 64 * (j))
#define XB_XGEN(j)  (2304 + 64 * (j))
#define XB_TOP      3328
#define XB_TOPGEN   3392
#define XCD_BAR_WORDS 3456
#define XB_SPIN_CAP (1u << 18)

__device__ __forceinline__ unsigned xb_ld(unsigned* p)              { return __hip_atomic_load(p, __ATOMIC_RELAXED, __HIP_MEMORY_SCOPE_AGENT); }
__device__ __forceinline__ unsigned xb_add(unsigned* p, unsigned v) { return __hip_atomic_fetch_add(p, v, __ATOMIC_RELAXED, __HIP_MEMORY_SCOPE_AGENT); }
__device__ __forceinline__ unsigned xb_xcc_id() { return (unsigned)__builtin_amdgcn_s_getreg((3 << 11) | 20) & 0xFu; }
#define XB_SPIN(cond, bar) do { unsigned _sp = 0; while (cond) { __builtin_amdgcn_s_sleep(1); \
    if ((++_sp & 255u) == 0u) { if (xb_ld(&(bar)[XB_TMO])) break; if (_sp > XB_SPIN_CAP) { atomicAdd(&(bar)[XB_TMO], 1u); break; } } } } while (0)

struct XcdBarrier {
    unsigned* bar; unsigned x;
    volatile LAS unsigned* st;
};

__device__ __forceinline__ XcdBarrier xcd_barrier_post(unsigned* bar, volatile LAS unsigned* st) {
    XcdBarrier b; b.bar = bar; b.x = xb_xcc_id(); b.st = st;
    if (threadIdx.x == 0) (void)xb_add(&bar[XB_XCNT(b.x)], 1u);
    return b;
}
__device__ __forceinline__ void xcd_barrier_complete(unsigned* bar, unsigned x, unsigned& nloc, unsigned& nx) {
    const unsigned G = gridDim.x * gridDim.y * gridDim.z;
    unsigned sum, cnt, mine, sp = 0u;
    for (;;) {
        sum = 0u; cnt = 0u; mine = 0u;
#pragma unroll
        for (unsigned j = 0; j < 16; ++j) { const unsigned c = xb_ld(&bar[XB_XCNT(j)]); sum += c; cnt += (c > 0u) ? 1u : 0u; mine = (j == x) ? c : mine; }
        if (sum == G) break;
        __builtin_amdgcn_s_sleep(1);
        if ((++sp & 255u) == 0u) { if (xb_ld(&bar[XB_TMO])) break; if (sp > XB_SPIN_CAP) { atomicAdd(&bar[XB_TMO], 1u); break; } }
    }
    nloc = mine > 0u ? mine : 1u; nx = cnt > 0u ? cnt : 1u;
}

__device__ __forceinline__ void xcd_barrier(const XcdBarrier& b) {
    asm volatile("s_waitcnt vmcnt(0)" ::: "memory");
    __syncthreads();
    if (threadIdx.x == 0) {
        unsigned* bar = b.bar;
        __builtin_amdgcn_s_waitcnt(0);
        unsigned nloc = b.st[0], nx = b.st[1];
        if (nloc == 0u) { xcd_barrier_complete(bar, b.x, nloc, nx); b.st[0] = nloc; b.st[1] = nx; }
        const unsigned old = xb_add(&bar[XB_XSUB(b.x)], 1u);
        const unsigned gen = old / nloc;
        if (old + 1u == (gen + 1u) * nloc) {
            __builtin_amdgcn_fence(__ATOMIC_RELEASE, "agent");
            asm volatile("s_waitcnt vmcnt(0)" ::: "memory");
            const unsigned og = xb_add(&bar[XB_TOP], 1u);
            const unsigned tg = og / nx;
            if (og + 1u == (tg + 1u) * nx) xb_add(&bar[XB_TOPGEN], 1u);
            else XB_SPIN(xb_ld(&bar[XB_TOPGEN]) == tg, bar);
            __builtin_amdgcn_fence(__ATOMIC_ACQUIRE, "agent");
            xb_add(&bar[XB_XGEN(b.x)], 1u);
            asm volatile("s_waitcnt vmcnt(0)" ::: "memory");
        } else {
            XB_SPIN(xb_ld(&bar[XB_XGEN(b.x)]) == gen, bar);
            __builtin_amdgcn_fence(__ATOMIC_ACQUIRE, "agent");
            asm volatile("s_waitcnt vmcnt(0)" ::: "memory");
        }
    }
    __syncthreads();
}

struct Frame {
    LAS unsigned char* lds;
    volatile LAS unsigned* MISC;
    gu32* ctl;
    int tid, lane, wave;
    int vcu, G;
    const float* in[21]; float* out; unsigned char* ws;
};
__device__ __forceinline__ float wave_sum(float v) {
#pragma unroll
    for (int o = 1; o < 64; o <<= 1) v += __shfl_xor(v, o);
    return v;
}
__device__ __forceinline__ int wave_sum_i(int v) {
#pragma unroll
    for (int o = 1; o < 64; o <<= 1) v += __shfl_xor(v, o);
    return v;
}
__device__ __forceinline__ float wave_max(float v) {
#pragma unroll
    for (int o = 1; o < 64; o <<= 1) v = fmaxf(v, __shfl_xor(v, o));
    return v;
}
__device__ __forceinline__ float bf2f(unsigned short h) { return __builtin_bit_cast(float, (unsigned)h << 16); }
__device__ __forceinline__ float bflo(unsigned u) { return __builtin_bit_cast(float, u << 16); }
__device__ __forceinline__ float bfhi(unsigned u) { return __builtin_bit_cast(float, u & 0xffff0000u); }
__device__ __forceinline__ float sigmoid_f(float x) { return 1.0f / (1.0f + __expf(-x)); }
__device__ __forceinline__ float gelu_tanh_f(float x) { const float u = 0.7978845608028654f * (x + 0.044715f * x * x * x); return 0.5f * x * (1.0f + tanhf(u)); }

enum { MAP_ID = 0, MAP_WIN = 1, MAP_WUP = 2 };
__device__ __forceinline__ int src_col(int kind, int n) {
    if (kind == MAP_WIN) {
        if (n >= 1280) return n - 188;
        const int pn = n >> 8, bj = (n >> 7) & 1, wc = (n >> 5) & 3, x = n & 31, H = 4 * pn + wc, d = 32 * bj + x;
        if (H < 17) return H * 64 + d;
        return (H == 17 && d < 4) ? 1088 + d : -1;
    }
    if (kind == MAP_WUP) { const int j = n >> 8, r = n & 255; return r < 128 ? j * 128 + r : DFF + j * 128 + (r - 128); }
    return n;
}
#ifndef P0_WNT
#define P0_WNT 0
#endif
#if P0_WNT
#define P0_WLOAD(p) __builtin_nontemporal_load(p)
#else
#define P0_WLOAD(p) (*(p))
#endif
__device__ __forceinline__ void p0_transpose_item(const float* W, int K, int N, int NP, const float* gain, int kind, bf16* WT, int ldk, LAS float* scr, int item, int lane) {
    const int nblk = NP / 32, kb = item / nblk, nb = item % nblk, k0 = 64 * kb, n0 = 32 * nb;
    const int sc = src_col(kind, n0 + (lane & 31));
    float wv[32];
#pragma unroll
    for (int i = 0; i < 32; ++i) { const int kk = 2 * i + (lane >> 5); wv[i] = (sc >= 0) ? P0_WLOAD(&W[(size_t)(k0 + kk) * N + sc]) : 0.f; }
    const bool has_gain = gain != nullptr; if (!has_gain) gain = W;
    float gq[32];
#pragma unroll
    for (int i = 0; i < 32; ++i) gq[i] = gain[k0 + 2 * i + (lane >> 5)];
#pragma unroll
    for (int i = 0; i < 32; ++i) { const int kk = 2 * i + (lane >> 5); scr[kk * 33 + (lane & 31)] = has_gain ? wv[i] * gq[i] : wv[i]; }
    LDS_WAIT(); asm volatile("" ::: "memory");
    const int c = lane & 7;
#pragma unroll
    for (int j = 0; j < 4; ++j) { const int n = (lane >> 3) + 8 * j; const LAS float* s = scr + (8 * c) * 33 + n;
        v4u o; o.x = pk2(s[0 * 33], s[1 * 33]); o.y = pk2(s[2 * 33], s[3 * 33]); o.z = pk2(s[4 * 33], s[5 * 33]); o.w = pk2(s[6 * 33], s[7 * 33]);
        *(GAS v4u*)(WT + (size_t)(n0 + n) * ldk + k0 + 8 * c) = o; }
    LDS_WAIT(); asm volatile("" ::: "memory");
}
__device__ __forceinline__ void p0_transpose_half(const float* W, int K, int N, int NP, const float* gain, int kind, bf16* WT, int ldk, LAS float* scr, int item, int half, int lane) {
    const int nblk = NP / 32, kb = item / nblk, nb = item % nblk, k0 = 64 * kb + 32 * half, n0 = 32 * nb;
    const int sc = src_col(kind, n0 + (lane & 31));
    float wv[16];
#pragma unroll
    for (int i = 0; i < 16; ++i) { const int kk = 2 * i + (lane >> 5); wv[i] = (sc >= 0) ? P0_WLOAD(&W[(size_t)(k0 + kk) * N + sc]) : 0.f; }
    const bool has_gain = gain != nullptr; if (!has_gain) gain = W;
    float gq[16];
#pragma unroll
    for (int i = 0; i < 16; ++i) gq[i] = gain[k0 + 2 * i + (lane >> 5)];
#pragma unroll
    for (int i = 0; i < 16; ++i) { const int kk = 2 * i + (lane >> 5); scr[kk * 33 + (lane & 31)] = has_gain ? wv[i] * gq[i] : wv[i]; }
    LDS_WAIT(); asm volatile("" ::: "memory");
    const int c = lane & 3;
#pragma unroll
    for (int j = 0; j < 2; ++j) { const int n = (lane >> 2) + 16 * j; const LAS float* s = scr + (8 * c) * 33 + n;
        v4u o; o.x = pk2(s[0 * 33], s[1 * 33]); o.y = pk2(s[2 * 33], s[3 * 33]); o.z = pk2(s[4 * 33], s[5 * 33]); o.w = pk2(s[6 * 33], s[7 * 33]);
        *(GAS v4u*)(WT + (size_t)(n0 + n) * ldk + k0 + 8 * c) = o; }
    LDS_WAIT(); asm volatile("" ::: "memory");
}
__device__ __forceinline__ void p0_transposes(Frame& F, int first, int last, int wi, int nw) {
    LAS float* scr = (LAS float*)(F.lds + RING_OFF + F.wave * 16384);
    constexpr int I_IN = 16 * (NIN / 32), I_OA = 8 * 32, I_OB = 16 * 32, I_OUT = 16 * 32, I_UP = 16 * (NUP / 32);
    unsigned char* ws = F.ws;
    for (int it = first + wi; it < last; it += nw) {
        int r = it;
        if (r < I_IN) { p0_transpose_item(F.in[2], 1024, IN_TOTAL, NIN, F.in[1], MAP_WIN, (bf16*)(ws + WS_WIN), 1024, scr, r, F.lane); continue; } r -= I_IN;
        if (r < I_OA) { p0_transpose_item(F.in[13], 512, 1024, 1024, nullptr, MAP_ID, (bf16*)(ws + WS_WOA), 1536, scr, r, F.lane); continue; } r -= I_OA;
        if (r < I_OB) { p0_transpose_item(F.in[14], 1024, 1024, 1024, nullptr, MAP_ID, (bf16*)(ws + WS_WOA) + 512, 1536, scr, r, F.lane); continue; } r -= I_OB;
        if (r < I_OUT) { p0_transpose_item(F.in[15], 1024, 1024, 1024, nullptr, MAP_ID, (bf16*)(ws + WS_WOUT), 1024, scr, r, F.lane); continue; } r -= I_OUT;
        if (r < I_UP) { p0_transpose_item(F.in[17], 1024, NUP, NUP, F.in[16], MAP_WUP, (bf16*)(ws + WS_WUP), 1024, scr, r, F.lane); continue; } r -= I_UP;
        p0_transpose_item(F.in[20], DFF, 1024, 1024, nullptr, MAP_ID, (bf16*)(ws + WS_WDN), DFF, scr, r, F.lane);
    }
}
#ifndef P0_HALF
#define P0_HALF 0
#endif
constexpr int P0_I_IN = 16 * (NIN / 32), P0_NITEMS = P0_I_IN + 8 * 32 + 16 * 32 + 16 * 32 + 16 * (NUP / 32) + (DFF / 64) * 32;
__device__ __forceinline__ bool p0_defer(int G) { return G == 256; }
__device__ __forceinline__ void p0_prologue(Frame& F) {
    const int gw = F.vcu * NWAVES + F.wave, NGW = F.G * NWAVES;
    unsigned char* ws = F.ws;
    if (P0_HALF && NGW == 2048) {
        p0_transposes(F, 0, 2048, gw, NGW);
        if (gw < 2 * (P0_I_IN - 2048)) p0_transpose_half(F.in[2], 1024, IN_TOTAL, NIN, F.in[1], MAP_WIN, (bf16*)(ws + WS_WIN), 1024, (LAS float*)(F.lds + RING_OFF + F.wave * 16384), 2048 + (gw >> 1), gw & 1, F.lane);
    } else p0_transposes(F, 0, p0_defer(F.G) ? P0_I_IN : P0_NITEMS, gw, NGW);
    if (F.vcu == 1 && F.wave == 0) {
        const float mq = wave_max(fabsf(F.in[3][F.lane])), mk = wave_max(fabsf(F.in[4][F.lane]));
        if (F.lane == 0) ((float*)(ws + WS_GAINS))[192] = 8.0f * mq * mk * 1.15f;
    }
    if (F.vcu == 0 && F.tid < 192) { float* gd = (float*)(ws + WS_GAINS); const int j = F.tid >> 6, d = F.tid & 63; const float v0 = F.in[3][d], v1 = F.in[4][d], v2 = F.in[5][d]; gd[F.tid] = j == 0 ? v0 : (j == 1 ? v1 : v2); }
}
__device__ __forceinline__ void p0_prologue_x(Frame& F) {
    const int gw = F.vcu * NWAVES + F.wave, NGW = F.G * NWAVES;
    unsigned char* ws = F.ws;
    const float* x = F.in[0]; bf16* xb = (bf16*)(ws + WS_XB); float* rinv1 = (float*)(ws + WS_RINV1);
#ifndef P0_XPIPE
#define P0_XPIPE 0
#endif
#if P0_XPIPE
    f32x4 v[4][4], vn[4][4];
    if (gw < M) {
#pragma unroll
        for (int q = 0; q < 4; ++q) { const int m = gw + q * NGW; const GAS f32x4* xr = (const GAS f32x4*)(x + (size_t)(m < M ? m : gw) * DM) + F.lane;
#pragma unroll
            for (int j = 0; j < 4; ++j) v[q][j] = __builtin_nontemporal_load(xr + 64 * j); }
    }
    for (int m0 = gw; m0 < M; m0 += 4 * NGW) {
        const int m1 = m0 + 4 * NGW;
        if (m1 < M) {
#pragma unroll
            for (int q = 0; q < 4; ++q) { const int m = m1 + q * NGW; const GAS f32x4* xr = (const GAS f32x4*)(x + (size_t)(m < M ? m : m1) * DM) + F.lane;
#pragma unroll
                for (int j = 0; j < 4; ++j) vn[q][j] = __builtin_nontemporal_load(xr + 64 * j); }
        }
#else
    for (int m0 = gw; m0 < M; m0 += 4 * NGW) {
        f32x4 v[4][4];
#pragma unroll
        for (int q = 0; q < 4; ++q) { const int m = m0 + q * NGW; const GAS f32x4* xr = (const GAS f32x4*)(x + (size_t)(m < M ? m : m0) * DM) + F.lane;
#pragma unroll
            for (int j = 0; j < 4; ++j) v[q][j] = __builtin_nontemporal_load(xr + 64 * j); }
#endif
#pragma unroll
        for (int q = 0; q < 4; ++q) { const int m = m0 + q * NGW; if (m >= M) break;
            float s = 0.f;
#pragma unroll
            for (int j = 0; j < 4; ++j) s += (v[q][j].x * v[q][j].x + v[q][j].y * v[q][j].y) + (v[q][j].z * v[q][j].z + v[q][j].w * v[q][j].w);
            s = wave_sum(s);
            const float ri = 1.0f / sqrtf(s * (1.0f / DM) + EPS);
            GAS unsigned long long* o8 = (GAS unsigned long long*)(xb + (size_t)m * DM) + F.lane;
#pragma unroll
            for (int j = 0; j < 4; ++j) o8[64 * j] = (unsigned long long)pk2(v[q][j].x * ri, v[q][j].y * ri) | ((unsigned long long)pk2(v[q][j].z * ri, v[q][j].w * ri) << 32);
            if (F.lane == 0) rinv1[m] = sqrtf(s * (1.0f / DM) + EPS); }
#if P0_XPIPE
#pragma unroll
        for (int q = 0; q < 4; ++q)
#pragma unroll
            for (int j = 0; j < 4; ++j) v[q][j] = vn[q][j];
#endif
    }
}

typedef float f32x16 __attribute__((ext_vector_type(16)));
typedef short v4i16_t __attribute__((ext_vector_type(4)));
__device__ __forceinline__ unsigned f2key(float f) { unsigned u = __builtin_bit_cast(unsigned, f); u = (u == 0x80000000u) ? 0u : u; return (u & 0x80000000u) ? ~u : (u | 0x80000000u); }
__device__ __forceinline__ unsigned lds_add_rtn(LAS unsigned* p, unsigned v) { return __hip_atomic_fetch_add(p, v, __ATOMIC_RELAXED, __HIP_MEMORY_SCOPE_WORKGROUP); }
__device__ __forceinline__ void lds_add(LAS unsigned* p, unsigned v) { (void)__hip_atomic_fetch_add(p, v, __ATOMIC_RELAXED, __HIP_MEMORY_SCOPE_WORKGROUP); }

__device__ __forceinline__ void slow_select(Frame& F, int qidx, LAS unsigned* keys, unsigned short* dst) {
    const int lane = F.lane, ksub = lane >> 3, chunk = lane & 7;
    const unsigned long long lt_mask = (lane == 0) ? 0ull : (~0ull >> (64 - lane));
    const bf16* PA = (const bf16*)(F.ws + WS_PA); const bf16* KI = (const bf16*)(F.ws + WS_KI); const float* WI = (const float*)(F.ws + WS_WI);
    const int b = qidx / SEQ, t = qidx % SEQ, n = t + 1;
    const bf16* qrow = PA + (size_t)qidx * PA_LD; const bf16* kbase = KI + (size_t)b * SEQ * 64;
    float qi[4][8];
#pragma unroll
    for (int h = 0; h < 4; ++h) { const v4u u = *(const GAS v4u*)(qrow + PA_QI + h * 64 + chunk * 8);
        qi[h][0] = bflo(u.x); qi[h][1] = bfhi(u.x); qi[h][2] = bflo(u.y); qi[h][3] = bfhi(u.y); qi[h][4] = bflo(u.z); qi[h][5] = bfhi(u.z); qi[h][6] = bflo(u.w); qi[h][7] = bfhi(u.w); }
    const f32x4 wv = *(const GAS f32x4*)(WI + (size_t)qidx * 4);
    for (int s0 = 0; s0 < n; s0 += 8) {
        const int s = s0 + ksub; const int sc = s < n ? s : t;
        const v4u u = *(const GAS v4u*)(kbase + (size_t)sc * 64 + chunk * 8);
        const float kf[8] = {bflo(u.x), bfhi(u.x), bflo(u.y), bfhi(u.y), bflo(u.z), bfhi(u.z), bflo(u.w), bfhi(u.w)};
        float a[4];
#pragma unroll
        for (int h = 0; h < 4; ++h) { float x = 0.f;
#pragma unroll
            for (int e = 0; e < 8; ++e) x += kf[e] * qi[h][e];
            x += __shfl_xor(x, 1); x += __shfl_xor(x, 2); x += __shfl_xor(x, 4); a[h] = x; }
        const float score = wv.x * fmaxf(a[0], 0.f) + wv.y * fmaxf(a[1], 0.f) + wv.z * fmaxf(a[2], 0.f) + wv.w * fmaxf(a[3], 0.f);
        if (chunk == 0 && s < n) keys[s] = f2key(score);
    }
    if (n > TOPK) {
        unsigned prefix = 0u;
        for (int bit = 31; bit >= 0; --bit) {
            const unsigned cand = prefix | (1u << bit);
            int cnt = 0;
            for (int s = lane; s < n; s += 64) cnt += (keys[s] >= cand) ? 1 : 0;
            cnt = wave_sum_i(cnt);
            if (cnt >= TOPK) prefix = cand;
        }
        const unsigned tau = prefix;
        int cgt = 0;
        for (int s = lane; s < n; s += 64) cgt += (keys[s] > tau) ? 1 : 0;
        cgt = wave_sum_i(cgt);
        const int need = TOPK - cgt;
        int base = 0, eqseen = 0;
        for (int s0 = 0; s0 < n; s0 += 64) {
            const int s = s0 + lane; const bool in = s < n; const unsigned k = in ? keys[s] : 0u;
            const bool gt = in && k > tau, eq = in && k == tau;
            const unsigned long long beq = __ballot(eq);
            const int rank_eq = eqseen + __popcll(beq & lt_mask);
            const bool take = gt || (eq && rank_eq < need);
            const unsigned long long bs = __ballot(take);
            if (take) dst[base + __popcll(bs & lt_mask)] = (unsigned short)s;
            base += __popcll(bs); eqseen += __popcll(beq);
        }
    } else {
        for (int j = lane; j < TOPK; j += 64) dst[j] = (unsigned short)(j < n ? j : t);
    }
}

constexpr int TK_ROW = 4112, TK_CROW = 4112, TK_CAP = 512;
constexpr int TK_SEL_OFF = 32 * 4112, TK_SM_OFF = PHASE_LDS - 1664;
static_assert(TK_SM_OFF + 1024 <= PHASE_LDS, "top-k LDS map");
__device__ __forceinline__ int crow16(int r, int hi) { return (r & 3) + 8 * (r >> 2) + 4 * hi; }

__device__ __forceinline__ float relu_asm(float x) { const int i = __builtin_bit_cast(int, x); return __builtin_bit_cast(float, i > 0 ? i : 0); }
__device__ __forceinline__ unsigned key_of(float sc) { const unsigned u = __builtin_bit_cast(unsigned, sc); return u ^ (((unsigned)((int)u >> 31)) | 0x80000000u); }
constexpr int TK_TRASH_OFF = TK_SM_OFF + 1024;
static_assert(TK_TRASH_OFF + 640 <= PHASE_LDS, "top-k LDS map");
constexpr int TK2_CAP = 768, TK2_KROW = TK2_CAP * 4 + 16, TK2_IROW = TK2_CAP * 2 + 8, TK2_IDX_OFF = 32 * TK2_KROW, TK2_TARGET = 470;
static_assert(TK2_IDX_OFF + 32 * TK2_IROW <= TK_SM_OFF, "top-k LDS map");
#ifndef TK_GROUPSCHED
#define TK_GROUPSCHED 0
#endif
#ifndef TK_PAIR
#define TK_PAIR 0
#endif
#ifndef AT_MFMA_SUM
#define AT_MFMA_SUM 0
#endif
#ifndef AT_WIDE_OUT
#define AT_WIDE_OUT 0
#endif
#ifndef TK_UNPACK
#define TK_UNPACK 1
#endif
#if TK_UNPACK
#define TK_NOPACK(x) asm("" : "+v"(x))
#else
#define TK_NOPACK(x) do { } while (0)
#endif
#ifndef TK_SHARD
#define TK_SHARD 0
#endif
#ifndef TK_BALLOT_STEP
#define TK_BALLOT_STEP 1
#endif
#ifndef TK_PIPE
#define TK_PIPE 1
#endif
#ifndef TK_SPLIT_HEADS
#define TK_SPLIT_HEADS 1
#endif
#ifndef TK_SKEW
#define TK_SKEW 0
#endif
#ifndef TK_EXECSTORE
#define TK_EXECSTORE 0
#endif
#ifndef TK_FAST
#define TK_FAST 1
#endif
template <int CTRL> __device__ __forceinline__ unsigned dpp_mov0(unsigned x) { return (unsigned)__builtin_amdgcn_update_dpp(0, (int)x, CTRL, 0xF, 0xF, false); }
__device__ __forceinline__ unsigned wave_sum_dpp(unsigned x) {
    x += dpp_mov0<0xB1>(x); x += dpp_mov0<0x4E>(x); x += dpp_mov0<0x124>(x); x += dpp_mov0<0x128>(x);
    return (unsigned)__builtin_amdgcn_readlane((int)x, 0) + (unsigned)__builtin_amdgcn_readlane((int)x, 16) + (unsigned)__builtin_amdgcn_readlane((int)x, 32) + (unsigned)__builtin_amdgcn_readlane((int)x, 48);
}
__device__ __forceinline__ unsigned wave_max_dpp(unsigned x) {
    unsigned y;
    y = dpp_mov0<0xB1>(x); x = x > y ? x : y; y = dpp_mov0<0x4E>(x); x = x > y ? x : y; y = dpp_mov0<0x124>(x); x = x > y ? x : y; y = dpp_mov0<0x128>(x); x = x > y ? x : y;
    const unsigned a = (unsigned)__builtin_amdgcn_readlane((int)x, 0), b = (unsigned)__builtin_amdgcn_readlane((int)x, 16), c = (unsigned)__builtin_amdgcn_readlane((int)x, 32), d = (unsigned)__builtin_amdgcn_readlane((int)x, 48);
    const unsigned ab = a > b ? a : b, cd = c > d ? c : d; return ab > cd ? ab : cd;
}
__device__ __forceinline__ unsigned wave_excl_scan_dpp(unsigned c, int lane) {
    unsigned x = c;
    x += dpp_mov0<0x111>(x); x += dpp_mov0<0x112>(x); x += dpp_mov0<0x114>(x); x += dpp_mov0<0x118>(x);
    const unsigned t0 = (unsigned)__builtin_amdgcn_readlane((int)x, 15), t1 = (unsigned)__builtin_amdgcn_readlane((int)x, 31), t2 = (unsigned)__builtin_amdgcn_readlane((int)x, 47);
    const int row = lane >> 4;
    return x - c + (row >= 1 ? t0 : 0u) + (row >= 2 ? t1 : 0u) + (row >= 3 ? t2 : 0u);
}
__device__ __forceinline__ void tk_keys(unsigned (&keyv)[16], const pg8::bf16x8 (&a0)[4], const pg8::bf16x8 (&qf)[4][4], f32x4 wv) {
    const f32x16 z16 = (f32x16){0.f, 0.f, 0.f, 0.f, 0.f, 0.f, 0.f, 0.f, 0.f, 0.f, 0.f, 0.f, 0.f, 0.f, 0.f, 0.f};
    f32x16 accA, accB;
    float part[16];
    accA = __builtin_amdgcn_mfma_f32_32x32x16_bf16(a0[0], qf[0][0], z16, 0, 0, 0); accB = __builtin_amdgcn_mfma_f32_32x32x16_bf16(a0[0], qf[1][0], z16, 0, 0, 0);
#pragma unroll
    for (int ks = 1; ks < 4; ++ks) { accA = __builtin_amdgcn_mfma_f32_32x32x16_bf16(a0[ks], qf[0][ks], accA, 0, 0, 0); accB = __builtin_amdgcn_mfma_f32_32x32x16_bf16(a0[ks], qf[1][ks], accB, 0, 0, 0); }
#pragma unroll
    for (int r = 0; r < 16; ++r) { float sc = __builtin_fmaf(wv.x, relu_asm(accA[r]), 0.0f); TK_NOPACK(sc); sc = __builtin_fmaf(wv.y, relu_asm(accB[r]), sc); TK_NOPACK(sc); part[r] = sc; }
    if (TK_SPLIT_HEADS) __builtin_amdgcn_sched_barrier(0);
    accA = __builtin_amdgcn_mfma_f32_32x32x16_bf16(a0[0], qf[2][0], z16, 0, 0, 0); accB = __builtin_amdgcn_mfma_f32_32x32x16_bf16(a0[0], qf[3][0], z16, 0, 0, 0);
#pragma unroll
    for (int ks = 1; ks < 4; ++ks) { accA = __builtin_amdgcn_mfma_f32_32x32x16_bf16(a0[ks], qf[2][ks], accA, 0, 0, 0); accB = __builtin_amdgcn_mfma_f32_32x32x16_bf16(a0[ks], qf[3][ks], accB, 0, 0, 0); }
#pragma unroll
    for (int r = 0; r < 16; ++r) { float sc = __builtin_fmaf(wv.z, relu_asm(accA[r]), part[r]); TK_NOPACK(sc); sc = __builtin_fmaf(wv.w, relu_asm(accB[r]), sc); TK_NOPACK(sc); keyv[r] = key_of(sc); }
}
template <int PASS, bool DIAG>
__device__ __forceinline__ void tk_consume(LAS unsigned char* L, const unsigned (&keyv)[16], int kt, int r32, int hi, int lane, unsigned bstar, LAS unsigned* hrow, LAS unsigned* sm, LAS unsigned short* selr) {
    if (PASS == 1) {
#pragma unroll
        for (int r = 0; r < 16; ++r) {
            const unsigned k = keyv[r];
            LAS unsigned* wp = (LAS unsigned*)((LAS unsigned char*)hrow + ((k >> 20) & 0xFFCu));
            const unsigned val = 1u << ((k >> 17) & 16u);
            if (DIAG) { if (crow16(r, hi) <= r32) lds_add(wp, val); } else lds_add(wp, val);
        }
    } else if (PASS == 3) {
        unsigned c = 0u; const unsigned thr = bstar << 20;
#pragma unroll
        for (int r = 0; r < 16; ++r) { const bool v = !DIAG || crow16(r, hi) <= r32; c += (v && keyv[r] >= thr) ? 1u : 0u; }
        unsigned pos = lds_add_rtn(sm + 128 + r32, c);
        const bool fits = pos + c <= (unsigned)TK2_CAP;
        LAS unsigned short* const trash16 = (LAS unsigned short*)(L + TK_TRASH_OFF) + lane;
        LAS unsigned* const trash32 = (LAS unsigned*)(L + TK_TRASH_OFF + 128) + lane;
        LAS unsigned* const keyr = (LAS unsigned*)(L + r32 * TK2_KROW);
        LAS unsigned short* const idxr = (LAS unsigned short*)(L + TK2_IDX_OFF + r32 * TK2_IROW);
#pragma unroll
        for (int r = 0; r < 16; ++r) { const unsigned s = (unsigned)(32 * kt + crow16(r, hi)); const bool v = !DIAG || crow16(r, hi) <= r32;
            const bool p = v && keyv[r] >= thr; const bool st = p && fits;
#if TK_EXECSTORE
            if (st) { keyr[pos] = keyv[r]; idxr[pos] = (unsigned short)s; } pos += p ? 1u : 0u; }
#else
            LAS unsigned* pk = st ? keyr + pos : trash32; *pk = keyv[r];
            LAS unsigned short* pi = st ? idxr + pos : trash16; *pi = (unsigned short)s; pos += p ? 1u : 0u; }
#endif
    } else {
        unsigned csel = 0u, ccand = 0u;
#pragma unroll
        for (int r = 0; r < 16; ++r) { const unsigned bin = keyv[r] >> 21; const bool v = !DIAG || crow16(r, hi) <= r32; csel += (v && bin > bstar) ? 1u : 0u; ccand += (v && bin == bstar) ? 1u : 0u; }
        unsigned psel = lds_add_rtn(sm + 96 + r32, csel);
        unsigned pcand = lds_add_rtn(sm + 128 + r32, ccand);
        LAS unsigned short* const trash16 = (LAS unsigned short*)(L + TK_TRASH_OFF) + lane;
        LAS unsigned long long* const trash64 = (LAS unsigned long long*)(L + TK_TRASH_OFF + 128) + lane;
        LAS unsigned long long* const candr = (LAS unsigned long long*)(L + r32 * TK_CROW);
#pragma unroll
        for (int r = 0; r < 16; ++r) { const unsigned bin = keyv[r] >> 21; const unsigned s = (unsigned)(32 * kt + crow16(r, hi)); const bool v = !DIAG || crow16(r, hi) <= r32;
            const bool isS = v && bin > bstar, isC = v && bin == bstar;
            LAS unsigned short* ps = (isS && psel < 256u) ? selr + psel : trash16; *ps = (unsigned short)s; psel += isS ? 1u : 0u;
            LAS unsigned long long* pc = (isC && pcand < (unsigned)TK_CAP) ? candr + pcand : trash64; *pc = ((unsigned long long)keyv[r] << 32) | s; pcand += isC ? 1u : 0u; }
    }
}
template <int PASS>
__device__ __forceinline__ void tk_pass(LAS unsigned char* L, const bf16* KIb, int ntiles, int wave, int r32, int hi, int lane, const pg8::bf16x8 (&qf)[4][4], f32x4 wv, unsigned bstar) {
    typedef pg8::bf16x8 bx8;
    const bf16* kp0 = KIb + (size_t)r32 * 64 + hi * 8;
    LAS unsigned* hrow = (LAS unsigned*)(L + r32 * TK_ROW);
    LAS unsigned* sm = (LAS unsigned*)(L + TK_SM_OFF);
    LAS unsigned short* selr = (LAS unsigned short*)(L + TK_SEL_OFF) + r32 * 256;
    bx8 a0[4], a1[4];
    if (TK_SKEW > 0 && wave >= 4) __builtin_amdgcn_s_sleep(TK_SKEW);
    int kt = wave;
    { const int k0 = kt < ntiles ? kt : 0;
#pragma unroll
      for (int ks = 0; ks < 4; ++ks) a0[ks] = *(const GAS bx8*)(kp0 + (size_t)k0 * 32 * 64 + ks * 16); }
    for (; kt < ntiles; kt += 8) {
        const int ktn = (kt + 8 < ntiles) ? kt + 8 : kt;
#pragma unroll
        for (int ks = 0; ks < 4; ++ks) a1[ks] = *(const GAS bx8*)(kp0 + (size_t)ktn * 32 * 64 + ks * 16);
        unsigned keyv[16];
        tk_keys(keyv, a0, qf, wv);
        if (kt == ntiles - 1) tk_consume<PASS, true>(L, keyv, kt, r32, hi, lane, bstar, hrow, sm, selr);
        else tk_consume<PASS, false>(L, keyv, kt, r32, hi, lane, bstar, hrow, sm, selr);
#pragma unroll
        for (int ks = 0; ks < 4; ++ks) a0[ks] = a1[ks];
    }
}

__device__ __forceinline__ void tk_mfma2(f32x16& accA, f32x16& accB, const pg8::bf16x8 (&a)[4], const pg8::bf16x8 (&qf)[4][4], int h0) {
    const f32x16 z16 = (f32x16){0.f, 0.f, 0.f, 0.f, 0.f, 0.f, 0.f, 0.f, 0.f, 0.f, 0.f, 0.f, 0.f, 0.f, 0.f, 0.f};
    accA = __builtin_amdgcn_mfma_f32_32x32x16_bf16(a[0], qf[h0][0], z16, 0, 0, 0); accB = __builtin_amdgcn_mfma_f32_32x32x16_bf16(a[0], qf[h0 + 1][0], z16, 0, 0, 0);
#pragma unroll
    for (int ks = 1; ks < 4; ++ks) { accA = __builtin_amdgcn_mfma_f32_32x32x16_bf16(a[ks], qf[h0][ks], accA, 0, 0, 0); accB = __builtin_amdgcn_mfma_f32_32x32x16_bf16(a[ks], qf[h0 + 1][ks], accB, 0, 0, 0); }
}
#ifndef TK_RING2
#define TK_RING2 0
#endif
__device__ __forceinline__ void tk_pass_collect(LAS unsigned char* L, const bf16* KIb, int ntiles, int wave, int r32, int hi, int lane, const pg8::bf16x8 (&qf)[4][4], f32x4 wv, unsigned bstar) {
    typedef pg8::bf16x8 bx8;
    const bf16* kp0 = KIb + (size_t)r32 * 64 + hi * 8;
    LAS unsigned* hrow = (LAS unsigned*)(L + r32 * TK_ROW);
    LAS unsigned* sm = (LAS unsigned*)(L + TK_SM_OFF);
    LAS unsigned short* selr = (LAS unsigned short*)(L + TK_SEL_OFF) + r32 * 256;
    int kt = wave;
    if (kt >= ntiles) return;
    bx8 an[4], a2[4];
#pragma unroll
    for (int ks = 0; ks < 4; ++ks) an[ks] = *(const GAS bx8*)(kp0 + (size_t)kt * 32 * 64 + ks * 16);
    { const int k1 = kt + 8 < ntiles ? kt + 8 : kt;
#pragma unroll
      for (int ks = 0; ks < 4; ++ks) a2[ks] = *(const GAS bx8*)(kp0 + (size_t)k1 * 32 * 64 + ks * 16); }
    unsigned keyv[16];
    tk_keys(keyv, an, qf, wv);
#if !TK_RING2
#pragma unroll
    for (int ks = 0; ks < 4; ++ks) an[ks] = a2[ks];
#endif
#if TK_RING2
    auto trip = [&](bx8 (&an)[4], bx8 (&a2)[4]) __attribute__((always_inline)) {
#else
    while (kt + 8 < ntiles) {
#endif
        f32x16 accA, accB;
        tk_mfma2(accA, accB, an, qf, 0);
        { const int k2 = kt + 16 < ntiles ? kt + 16 : kt + 8;
#pragma unroll
          for (int ks = 0; ks < 4; ++ks) a2[ks] = *(const GAS bx8*)(kp0 + (size_t)k2 * 32 * 64 + ks * 16); }
#if !TK_GROUPSCHED
        __builtin_amdgcn_sched_barrier(0);
#endif
        tk_consume<3, false>(L, keyv, kt, r32, hi, lane, bstar, hrow, sm, selr);
#if TK_GROUPSCHED
#pragma unroll
        for (int k = 0; k < 8; ++k) { __builtin_amdgcn_sched_group_barrier(0x008, 1, 0); __builtin_amdgcn_sched_group_barrier(0x002, TK_GROUPSCHED, 0); }
#endif
        __builtin_amdgcn_sched_barrier(0);
        float part[16];
#pragma unroll
        for (int r = 0; r < 16; ++r) { float sc = __builtin_fmaf(wv.x, relu_asm(accA[r]), 0.0f); TK_NOPACK(sc); sc = __builtin_fmaf(wv.y, relu_asm(accB[r]), sc); TK_NOPACK(sc); part[r] = sc; }
        __builtin_amdgcn_sched_barrier(0);
        tk_mfma2(accA, accB, an, qf, 2);
#pragma unroll
        for (int r = 0; r < 16; ++r) { float sc = __builtin_fmaf(wv.z, relu_asm(accA[r]), part[r]); TK_NOPACK(sc); sc = __builtin_fmaf(wv.w, relu_asm(accB[r]), sc); TK_NOPACK(sc); keyv[r] = key_of(sc); }
#if !TK_RING2
#pragma unroll
        for (int ks = 0; ks < 4; ++ks) an[ks] = a2[ks];
#endif
        kt += 8;
#if TK_RING2
    };
    while (kt + 8 < ntiles) {
        trip(a2, an);
        if (!(kt + 8 < ntiles)) break;
        trip(an, a2);
    }
#else
    }
#endif
    if (kt == ntiles - 1) tk_consume<3, true>(L, keyv, kt, r32, hi, lane, bstar, hrow, sm, selr);
    else tk_consume<3, false>(L, keyv, kt, r32, hi, lane, bstar, hrow, sm, selr);
}
template <int NJ>
__device__ __forceinline__ void tk2_load(LAS unsigned char* L, int r, int m, int lane5, unsigned (&kr)[NJ], unsigned (&ir)[NJ]) {
    const LAS unsigned* keyr = (const LAS unsigned*)(L + r * TK2_KROW);
    const LAS unsigned short* idxr = (const LAS unsigned short*)(L + TK2_IDX_OFF + r * TK2_IROW);
#pragma unroll
    for (int j = 0; j < NJ; ++j) { const int i = lane5 + 64 * j; const unsigned kv = keyr[i]; ir[j] = (unsigned)idxr[i]; kr[j] = i < m ? kv : 0u; }
}
template <int NJ>
__device__ __forceinline__ unsigned tk2_count_ge(const unsigned (&kr)[NJ], unsigned cand) {
    unsigned long long mk[NJ];
#pragma unroll
    for (int j = 0; j < NJ; ++j) mk[j] = __ballot(kr[j] >= cand);
    __builtin_amdgcn_sched_barrier(0);
    unsigned cnt = 0u;
#pragma unroll
    for (int j = 0; j < NJ; ++j) cnt += (unsigned)__popcll(mk[j]);
    return cnt;
}
template <int NJ>
__device__ __forceinline__ void tk2_finish(LAS unsigned char* L, int r, int m, int lane5, bool dry, const unsigned (&kr)[NJ], const unsigned (&ir)[NJ], unsigned lo0, unsigned prefix, unsigned exact_ge) {
    unsigned tau = 0u, X = 0xFFFFu, gt_thr = 0u; bool eq_en = true;
    if (m > 256) {
        tau = lo0 + prefix;
        if (exact_ge != 0u) { gt_thr = exact_ge - 1u; eq_en = false; }
        else {
            gt_thr = tau;
            unsigned c2 = 0u;
#pragma unroll
            for (int j = 0; j < NJ; ++j) { const bool in = lane5 + 64 * j < m; c2 += (kr[j] > tau ? 1u : 0u) + ((kr[j] == tau) & in ? 0x10000u : 0u); }
            const unsigned t2 = wave_sum_dpp(c2);
            const int need_eq = 256 - (int)(t2 & 0xFFFFu), ceq = (int)(t2 >> 16);
            if (need_eq < ceq) {
                unsigned xp = 0u;
                for (int bit = 11; bit >= 0; --bit) {
                    const unsigned cand = xp | (1u << bit);
                    unsigned c = 0u;
#pragma unroll
                    for (int j = 0; j < NJ; ++j) { const bool in = lane5 + 64 * j < m; c += ((kr[j] == tau) & (ir[j] < cand) & in) ? 1u : 0u; }
                    if ((int)wave_sum_dpp(c) < need_eq) xp = cand;
                }
                X = xp;
            }
        }
    }
    LAS unsigned short* lst = (LAS unsigned short*)(L + (dry ? TK_TRASH_OFF + 128 : r * TK2_KROW));
    LAS unsigned short* const trash16 = (LAS unsigned short*)(L + TK_TRASH_OFF) + lane5;
    unsigned tk = 0u, nt = 0u;
#pragma unroll
    for (int j = 0; j < NJ; ++j) {
        const bool in = lane5 + 64 * j < m;
        const bool take = in & ((kr[j] > gt_thr) | (eq_en & (kr[j] == tau) & (ir[j] <= X)));
        tk |= take ? (1u << j) : 0u; nt += take ? 1u : 0u;
    }
    unsigned pos = wave_excl_scan_dpp(nt, lane5);
#pragma unroll
    for (int j = 0; j < NJ; ++j) {
        const bool take = (tk >> j) & 1u;
        LAS unsigned short* pw = (take & (pos < 256u)) ? lst + pos : trash16; *pw = (unsigned short)ir[j]; pos += take ? 1u : 0u;
    }
}
template <int NJ>
__device__ __forceinline__ unsigned tk2_max(const unsigned (&kr)[NJ]) { unsigned mx = kr[0];
#pragma unroll
    for (int j = 1; j < NJ; ++j) mx = mx > kr[j] ? mx : kr[j];
    return wave_max_dpp(mx); }
template <int NJ>
__device__ __forceinline__ void tk2_select(LAS unsigned char* L, LAS unsigned* sm, int r, int m, int lane5, bool dry) {
    unsigned kr[NJ], ir[NJ];
    tk2_load<NJ>(L, r, m, lane5, kr, ir);
    unsigned lo0 = 0u, prefix = 0u, exact_ge = 0u;
    if (m > 256) {
        const unsigned mx = tk2_max<NJ>(kr);
        lo0 = (unsigned)__builtin_amdgcn_readfirstlane((int)sm[r]) << 20;
        const unsigned dmax = mx - lo0;
        if (dmax != 0u) {
            for (int bit = 31 - __builtin_clz(dmax); bit >= 0; --bit) {
                const unsigned d = prefix | (1u << bit);
                if (d > dmax) continue;
                const unsigned cnt = tk2_count_ge<NJ>(kr, lo0 + d);
                if (cnt == 256u) { exact_ge = lo0 + d; break; }
                if (cnt > 256u) prefix = d;
            }
        }
    }
    tk2_finish<NJ>(L, r, m, lane5, dry, kr, ir, lo0, prefix, exact_ge);
}
template <int NJ>
__device__ __forceinline__ void tk2_select_pair(LAS unsigned char* L, LAS unsigned* sm, int r, int m0, int m1, int lane5, bool dry) {
    unsigned ka[NJ], ia[NJ], kb[NJ], ib[NJ];
    tk2_load<NJ>(L, r, m0, lane5, ka, ia); tk2_load<NJ>(L, r + 1, m1, lane5, kb, ib);
    const unsigned mxa = tk2_max<NJ>(ka), mxb = tk2_max<NJ>(kb);
    const unsigned loa = (unsigned)__builtin_amdgcn_readfirstlane((int)sm[r]) << 20, lob = (unsigned)__builtin_amdgcn_readfirstlane((int)sm[r + 1]) << 20;
    const unsigned dma = mxa - loa, dmb = mxb - lob;
    const int hba = dma ? 31 - __builtin_clz(dma) : -1, hbb = dmb ? 31 - __builtin_clz(dmb) : -1;
    unsigned pa = 0u, pb = 0u, ea = 0u, eb = 0u; bool da = hba < 0, db = hbb < 0;
    for (int bit = hba > hbb ? hba : hbb; bit >= 0 && !(da && db); --bit) {
        const unsigned xa = pa | (1u << bit), xb = pb | (1u << bit);
        const bool va = !da && bit <= hba && xa <= dma, vb = !db && bit <= hbb && xb <= dmb;
        const unsigned ca = va ? loa + xa : 0xFFFFFFFFu, cb = vb ? lob + xb : 0xFFFFFFFFu;
        unsigned long long mka[NJ], mkb[NJ];
#pragma unroll
        for (int j = 0; j < NJ; ++j) mka[j] = __ballot(ka[j] >= ca);
#pragma unroll
        for (int j = 0; j < NJ; ++j) mkb[j] = __ballot(kb[j] >= cb);
        __builtin_amdgcn_sched_barrier(0);
        unsigned na = 0u, nb = 0u;
#pragma unroll
        for (int j = 0; j < NJ; ++j) { na += (unsigned)__popcll(mka[j]); nb += (unsigned)__popcll(mkb[j]); }
        if (va) { if (na == 256u) { ea = ca; da = true; } else if (na > 256u) pa = xa; }
        if (vb) { if (nb == 256u) { eb = cb; db = true; } else if (nb > 256u) pb = xb; }
    }
    tk2_finish<NJ>(L, r, m0, lane5, dry, ka, ia, loa, pa, ea);
    tk2_finish<NJ>(L, r + 1, m1, lane5, dry, kb, ib, lob, pb, eb);
}
__device__ __forceinline__ void p3_topk(Frame& F, int qrep) {
    typedef pg8::bf16x8 bx8;
    LAS unsigned char* L = F.lds;
    LAS unsigned* sm = (LAS unsigned*)(L + TK_SM_OFF);
    const int tid = F.tid, wave = F.wave;
    const bf16* PA = (const bf16*)(F.ws + WS_PA); const bf16* KI = (const bf16*)(F.ws + WS_KI); const float* WI = (const float*)(F.ws + WS_WI);
    unsigned short* SELG = (unsigned short*)F.out;
    constexpr int NUNITS = NB * 120;
#if TKPROBE == 21
    unsigned probe_steps = 0u;
#endif
#if TKPROBE >= 31 && TKPROBE <= 33
    unsigned probe_ticks = 0u; unsigned long long probe_t0 = 0ull;
#define PROBE_BEGIN(n) do { if (TKPROBE == (n)) { __builtin_amdgcn_sched_barrier(0); asm volatile("s_waitcnt vmcnt(0) lgkmcnt(0)" ::: "memory"); probe_t0 = __builtin_amdgcn_s_memrealtime(); asm volatile("s_waitcnt lgkmcnt(0)" ::: "memory"); __builtin_amdgcn_sched_barrier(0); } } while (0)
#define PROBE_END(n) do { if (TKPROBE == (n)) { __builtin_amdgcn_sched_barrier(0); asm volatile("s_waitcnt vmcnt(0) lgkmcnt(0)" ::: "memory"); const unsigned long long t1_ = __builtin_amdgcn_s_memrealtime(); asm volatile("s_waitcnt lgkmcnt(0)" ::: "memory"); probe_ticks += (unsigned)(t1_ - probe_t0); __builtin_amdgcn_sched_barrier(0); } } while (0)
#else
#define PROBE_BEGIN(n) do { } while (0)
#define PROBE_END(n) do { } while (0)
#endif
#ifndef TKSTAGE
#define TKSTAGE (-1)
#endif
#if TKSTAGE >= 0
    unsigned long long tks_acc = 0ull, tks_prev = 0ull;
#define TKS_MARK(k) do { if (blockIdx.x == 0 && threadIdx.x == 0) { asm volatile("s_waitcnt vmcnt(0) lgkmcnt(0)" ::: "memory"); const unsigned long long t_ = __builtin_amdgcn_s_memrealtime(); asm volatile("s_waitcnt lgkmcnt(0)" ::: "memory"); if ((k) == TKSTAGE) tks_acc += t_ - tks_prev; tks_prev = t_; } } while (0)
#else
#define TKS_MARK(k) do { } while (0)
#endif
    PROBE_BEGIN(33);
    int qcur = (int)blockIdx.x & 7, qtried = 0;
    bool skip_top = false;
    for (;;) {
        if (!skip_top) __syncthreads();
        skip_top = false;
#if TK_SHARD
        if (tid == 0) {
            unsigned uu;
            for (;;) { uu = __hip_atomic_fetch_add(F.ctl + 1024 + 512 * qrep + 64 * qcur, 1u, RLX_AGENT); if (uu < 120u || qtried == 7) break; qcur = (qcur + 1) & 7; ++qtried; }
            sm[161] = uu < 120u ? uu * 8u + (unsigned)qcur : (unsigned)NUNITS;
        }
#else
        if (tid == 0) sm[161] = __hip_atomic_fetch_add(F.ctl + CW_QUEUE + 64 * qrep, 1u, RLX_AGENT);
#endif
        __syncthreads();
            TKS_MARK(0);
        const int u = __builtin_amdgcn_readfirstlane((int)sm[161]);
#if TKPROBE == 21
        if (u >= NUNITS) { if (F.lane == 0) (void)__hip_atomic_fetch_add(F.ctl + CW_QUEUE + 32, probe_steps, RLX_AGENT); }
#endif
#if TKPROBE >= 31 && TKPROBE <= 33
        if (u >= NUNITS) { PROBE_END(33); }
        if (u >= NUNITS) { if (F.lane == 0) (void)__hip_atomic_fetch_add(F.ctl + CW_QUEUE + 32, probe_ticks, RLX_AGENT); }
#endif
#if TKSTAGE >= 0
        if (u >= NUNITS && blockIdx.x == 0 && threadIdx.x == 0) __hip_atomic_store(F.ctl + CW_QUEUE + 40, (unsigned)tks_acc, RLX_AGENT);
#endif
        if (u >= NUNITS) break;
        const int qb = 127 - (u >> 3), b = u & 7, q0 = qb * 32, ntiles = qb + 1;
        int lane_p = F.lane; asm volatile("" : "+v"(lane_p));
        const int r32 = lane_p & 31, hi = lane_p >> 5;
        const int t = q0 + r32;
        const bf16* KIb = KI + (size_t)b * SEQ * 64;
        bx8 qf[4][4];
        { const bf16* qrow = PA + (size_t)(b * SEQ + t) * PA_LD + PA_QI + hi * 8;
#pragma unroll
          for (int h = 0; h < 4; ++h)
#pragma unroll
              for (int ks = 0; ks < 4; ++ks) qf[h][ks] = *(const GAS bx8*)(qrow + h * 64 + ks * 16); }
        const f32x4 wv = *(const GAS f32x4*)(WI + (size_t)(b * SEQ + t) * 4);
#ifndef TKPROBE
#define TKPROBE 0
#endif
#if TK_FAST
        {
            const int ns = ntiles > 16 ? (ntiles - 1) >> 3 : 0;
            bx8 sa0[4];
            { const int j0 = wave < ns ? wave : 0;
              const bf16* kp0 = KIb + (size_t)r32 * 64 + hi * 8;
#pragma unroll
              for (int ks = 0; ks < 4; ++ks) sa0[ks] = *(const GAS bx8*)(kp0 + (size_t)(8 * j0 + 7) * 32 * 64 + ks * 16); }
            for (int rp11 = 0; rp11 < (TKPROBE == 11 ? 2 : 1); ++rp11) {
            if (ns > 0) {
                for (int i = tid; i < (32 * 4112) / 16; i += NWAVES * 64) *(LAS v4u*)(L + i * 16) = (v4u){0u, 0u, 0u, 0u};
            }
            if (tid < 32) sm[tid] = 0u;
            if ((tid >= 128 && tid < 160) || tid == 162) sm[tid] = 0u;
            __syncthreads();
            TKS_MARK(1);
            if (ns > 0) {
                LAS unsigned char* hrow8 = L + r32 * TK_ROW;
                if (wave < ns) { unsigned keyv[16]; tk_keys(keyv, sa0, qf, wv);
#pragma unroll
                    for (int r = 0; r < 16; ++r) { const unsigned k = keyv[r]; lds_add((LAS unsigned*)(hrow8 + ((k >> 20) & 0xFFCu)), 1u << ((k >> 17) & 24u)); } }
                __builtin_amdgcn_sched_barrier(0);
                if (wave + 8 < ns) { unsigned keyv[16]; bx8 sa1[4];
                    { const bf16* kp1 = KIb + (size_t)r32 * 64 + hi * 8 + (size_t)(8 * (wave + 8) + 7) * 32 * 64;
#pragma unroll
                      for (int ks = 0; ks < 4; ++ks) sa1[ks] = *(const GAS bx8*)(kp1 + ks * 16); }
                    tk_keys(keyv, sa1, qf, wv);
#pragma unroll
                    for (int r = 0; r < 16; ++r) { const unsigned k = keyv[r]; lds_add((LAS unsigned*)(hrow8 + ((k >> 20) & 0xFFCu)), 1u << ((k >> 17) & 24u)); } }
                __syncthreads();
            TKS_MARK(2);
                int lane = F.lane; asm volatile("" : "+v"(lane));
#pragma unroll 2
                for (int qq = 0; qq < 4; ++qq) {
                    const int r = wave * 4 + qq;
                    const unsigned T = (unsigned)((float)(TK2_TARGET * 32 * ns) * __builtin_amdgcn_rcpf((float)(q0 + r + 1))) + 1u;
                    const LAS unsigned char* hr = L + r * TK_ROW + (1008 - 16 * lane) * 4;
                    v4u w[4];
#pragma unroll
                    for (int i = 0; i < 4; ++i) w[i] = *(const LAS v4u*)(hr + i * 16);
                    unsigned tot = 0u;
#pragma unroll
                    for (int i = 0; i < 4; ++i) { tot = __builtin_amdgcn_sad_u8(w[i].x, 0u, tot); tot = __builtin_amdgcn_sad_u8(w[i].y, 0u, tot); tot = __builtin_amdgcn_sad_u8(w[i].z, 0u, tot); tot = __builtin_amdgcn_sad_u8(w[i].w, 0u, tot); }
                    const unsigned excl = wave_excl_scan_dpp(tot, lane), incl = excl + tot;
                    unsigned c = excl, fcw = 0u, xw = 0u; int fw = -1;
#pragma unroll
                    for (int wi = 15; wi >= 0; --wi) {
                        const unsigned x = (wi & 3) == 0 ? w[wi >> 2].x : ((wi & 3) == 1 ? w[wi >> 2].y : ((wi & 3) == 2 ? w[wi >> 2].z : w[wi >> 2].w));
                        const unsigned sx = __builtin_amdgcn_sad_u8(x, 0u, 0u);
                        if (fw < 0 && c + sx >= T) { fw = wi; fcw = c; xw = x; }
                        c += sx;
                    }
                    c = fcw; int fb = -1;
#pragma unroll
                    for (int by = 3; by >= 0; --by) { const unsigned cnt = (xw >> (8 * by)) & 0xFFu; if (fb < 0 && c + cnt >= T) fb = by; c += cnt; }
                    if (excl < T && incl >= T) sm[r] = (unsigned)(4 * (1008 - 16 * lane + fw) + (fb < 0 ? 0 : fb));
                }
                __syncthreads();
            TKS_MARK(3);
            }
            }
            for (int rp12 = 0; rp12 < (TKPROBE == 12 ? 2 : 1); ++rp12) {
            if (rp12) { if (tid >= 128 && tid < 160) sm[tid] = 0u; __syncthreads(); }
            PROBE_BEGIN(32);
            if (TK_PIPE) tk_pass_collect(L, KIb, ntiles, wave, r32, hi, lane_p, qf, wv, sm[r32]); else tk_pass<3>(L, KIb, ntiles, wave, r32, hi, lane_p, qf, wv, sm[r32]);
            PROBE_END(32);
            __syncthreads();
            TKS_MARK(4);
            }
            {
                int lane5 = F.lane; asm volatile("" : "+v"(lane5));
                PROBE_BEGIN(31);
#pragma unroll 1
                for (int qq5 = 0; qq5 < (TKPROBE == 13 ? 8 : 4); qq5 += 2) {
                    const int qq = qq5 & 3;
                    const int r = wave * 4 + qq;
                    const int m0 = (int)sm[128 + r], m1 = (int)sm[128 + r + 1];
                    const bool dry = TKPROBE == 13 && qq5 < 4;
                    if (TK_PAIR && m0 > 256 && m0 <= 576 && m1 > 256 && m1 <= 576) { tk2_select_pair<9>(L, sm, r, m0, m1, lane5, dry); continue; }
#pragma unroll 1
                    for (int h = 0; h < 2; ++h) { const int m = h ? m1 : m0;
                        if (m < 256 || m > TK2_CAP) { if (lane5 == 0) (void)__hip_atomic_fetch_or(sm + 162, 1u, __ATOMIC_RELAXED, __HIP_MEMORY_SCOPE_WORKGROUP); continue; }
                        if (m <= 576) tk2_select<9>(L, sm, r + h, m, lane5, dry); else tk2_select<12>(L, sm, r + h, m, lane5, dry); }
                }
            }
            PROBE_END(31);
            {
                int tid6 = F.tid; asm volatile("" : "+v"(tid6)); const int r = tid6 >> 4, c16 = (tid6 & 15) * 16;
                const LAS unsigned short* src = (const LAS unsigned short*)(L + r * TK2_KROW) + c16;
                const v4u v0 = *(const LAS v4u*)src, v1 = *(const LAS v4u*)(src + 8);
                unsigned short* dst = SELG + (size_t)(b * SEQ + q0 + r) * 256 + c16;
                *(GAS v4u*)dst = v0; *(GAS v4u*)(dst + 8) = v1;
            }
            __syncthreads();
            TKS_MARK(5);
            if (sm[162] == 0u) { skip_top = true; continue; }
#if TKPROBE == 9
            if (tid == 0) (void)__hip_atomic_fetch_add(F.ctl + CW_QUEUE + 32, 1u, RLX_AGENT);
#endif
        }
#endif

        for (int rep1 = 0; rep1 < (TKPROBE == 1 ? 2 : 1); ++rep1) {
        __syncthreads();
        for (int i = tid; i < (32 * 4112) / 16; i += NWAVES * 64) *(LAS v4u*)(L + i * 16) = (v4u){0u, 0u, 0u, 0u};
        if (tid >= 96 && tid < 161) sm[tid] = 0u;
        __syncthreads();
        tk_pass<1>(L, KIb, ntiles, wave, r32, hi, lane_p, qf, wv, 0u);
        __syncthreads();
        }
        int lane = F.lane; asm volatile("" : "+v"(lane));
#pragma unroll 1
        for (int qq3 = 0; qq3 < (TKPROBE == 2 ? 8 : 4); ++qq3) {
            const int qq = qq3 & 3; const int r = wave * 4 + qq;
            const LAS unsigned char* hr = L + r * TK_ROW + (1008 - 16 * lane) * 4;
            v4u w[4];
#pragma unroll
            for (int i = 0; i < 4; ++i) w[i] = *(const LAS v4u*)(hr + i * 16);
            unsigned tot = 0u;
#pragma unroll
            for (int i = 0; i < 4; ++i) { tot += (w[i].x & 0xffffu) + (w[i].x >> 16); tot += (w[i].y & 0xffffu) + (w[i].y >> 16); tot += (w[i].z & 0xffffu) + (w[i].z >> 16); tot += (w[i].w & 0xffffu) + (w[i].w >> 16); }
            unsigned incl = tot;
#pragma unroll
            for (int o = 1; o < 64; o <<= 1) { const unsigned v = __shfl_up(incl, o); if (lane >= o) incl += v; }
            const unsigned excl = incl - tot;
            unsigned c = excl; int fb = -1; unsigned fc = 0u, fm = 0u;
#pragma unroll
            for (int wi = 15; wi >= 0; --wi) {
                const unsigned x = (wi & 3) == 0 ? w[wi >> 2].x : ((wi & 3) == 1 ? w[wi >> 2].y : ((wi & 3) == 2 ? w[wi >> 2].z : w[wi >> 2].w));
                const int bin0 = 2 * (1008 - 16 * lane + wi);
                unsigned cnt = x >> 16;
                if (fb < 0 && c + cnt >= 256u) { fb = bin0 + 1; fc = c; fm = cnt; }
                c += cnt; cnt = x & 0xffffu;
                if (fb < 0 && c + cnt >= 256u) { fb = bin0; fc = c; fm = cnt; }
                c += cnt;
            }
            if (excl < 256u && incl >= 256u) { sm[r] = (unsigned)fb; sm[32 + r] = fc; sm[64 + r] = fm; if (fm > (unsigned)TK_CAP) (void)__hip_atomic_fetch_or(sm + 160, 1u << r, __ATOMIC_RELAXED, __HIP_MEMORY_SCOPE_WORKGROUP); }
        }
        __syncthreads();
        for (int rep2 = 0; rep2 < (TKPROBE == 3 ? 2 : 1); ++rep2) {
        if (rep2) { if (tid >= 96 && tid < 160) sm[tid] = 0u; __syncthreads(); }
        tk_pass<2>(L, KIb, ntiles, wave, r32, hi, lane_p, qf, wv, sm[r32]);
        __syncthreads();
        }
        int lane5 = F.lane; asm volatile("" : "+v"(lane5));
        const unsigned long long lt_mask = (lane5 == 0) ? 0ull : (~0ull >> (64 - lane5));
#pragma unroll 1
        for (int qq5 = 0; qq5 < (TKPROBE == 4 ? 8 : 4); ++qq5) {
            const int qq = qq5 & 3; const int r = wave * 4 + qq;
            const unsigned m0 = sm[128 + r]; const int m = (int)(m0 < (unsigned)TK_CAP ? m0 : (unsigned)TK_CAP);
            const int cab = (int)sm[32 + r], need2 = 256 - cab; const unsigned bst = sm[r];
            if (m0 > (unsigned)TK_CAP) continue;
            const LAS unsigned long long* cd = (const LAS unsigned long long*)(L + r * TK_CROW);
            LAS unsigned short* selr = (LAS unsigned short*)(L + TK_SEL_OFF) + r * 256;
            unsigned kr[8], ir[8];
#pragma unroll
            for (int j = 0; j < 8; ++j) { const int i = lane5 + 64 * j; const unsigned long long e = i < m ? cd[i] : 0ull; kr[j] = (unsigned)(e >> 32); ir[j] = (unsigned)e & 0xFFFFu; }
            unsigned tau = 0u, X = 0xFFFFu, exact_ge = 0u;
            if (need2 < m) {
                unsigned prefix = bst << 21;
                for (int bit = 20; bit >= 0; --bit) {
                    const unsigned cand = prefix | (1u << bit);
                    int cnt = 0;
#pragma unroll
                    for (int j = 0; j < 8; ++j) cnt += __popcll(__ballot(kr[j] >= cand));
                    if (cnt == need2) { exact_ge = cand; break; }
                    if (cnt > need2) prefix = cand;
                }
                tau = prefix;
                int cgt = 0, ceq = 0;
#pragma unroll
                for (int j = 0; j < 8; ++j) { cgt += __popcll(__ballot(kr[j] > tau)); ceq += __popcll(__ballot(kr[j] == tau && lane5 + 64 * j < m)); }
                const int need_eq = need2 - cgt;
                if (exact_ge == 0u && need_eq < ceq) {
                    unsigned xp = 0u;
                    for (int bit = 11; bit >= 0; --bit) {
                        const unsigned cand = xp | (1u << bit);
                        int cnt = 0;
#pragma unroll
                        for (int j = 0; j < 8; ++j) cnt += __popcll(__ballot(kr[j] == tau && ir[j] < cand && lane5 + 64 * j < m));
                        if (cnt < need_eq) xp = cand;
                    }
                    X = xp;
                }
            }
            int base = cab;
#pragma unroll
            for (int j = 0; j < 8; ++j) {
                const bool in = lane5 + 64 * j < m;
                const bool take = in && (need2 >= m || (exact_ge != 0u ? kr[j] >= exact_ge : (kr[j] > tau || (kr[j] == tau && ir[j] <= X))));
                const unsigned long long bs = __ballot(take);
                const int pos = base + __popcll(bs & lt_mask);
                if (take && pos < 256) selr[pos] = (unsigned short)ir[j];
                base += __popcll(bs);
            }
        }
        __syncthreads();
        { int tid6 = F.tid; asm volatile("" : "+v"(tid6)); const int r = tid6 >> 4, c16 = (tid6 & 15) * 16;
          const LAS unsigned short* src = (const LAS unsigned short*)(L + TK_SEL_OFF) + r * 256 + c16;
          const v4u v0 = *(const LAS v4u*)src, v1 = *(const LAS v4u*)(src + 8);
          unsigned short* dst = SELG + (size_t)(b * SEQ + q0 + r) * 256 + c16;
          *(GAS v4u*)dst = v0; *(GAS v4u*)(dst + 8) = v1; }
        const unsigned slowmask = sm[160];
        if (slowmask) {
            asm volatile("s_waitcnt vmcnt(0)" ::: "memory"); __syncthreads();
            for (int r = wave; r < 32; r += 8) if ((slowmask >> r) & 1u) slow_select(F, b * SEQ + q0 + r, (LAS unsigned*)(L + wave * 16384), SELG + (size_t)(b * SEQ + q0 + r) * 256);
        }
    }
}

constexpr int AT_WAVE_LDS = 17408;
static_assert(8 * AT_WAVE_LDS <= PHASE_LDS, "attention LDS map");
typedef float f32x2_t __attribute__((ext_vector_type(2)));
template <bool HI> __device__ __forceinline__ unsigned fp8x2_to_bf16x2(int w) { const f32x2_t f = __builtin_amdgcn_cvt_pk_f32_fp8(w, HI);
    return pg8::cvt_pk_bf16_av(f.x, f.y); }
__device__ __forceinline__ void p4_attn(Frame& F) {
    typedef pg8::bf16x8 bx8;
    const int lane = F.lane, n16 = lane & 15, kg = lane >> 4;
    LAS unsigned char* wl = F.lds + F.wave * AT_WAVE_LDS;
    LAS unsigned short* sl = (LAS unsigned short*)(wl + 16384);
    const bf16* PA = (const bf16*)(F.ws + WS_PA); const unsigned char* KV = (const unsigned char*)F.out + OUT_KV; bf16* ATT = (bf16*)((unsigned char*)F.out + OUT_ARN);
    const unsigned short* SELG = (const unsigned short*)F.out;
    const int gw = F.vcu * NWAVES + F.wave, NGW = F.G * NWAVES;
    const int nq_per = (M + NGW - 1) / NGW;
    const float c2 = 0.125f * 1.4426950408889634f;
    const float mref = ((const float*)(F.ws + WS_GAINS))[192] * 8.0f; const float nmc = -mref * (0.125f * 1.4426950408889634f);
    const int trow = 4 * kg + (n16 >> 2), tx = trow & 7;
    const int trbase = trow * 256 + (n16 & 3) * 8;
#ifndef AT_VHALF
#define AT_VHALF 0
#endif
#if AT_VHALF
    const int vkey16 = lane >> 2, c4 = lane & 3;
#define VROW(i) (16 * ((i) >> 1) + vkey16)
#define VCH(i) (4 * ((i) & 1) + c4)
#else
    const int vkey = lane >> 3, c8v = lane & 7;
#define VROW(i) (8 * (i) + vkey)
#define VCH(i) (c8v)
#endif
#ifndef AT_XQ
#define AT_XQ 1
#endif
#ifndef AT_VD0
#define AT_VD0 3
#endif
#ifndef AT_XQ_LEARLY
#define AT_XQ_LEARLY 0
#endif
#ifndef AT_XQ_KS
#define AT_XQ_KS 3
#endif
#ifndef AT_VD
#define AT_VD 4
#endif
#ifndef AT_SKEW
#define AT_SKEW 0
#endif
    if (AT_SKEW && F.wave >= 4) { __builtin_amdgcn_s_sleep(127); if (AT_SKEW > 1) __builtin_amdgcn_s_sleep(127); }
    unsigned long long lnext = 0ull;
#if AT_XQ
    v4u ka[8][2];
#ifndef AT_XQQ
#define AT_XQQ 1
#endif
    v4u qua = (v4u){0u, 0u, 0u, 0u}, qub = qua;
    {
        const int q0_ = gw; const int b0_ = q0_ / SEQ, t0_ = q0_ % SEQ;
        if (q0_ < M) {
            if (AT_XQQ && n16 < 8) { qua = __builtin_nontemporal_load((const GAS v4u*)(PA + (size_t)q0_ * PA_LD + n16 * 64 + kg * 16)); qub = __builtin_nontemporal_load((const GAS v4u*)(PA + (size_t)q0_ * PA_LD + n16 * 64 + kg * 16 + 8)); }
            if (t0_ >= TOPK) *(LAS unsigned long long*)(sl + lane * 4) = *(const GAS unsigned long long*)(SELG + (size_t)q0_ * 256 + lane * 4);
            else {
#pragma unroll
                for (int i = 0; i < 4; ++i) { const int j = lane * 4 + i; sl[j] = (unsigned short)(j <= t0_ ? j : t0_); } }
            asm volatile("" ::: "memory");
            const GAS unsigned char* kvb0 = (const GAS unsigned char*)(KV + (size_t)b0_ * SEQ * 256);
#pragma unroll
            for (int T = 0; T < 7; ++T) { const unsigned off = (unsigned)sl[16 * T + n16] * 256u + (unsigned)kg * 16u;
                ka[T][0] = *(const GAS v4u*)(kvb0 + off); ka[T][1] = *(const GAS v4u*)(kvb0 + off + 64); }
        }
    }
#else
    if (gw < M && (gw % SEQ) >= TOPK) lnext = *(const GAS unsigned long long*)(SELG + (size_t)gw * 256 + lane * 4);
#endif
#pragma unroll 1
    for (int it = 0; it < nq_per; ++it) {
#if AT_XQ
        LAS unsigned short* const sl = (LAS unsigned short*)(wl + 16384 + (it & 1) * 512);
        LAS unsigned short* const sln = (LAS unsigned short*)(wl + 16384 + ((it + 1) & 1) * 512);
#endif
        int qidx;
        if (NGW == 2048) { const int b_ = it >> 1; const int t_ = (it & 1) ? (SEQ - 1 - gw) : gw; qidx = b_ * SEQ + t_; }
        else { qidx = gw + it * NGW; if (qidx >= M) break; }
        int qn = M;
        if (it + 1 < nq_per) { if (NGW == 2048) { const int b_ = (it + 1) >> 1; const int t_ = ((it + 1) & 1) ? (SEQ - 1 - gw) : gw; qn = b_ * SEQ + t_; } else qn = gw + (it + 1) * NGW; }
        const bool qn_list = qn < M && (qn % SEQ) >= TOPK;
        const int b = qidx / SEQ, t = qidx % SEQ, cnt = (t + 1 < TOPK) ? t + 1 : TOPK;
        const GAS unsigned char* kvb = (const GAS unsigned char*)(KV + (size_t)b * SEQ * 256);
#if AT_XQ
#else
        if (t >= TOPK) { *(LAS unsigned long long*)(sl + lane * 4) = lnext; }
        else {
#pragma unroll
            for (int i = 0; i < 4; ++i) { const int j = lane * 4 + i; sl[j] = (unsigned short)(j <= t ? j : t); }
        }
        asm volatile("" ::: "memory");
#endif
        v4u vr[AT_VD][4];
#pragma unroll
        for (int c = 0; c < AT_VD0; ++c)
#pragma unroll
            for (int i = 0; i < 4; ++i) { const unsigned off = (unsigned)sl[32 * c + VROW(i)] * 256u + 128u + (unsigned)VCH(i) * 16u; vr[c][i] = *(const GAS v4u*)(kvb + off); }
        long qb[4];
        { long q0 = 0, q1 = 0;
#if AT_XQ && AT_XQQ
          if (n16 < 8) { const v4u ua = qua, ub = qub;
#else
          if (n16 < 8) { const v4u ua = __builtin_nontemporal_load((const GAS v4u*)(PA + (size_t)qidx * PA_LD + n16 * 64 + kg * 16)), ub = __builtin_nontemporal_load((const GAS v4u*)(PA + (size_t)qidx * PA_LD + n16 * 64 + kg * 16 + 8));
#endif
              int w0 = __builtin_amdgcn_cvt_pk_fp8_f32(bflo(ua.x), bfhi(ua.x), 0, false); w0 = __builtin_amdgcn_cvt_pk_fp8_f32(bflo(ua.y), bfhi(ua.y), w0, true);
              int w1 = __builtin_amdgcn_cvt_pk_fp8_f32(bflo(ua.z), bfhi(ua.z), 0, false); w1 = __builtin_amdgcn_cvt_pk_fp8_f32(bflo(ua.w), bfhi(ua.w), w1, true);
              int w2 = __builtin_amdgcn_cvt_pk_fp8_f32(bflo(ub.x), bfhi(ub.x), 0, false); w2 = __builtin_amdgcn_cvt_pk_fp8_f32(bflo(ub.y), bfhi(ub.y), w2, true);
              int w3 = __builtin_amdgcn_cvt_pk_fp8_f32(bflo(ub.z), bfhi(ub.z), 0, false); w3 = __builtin_amdgcn_cvt_pk_fp8_f32(bflo(ub.w), bfhi(ub.w), w3, true);
              q0 = (long)((unsigned long long)(unsigned)w0 | ((unsigned long long)(unsigned)w1 << 32)); q1 = (long)((unsigned long long)(unsigned)w2 | ((unsigned long long)(unsigned)w3 << 32)); }
          const bool g1 = (n16 >> 2) == 1;
          qb[0] = g1 ? 0 : q0; qb[1] = g1 ? 0 : q1; qb[2] = g1 ? q0 : 0; qb[3] = g1 ? q1 : 0; }
#if !AT_XQ
        v4u ka[8][2];
#pragma unroll
        for (int T = 0; T < 7; ++T) { const unsigned off = (unsigned)sl[16 * T + n16] * 256u + (unsigned)kg * 16u;
            ka[T][0] = *(const GAS v4u*)(kvb + off); ka[T][1] = *(const GAS v4u*)(kvb + off + 64); }
#endif
        float sum = 0.f;
        bx8 pfr[8];
#pragma unroll
        for (int KS = 0; KS < 8; ++KS) {
            v4u pw;
#pragma unroll
            for (int half = 0; half < 2; ++half) { const int T = 2 * KS + half;
                asm volatile("" ::: "memory");
                if (T + 7 < 16) { const unsigned off = (unsigned)sl[16 * (T + 7) + n16] * 256u + (unsigned)kg * 16u;
                    ka[(T + 7) & 7][0] = *(const GAS v4u*)(kvb + off); ka[(T + 7) & 7][1] = *(const GAS v4u*)(kvb + off + 64); }
                f32x4 s = (f32x4){0.f, 0.f, 0.f, 0.f};
#pragma unroll
                for (int g = 0; g < 2; ++g) { const v4u kk = ka[T & 7][g];
                    const long a0 = (long)((unsigned long long)kk.x | ((unsigned long long)kk.y << 32)), a1 = (long)((unsigned long long)kk.z | ((unsigned long long)kk.w << 32));
                    s = __builtin_amdgcn_mfma_f32_16x16x32_fp8_fp8(a0, qb[2 * g], s, 0, 0, 0);
                    s = __builtin_amdgcn_mfma_f32_16x16x32_fp8_fp8(a1, qb[2 * g + 1], s, 0, 0, 0); }
                float pv4[4];
#pragma unroll
                for (int r = 0; r < 4; ++r) pv4[r] = __builtin_amdgcn_exp2f(__builtin_fmaf(s[r], c2, nmc));
                if (16 * T + 16 > cnt) {
#pragma unroll
                    for (int r = 0; r < 4; ++r) pv4[r] = (16 * T + 4 * kg + r < cnt) ? pv4[r] : 0.f; }
#pragma unroll
                for (int r = 0; r < 4; ++r) { if (!AT_MFMA_SUM) sum += pv4[r]; }
                if (half == 0) { pw.x = pg8::cvt_pk_bf16_av(pv4[0], pv4[1]); pw.y = pg8::cvt_pk_bf16_av(pv4[2], pv4[3]); } else { pw.z = pg8::cvt_pk_bf16_av(pv4[0], pv4[1]); pw.w = pg8::cvt_pk_bf16_av(pv4[2], pv4[3]); }
            }
            pfr[KS] = __builtin_bit_cast(bx8, pw); asm volatile("" : "+v"(pfr[KS]));
#if AT_XQ && AT_XQ_LEARLY
            if (KS == 4 && qn_list) lnext = __builtin_nontemporal_load((const GAS unsigned long long*)(SELG + (size_t)qn * 256 + lane * 4));
#endif
        }
        if (!AT_MFMA_SUM) { sum += __shfl_xor(sum, 16); sum += __shfl_xor(sum, 32); }
        asm volatile("" ::: "memory");
#if AT_XQ && !AT_XQ_LEARLY
        if (qn_list) lnext = __builtin_nontemporal_load((const GAS unsigned long long*)(SELG + (size_t)qn * 256 + lane * 4));
#endif
#pragma unroll
        for (int c = AT_VD0; c < AT_VD; ++c)
#pragma unroll
            for (int i = 0; i < 4; ++i) { const unsigned off = (unsigned)sl[32 * c + VROW(i)] * 256u + 128u + (unsigned)VCH(i) * 16u; vr[c][i] = *(const GAS v4u*)(kvb + off); }
        f32x4 O[8];
#pragma unroll
        for (int i = 0; i < 8; ++i) O[i] = (f32x4){0.f, 0.f, 0.f, 0.f};
        f32x4 Os = (f32x4){0.f, 0.f, 0.f, 0.f};
        const bx8 ones8 = (bx8){(short)0x3F80, (short)0x3F80, (short)0x3F80, (short)0x3F80, (short)0x3F80, (short)0x3F80, (short)0x3F80, (short)0x3F80};
#pragma unroll
        for (int KS = 0; KS < 8; ++KS) {
            LAS unsigned char* buf = wl + (KS & 1) * 8192;
            asm volatile("" ::: "memory");
#pragma unroll
            for (int i = 0; i < 4; ++i) { const int rowl = VROW(i); const int c8 = VCH(i); const v4u w = vr[KS % AT_VD][i];
                v4u lo, hi4;
                lo.x = fp8x2_to_bf16x2<false>((int)w.x); lo.y = fp8x2_to_bf16x2<true>((int)w.x); lo.z = fp8x2_to_bf16x2<false>((int)w.y); lo.w = fp8x2_to_bf16x2<true>((int)w.y);
                hi4.x = fp8x2_to_bf16x2<false>((int)w.z); hi4.y = fp8x2_to_bf16x2<true>((int)w.z); hi4.z = fp8x2_to_bf16x2<false>((int)w.w); hi4.w = fp8x2_to_bf16x2<true>((int)w.w);
                LAS unsigned char* rp = buf + rowl * 256 + ((c8 * 32) ^ ((rowl & 7) << 5));
                *(LAS v4u*)rp = lo; *(LAS v4u*)(rp + 16) = hi4; }
            if (KS + AT_VD < 8) {
#pragma unroll
                for (int i = 0; i < 4; ++i) { const unsigned off = (unsigned)sl[32 * (KS + AT_VD) + VROW(i)] * 256u + 128u + (unsigned)VCH(i) * 16u; vr[KS % AT_VD][i] = *(const GAS v4u*)(kvb + off); }
            }
#if AT_XQ
            if (KS == AT_XQ_KS && qn < M) {
                const int bn = qn / SEQ, tn = qn % SEQ;
                if (tn >= TOPK) *(LAS unsigned long long*)(sln + lane * 4) = lnext;
                else {
#pragma unroll
                    for (int i = 0; i < 4; ++i) { const int j = lane * 4 + i; sln[j] = (unsigned short)(j <= tn ? j : tn); } }
                asm volatile("" ::: "memory");
                const GAS unsigned char* kvbn = (const GAS unsigned char*)(KV + (size_t)bn * SEQ * 256);
#pragma unroll
                for (int T = 0; T < 7; ++T) { const unsigned off = (unsigned)sln[16 * T + n16] * 256u + (unsigned)kg * 16u;
                    ka[T][0] = *(const GAS v4u*)(kvbn + off); ka[T][1] = *(const GAS v4u*)(kvbn + off + 64); }
                if (AT_XQQ && n16 < 8) { qua = __builtin_nontemporal_load((const GAS v4u*)(PA + (size_t)qn * PA_LD + n16 * 64 + kg * 16)); qub = __builtin_nontemporal_load((const GAS v4u*)(PA + (size_t)qn * PA_LD + n16 * 64 + kg * 16 + 8)); }
                asm volatile("" ::: "memory");
            }
#endif
            if (!AT_XQ && KS == 5 && qn_list) lnext = __builtin_nontemporal_load((const GAS unsigned long long*)(SELG + (size_t)qn * 256 + lane * 4));
            const bx8 pf = pfr[KS];
#pragma unroll
            for (int gd = 0; gd < 8; ++gd) {
                const LAS unsigned char* p0 = buf + trbase + ((gd ^ tx) << 5);
                const v4i16_t lo = __builtin_amdgcn_ds_read_tr16_b64_v4i16((LAS v4i16_t*)p0);
                const v4i16_t hi4 = __builtin_amdgcn_ds_read_tr16_b64_v4i16((LAS v4i16_t*)(p0 + 4096));
                const bx8 vf = (bx8){lo[0], lo[1], lo[2], lo[3], hi4[0], hi4[1], hi4[2], hi4[3]};
                O[gd] = __builtin_amdgcn_mfma_f32_16x16x32_bf16(pf, vf, O[gd], 0, 0, 0);
            }
            if (AT_MFMA_SUM) Os = __builtin_amdgcn_mfma_f32_16x16x32_bf16(pf, ones8, Os, 0, 0, 0);
        }
        float inv[4];
#pragma unroll
        for (int r = 0; r < 4; ++r) inv[r] = AT_MFMA_SUM ? 1.0f / Os[r] : 1.0f / __shfl(sum, (4 * kg + r) & 15);
#if AT_WIDE_OUT
        {
            LAS unsigned short* ob = (LAS unsigned short*)wl;
            if (kg < 2) {
#pragma unroll
                for (int db = 0; db < 4; ++db)
#pragma unroll
                    for (int r = 0; r < 4; ++r) { const float v = (kg == 0 ? O[db][r] : O[4 + db][r]) * inv[r]; ob[(4 * kg + r) * 64 + db * 16 + n16] = (unsigned short)f2bf(v); }
            }
            asm volatile("s_waitcnt lgkmcnt(0)" ::: "memory");
            const v4u ov = *(const LAS v4u*)(wl + lane * 16);
            *(GAS v4u*)(ATT + (size_t)qidx * 1536 + lane * 8) = ov;
            asm volatile("" ::: "memory");
        }
#else
        if (kg < 2) {
            bf16* orow = ATT + (size_t)qidx * 1536 + (4 * kg) * 64 + n16;
#pragma unroll
            for (int db = 0; db < 4; ++db)
#pragma unroll
                for (int r = 0; r < 4; ++r) { const float v = (kg == 0 ? O[db][r] : O[4 + db][r]) * inv[r]; orow[r * 64 + db * 16] = (bf16)f2bf(v); }
        }
#endif
    }
}
constexpr int RG_WT_PITCH = 144;
constexpr int RG_WA_OFF = 0, RG_WX_OFF = 32 * RG_WT_PITCH, RG_XCB_OFF = 2 * 32 * RG_WT_PITCH, RG_XF_OFF = RG_XCB_OFF + 128 * RG_WT_PITCH, RG_CARR_OFF = RG_XF_OFF + 128 * 256;
constexpr int RG_STG_OFF = RG_CARR_OFF + 2 * 8 * 2 * 32 * 4, RG_STG_WAVE = 24 * 128 + 1024 + 1024;
static_assert(RG_STG_OFF + 8 * RG_STG_WAVE <= PHASE_LDS, "rg-lru LDS map");
__device__ __forceinline__ float fast_sigmoid(float x) { return __builtin_amdgcn_rcpf(1.0f + __builtin_amdgcn_exp2f(-1.4426950408889634f * x)); }
__device__ __forceinline__ void p4_rglru(Frame& F) {
    typedef pg8::bf16x8 bx8;
    const int tid = F.tid, lane = F.lane, wave = F.wave, n16 = lane & 15, kg = lane >> 4;
    LAS unsigned char* L = F.lds;
    LAS float* Xf = (LAS float*)(L + RG_XF_OFF); LAS float* carr = (LAS float*)(L + RG_CARR_OFF);
    const bf16* RX = (const bf16*)(F.ws + WS_RX); const bf16* RG = (const bf16*)(F.ws + WS_RGATE); bf16* RNN = (bf16*)((unsigned char*)F.out + OUT_ARN) + 512;
    const float* conv_w = F.in[6]; const float* conv_b = F.in[7]; const float* rg_wa = F.in[8]; const float* rg_ba = F.in[9]; const float* rg_wx = F.in[10]; const float* rg_bx = F.in[11]; const float* lam = F.in[12];
    for (int task = F.vcu; task < NB * 32; task += F.G) {
        const int b = task >> 5, nb = (task >> 1) & 15, hf = task & 1, c0 = nb * 64, e0 = 32 * hf;
        __syncthreads();
        for (int i = tid; i < 2048; i += NWAVES * 64) { const int d = i >> 5, e = i & 31;
            *(LAS bf16*)(L + RG_WA_OFF + e * RG_WT_PITCH + d * 2) = (bf16)f2bf(rg_wa[(size_t)nb * 4096 + d * 64 + e0 + e]);
            *(LAS bf16*)(L + RG_WX_OFF + e * RG_WT_PITCH + d * 2) = (bf16)f2bf(rg_wx[(size_t)nb * 4096 + d * 64 + e0 + e]); }
        const int c = c0 + lane;
        const float cw0 = conv_w[c], cw1 = conv_w[1024 + c], cw2 = conv_w[2048 + c], cw3 = conv_w[3072 + c], cb = conv_b[c];
        float bav[2], bxv[2], lsl[2];
#pragma unroll
        for (int j = 0; j < 2; ++j) { const int ce = c0 + e0 + 16 * j + n16; bav[j] = rg_ba[ce]; bxv[j] = rg_bx[ce]; lsl[j] = -8.0f * 1.4426950408889634f * log1pf(__expf(-lam[ce])); }
        float hst[2] = {0.f, 0.f};
        __syncthreads();
        LAS unsigned char* stg = L + RG_STG_OFF + wave * RG_STG_WAVE;
        const int xr_row = lane >> 3, xr_c8 = lane & 7, gt_tok = lane >> 2, gt_c8 = lane & 3;
        v4u xq[3][3], gq[3];
#pragma unroll
        for (int pc = 0; pc < 3; ++pc) { const int t0 = pc * 128 + wave * 16; const size_t rowb = (size_t)b * SEQ + t0;
#pragma unroll
            for (int i = 0; i < 3; ++i) { const int ri = 8 * i + xr_row, t = t0 - 3 + ri; xq[pc][i] = (v4u){0u, 0u, 0u, 0u};
                if (ri < 19 && t >= 0) xq[pc][i] = *(const GAS v4u*)(RX + (rowb - 3 + ri) * 1024 + c0 + xr_c8 * 8); }
            gq[pc] = *(const GAS v4u*)(RG + (rowb + gt_tok) * 1024 + c0 + e0 + gt_c8 * 8); }
#pragma unroll 1
        for (int ch = 0; ch < SEQ / 128; ++ch) {
            const int t0 = ch * 128 + wave * 16;
            const size_t rowb = (size_t)b * SEQ + t0;
#pragma unroll
            for (int i = 0; i < 3; ++i) *(LAS v4u*)(stg + (8 * i + xr_row) * 128 + xr_c8 * 16) = xq[0][i];
            *(LAS v4u*)(stg + 24 * 128 + gt_tok * 64 + gt_c8 * 16) = gq[0];
#pragma unroll
            for (int i = 0; i < 3; ++i) { xq[0][i] = xq[1][i]; xq[1][i] = xq[2][i]; }
            gq[0] = gq[1]; gq[1] = gq[2];
            if (ch + 3 < SEQ / 128) {
#pragma unroll
                for (int i = 0; i < 3; ++i) { const int ri = 8 * i + xr_row; if (ri < 19) xq[2][i] = *(const GAS v4u*)(RX + (rowb + 384 - 3 + ri) * 1024 + c0 + xr_c8 * 8); }
                gq[2] = *(const GAS v4u*)(RG + (rowb + 384 + gt_tok) * 1024 + c0 + e0 + gt_c8 * 8);
            }
            asm volatile("s_waitcnt lgkmcnt(0)" ::: "memory");
            float xv[19];
#pragma unroll
            for (int i = 0; i < 19; ++i) xv[i] = bf2f(*(const LAS unsigned short*)(stg + i * 128 + lane * 2));
#pragma unroll
            for (int i = 0; i < 16; ++i) { const float x = cb + cw0 * xv[i] + cw1 * xv[i + 1] + cw2 * xv[i + 2] + cw3 * xv[i + 3];
                Xf[(wave * 16 + i) * 64 + lane] = x; *(LAS bf16*)(L + RG_XCB_OFF + (wave * 16 + i) * RG_WT_PITCH + lane * 2) = (bf16)f2bf(x); }
            float gcur[2][4];
#pragma unroll
            for (int j = 0; j < 2; ++j)
#pragma unroll
                for (int r = 0; r < 4; ++r) gcur[j][r] = bf2f(*(const LAS unsigned short*)(stg + 24 * 128 + (4 * kg + r) * 64 + (16 * j + n16) * 2));
            asm volatile("s_waitcnt lgkmcnt(0)" ::: "memory");
            bx8 af[2];
#pragma unroll
            for (int ks = 0; ks < 2; ++ks) af[ks] = *(const LAS bx8*)(L + RG_XCB_OFF + (wave * 16 + n16) * RG_WT_PITCH + (32 * ks + 8 * kg) * 2);
            float av[2][4], bv[2][4], Pl[2], Hl[2];
#pragma unroll
            for (int j = 0; j < 2; ++j) {
                f32x4 cr = (f32x4){0.f, 0.f, 0.f, 0.f}, ci = (f32x4){0.f, 0.f, 0.f, 0.f};
#pragma unroll
                for (int ks = 0; ks < 2; ++ks) {
                    const bx8 wa_f = *(const LAS bx8*)(L + RG_WA_OFF + (16 * j + n16) * RG_WT_PITCH + (32 * ks + 8 * kg) * 2);
                    const bx8 wx_f = *(const LAS bx8*)(L + RG_WX_OFF + (16 * j + n16) * RG_WT_PITCH + (32 * ks + 8 * kg) * 2);
                    cr = __builtin_amdgcn_mfma_f32_16x16x32_bf16(af[ks], wa_f, cr, 0, 0, 0);
                    ci = __builtin_amdgcn_mfma_f32_16x16x32_bf16(af[ks], wx_f, ci, 0, 0, 0);
                }
                float p = 1.f, h = 0.f;
#pragma unroll
                for (int r = 0; r < 4; ++r) {
                    const float rr = fast_sigmoid(cr[r] + bav[j]), ig = fast_sigmoid(ci[r] + bxv[j]);
                    const float l2 = rr * lsl[j];
                    const float a = __builtin_amdgcn_exp2f(l2);
                    const float x2 = l2 * 1.3862943611198906f;
                    const float oma = x2 > -0.0625f ? -x2 * (1.0f + x2 * (0.5f + x2 * (0.16666667f + x2 * 0.041666668f))) : 1.0f - a * a;
                    const float xcv = Xf[(wave * 16 + 4 * kg + r) * 64 + e0 + 16 * j + n16];
                    const float bb = __builtin_amdgcn_sqrtf(oma) * (ig * xcv);
                    av[j][r] = a; bv[j][r] = bb; h = a * h + bb; p *= a;
                }
                Pl[j] = p; Hl[j] = h;
            }
            float Pe[2], He[2];
#pragma unroll
            for (int j = 0; j < 2; ++j) {
                float P = Pl[j], H = Hl[j];
                { const float p1 = __shfl_up(P, 16), h1 = __shfl_up(H, 16); if (kg >= 1) { H = P * h1 + H; P = P * p1; } }
                { const float p2 = __shfl_up(P, 32), h2 = __shfl_up(H, 32); if (kg >= 2) { H = P * h2 + H; P = P * p2; } }
                const float pe = __shfl_up(P, 16), he = __shfl_up(H, 16);
                Pe[j] = kg >= 1 ? pe : 1.f; He[j] = kg >= 1 ? he : 0.f;
                if (kg == 3) { LAS float* cw_ = carr + (ch & 1) * 512 + wave * 64 + j * 32; cw_[n16] = P; cw_[16 + n16] = H; }
            }
            __syncthreads();
#pragma unroll
            for (int j = 0; j < 2; ++j) {
                const LAS float* cr_ = carr + (ch & 1) * 512 + j * 32;
                float cin = 0.f, cc = hst[j];
#pragma unroll
                for (int w2 = 0; w2 < 8; ++w2) { if (w2 == wave) cin = cc; cc = cr_[w2 * 64 + n16] * cc + cr_[w2 * 64 + 16 + n16]; }
                hst[j] = cc;
                float h = Pe[j] * cin + He[j];
#pragma unroll
                for (int r = 0; r < 4; ++r) { h = av[j][r] * h + bv[j][r];
                    const float g = gcur[j][r]; const float u = 0.7978845608028654f * (g + 0.044715f * g * g * g);
                    *(LAS bf16*)(stg + 24 * 128 + 1024 + (4 * kg + r) * 64 + (16 * j + n16) * 2) = (bf16)f2bf(h * (g * fast_sigmoid(2.0f * u))); }
            }
            asm volatile("s_waitcnt lgkmcnt(0)" ::: "memory");
            { const v4u o = *(const LAS v4u*)(stg + 24 * 128 + 1024 + gt_tok * 64 + gt_c8 * 16);
              *(GAS v4u*)(RNN + (rowb + gt_tok) * 1536 + c0 + e0 + gt_c8 * 8) = o; }
        }
    }
}

constexpr int RG2_XCB_OFF = 2 * 32 * RG_WT_PITCH, RG2_XF_OFF = RG2_XCB_OFF + 256 * RG_WT_PITCH, RG2_CARR_OFF = RG2_XF_OFF + 256 * 128;
constexpr int RG2_STG_OFF = RG2_CARR_OFF + 2 * 8 * 2 * 32 * 4, RG2_STG_WAVE = 35 * 128 + 2048 + 2048;
static_assert(RG2_STG_OFF + 8 * RG2_STG_WAVE <= PHASE_LDS, "rg-lru LDS map");
__device__ __forceinline__ unsigned rg_cvt_pk(float lo, float hi) { unsigned r; asm("v_cvt_pk_bf16_f32 %0, %1, %2" : "=v"(r) : "v"(lo), "v"(hi)); return r; }
__device__ __forceinline__ void p4_rglru2(Frame& F) {
    typedef pg8::bf16x8 bx8;
    const int tid = F.tid, lane = F.lane, wave = F.wave, n16 = lane & 15, kg = lane >> 4;
    LAS unsigned char* L = F.lds;
    LAS float* Xf = (LAS float*)(L + RG2_XF_OFF); LAS float* carr = (LAS float*)(L + RG2_CARR_OFF);
    const bf16* RX = (const bf16*)(F.ws + WS_RX); const bf16* RG = (const bf16*)(F.ws + WS_RGATE); bf16* RNN = (bf16*)((unsigned char*)F.out + OUT_ARN) + 512;
    const float* conv_w = F.in[6]; const float* conv_b = F.in[7]; const float* rg_wa = F.in[8]; const float* rg_ba = F.in[9]; const float* rg_wx = F.in[10]; const float* rg_bx = F.in[11]; const float* lam = F.in[12];
    for (int task = F.vcu; task < NB * 32; task += F.G) {
        const int b = task >> 5, nb = (task >> 1) & 15, hf = task & 1, c0 = nb * 64, e0 = 32 * hf;
        __syncthreads();
        for (int i = tid; i < 2048; i += NWAVES * 64) { const int d = i >> 5, e = i & 31;
            *(LAS bf16*)(L + RG_WA_OFF + e * RG_WT_PITCH + d * 2) = (bf16)f2bf(rg_wa[(size_t)nb * 4096 + d * 64 + e0 + e]);
            *(LAS bf16*)(L + RG_WX_OFF + e * RG_WT_PITCH + d * 2) = (bf16)f2bf(rg_wx[(size_t)nb * 4096 + d * 64 + e0 + e]); }
        const int c = c0 + lane;
        const float cw0 = conv_w[c], cw1 = conv_w[1024 + c], cw2 = conv_w[2048 + c], cw3 = conv_w[3072 + c], cb = conv_b[c];
        const bool mine = (lane >> 5) == hf;
        float bav[2], bxv[2], lsl[2];
#pragma unroll
        for (int j = 0; j < 2; ++j) { const int ce = c0 + e0 + 16 * j + n16; bav[j] = rg_ba[ce]; bxv[j] = rg_bx[ce]; lsl[j] = -8.0f * 1.4426950408889634f * log1pf(__expf(-lam[ce])); }
        float hst[2] = {0.f, 0.f};
        const float nba[2] = {-1.4426950408889634f * bav[0], -1.4426950408889634f * bav[1]}, nbx[2] = {-1.4426950408889634f * bxv[0], -1.4426950408889634f * bxv[1]};
        __syncthreads();
        LAS unsigned char* stg = L + RG2_STG_OFF + wave * RG2_STG_WAVE;
        LAS float* xf_w = Xf + (wave * 32) * 32 + (lane & 31); LAS unsigned char* xcb_w = L + RG2_XCB_OFF + (wave * 32) * RG_WT_PITCH + lane * 2;
        asm volatile("" : "+v"(xf_w), "+v"(xcb_w));
        const int xr_row = lane >> 3, xr_c8 = lane & 7, gt_tok = lane >> 2, gt_c8 = lane & 3;
        v4u xq[2][5], gq[2][2];
        const GAS unsigned char* rxb = (const GAS unsigned char*)(RX + (size_t)b * SEQ * 1024 + c0); const GAS unsigned char* rgb = (const GAS unsigned char*)(RG + (size_t)b * SEQ * 1024 + c0 + e0);
        GAS unsigned char* rnb = (GAS unsigned char*)(RNN + (size_t)b * SEQ * 1536 + c0 + e0);
        const unsigned xoff = (unsigned)(xr_row * 1024 + xr_c8 * 8) * 2u, goff = (unsigned)(gt_tok * 1024 + gt_c8 * 8) * 2u, ooff = (unsigned)(gt_tok * 1536 + gt_c8 * 8) * 2u;
#pragma unroll
        for (int pc = 0; pc < 2; ++pc) { const int t0 = pc * 256 + wave * 32;
#pragma unroll
            for (int i = 0; i < 5; ++i) { const int ri = 8 * i + xr_row, t = t0 - 3 + ri; xq[pc][i] = (v4u){0u, 0u, 0u, 0u};
                if (ri < 35 && t >= 0) xq[pc][i] = *(const GAS v4u*)(rxb + (unsigned)((t0 - 3 + 8 * i) * 2048 + (int)xoff)); }
#pragma unroll
            for (int i = 0; i < 2; ++i) gq[pc][i] = *(const GAS v4u*)(rgb + (unsigned)((t0 + 16 * i) * 2048 + (int)goff)); }
#pragma unroll 1
        for (int ch = 0; ch < SEQ / 256; ++ch) {
            const int t0 = ch * 256 + wave * 32;
#pragma unroll
            for (int i = 0; i < 5; ++i) { if (8 * i + xr_row < 35) *(LAS v4u*)(stg + (8 * i + xr_row) * 128 + xr_c8 * 16) = xq[0][i]; }
#pragma unroll
            for (int i = 0; i < 2; ++i) *(LAS v4u*)(stg + 35 * 128 + (16 * i + gt_tok) * 64 + gt_c8 * 16) = gq[0][i];
#pragma unroll
            for (int i = 0; i < 5; ++i) xq[0][i] = xq[1][i];
            gq[0][0] = gq[1][0]; gq[0][1] = gq[1][1];
            if (ch + 2 < SEQ / 256) {
#pragma unroll
                for (int i = 0; i < 5; ++i) { const int ri = 8 * i + xr_row; if (ri < 35) xq[1][i] = *(const GAS v4u*)(rxb + (unsigned)((t0 + 512 - 3 + 8 * i) * 2048 + (int)xoff)); }
#pragma unroll
                for (int i = 0; i < 2; ++i) gq[1][i] = *(const GAS v4u*)(rgb + (unsigned)((t0 + 512 + 16 * i) * 2048 + (int)goff));
            }
            asm volatile("s_waitcnt lgkmcnt(0)" ::: "memory");
            { float xv[35];
#pragma unroll
              for (int i = 0; i < 35; ++i) xv[i] = bf2f(*(const LAS unsigned short*)(stg + i * 128 + lane * 2));
              float xo[32];
#pragma unroll
              for (int i = 0; i < 32; i += 2) { xo[i] = cb + cw0 * xv[i] + cw1 * xv[i + 1] + cw2 * xv[i + 2] + cw3 * xv[i + 3]; xo[i + 1] = cb + cw0 * xv[i + 1] + cw1 * xv[i + 2] + cw2 * xv[i + 3] + cw3 * xv[i + 4];
                  const unsigned pk = pg8::cvt_pk_bf16_av(xo[i], xo[i + 1]);
                  *(LAS bf16*)(xcb_w + i * RG_WT_PITCH) = (bf16)(pk & 0xFFFFu); *(LAS bf16*)(xcb_w + (i + 1) * RG_WT_PITCH) = (bf16)(pk >> 16); }
              if (mine) {
#pragma unroll
                  for (int i = 0; i < 32; ++i) xf_w[i * 32] = xo[i]; } }
            float gcur[2][2][4];
#pragma unroll
            for (int s = 0; s < 2; ++s)
#pragma unroll
                for (int j = 0; j < 2; ++j)
#pragma unroll
                    for (int r = 0; r < 4; ++r) gcur[s][j][r] = bf2f(*(const LAS unsigned short*)(stg + 35 * 128 + (16 * s + 4 * kg + r) * 64 + (16 * j + n16) * 2));
            asm volatile("s_waitcnt lgkmcnt(0)" ::: "memory");
            float av[2][2][4], bv[2][2][4], Pe[2][2], He[2][2], Pt[2][2], Ht[2][2];
#pragma unroll
            for (int s = 0; s < 2; ++s) {
                bx8 af[2];
#pragma unroll
                for (int ks = 0; ks < 2; ++ks) af[ks] = *(const LAS bx8*)(L + RG2_XCB_OFF + (wave * 32 + 16 * s + n16) * RG_WT_PITCH + (32 * ks + 8 * kg) * 2);
#pragma unroll
                for (int j = 0; j < 2; ++j) {
                    f32x4 cr = (f32x4){0.f, 0.f, 0.f, 0.f}, ci = (f32x4){0.f, 0.f, 0.f, 0.f};
#pragma unroll
                    for (int ks = 0; ks < 2; ++ks) {
                        const bx8 wa_f = *(const LAS bx8*)(L + RG_WA_OFF + (16 * j + n16) * RG_WT_PITCH + (32 * ks + 8 * kg) * 2);
                        const bx8 wx_f = *(const LAS bx8*)(L + RG_WX_OFF + (16 * j + n16) * RG_WT_PITCH + (32 * ks + 8 * kg) * 2);
                        cr = __builtin_amdgcn_mfma_f32_16x16x32_bf16(af[ks], wa_f, cr, 0, 0, 0);
                        ci = __builtin_amdgcn_mfma_f32_16x16x32_bf16(af[ks], wx_f, ci, 0, 0, 0);
                    }
                    float p = 1.f, h = 0.f;
#pragma unroll
                    for (int r = 0; r < 4; ++r) {
                        const float rr = __builtin_amdgcn_rcpf(1.0f + __builtin_amdgcn_exp2f(__builtin_fmaf(cr[r], -1.4426950408889634f, nba[j]))), ig = __builtin_amdgcn_rcpf(1.0f + __builtin_amdgcn_exp2f(__builtin_fmaf(ci[r], -1.4426950408889634f, nbx[j])));
                        const float l2 = rr * lsl[j];
                        const float a = __builtin_amdgcn_exp2f(l2);
                        const float oma = __builtin_fmaf(-a, a, 1.0f);
                        const float xcv = Xf[(wave * 32 + 16 * s + 4 * kg + r) * 32 + 16 * j + n16];
                        const float bb = __builtin_amdgcn_sqrtf(oma) * (ig * xcv);
                        av[s][j][r] = a; bv[s][j][r] = bb; h = a * h + bb; p *= a;
                    }
                    float P = p, H = h;
                    { const float p1 = __shfl_up(P, 16), h1 = __shfl_up(H, 16); if (kg >= 1) { H = P * h1 + H; P = P * p1; } }
                    { const float p2 = __shfl_up(P, 32), h2 = __shfl_up(H, 32); if (kg >= 2) { H = P * h2 + H; P = P * p2; } }
                    const float pe = __shfl_up(P, 16), he = __shfl_up(H, 16);
                    Pe[s][j] = kg >= 1 ? pe : 1.f; He[s][j] = kg >= 1 ? he : 0.f;
                    Pt[s][j] = __shfl(P, 48 + n16); Ht[s][j] = __shfl(H, 48 + n16);
                }
            }
#pragma unroll
            for (int j = 0; j < 2; ++j)
                if (kg == 3) { LAS float* cw_ = carr + (ch & 1) * 512 + wave * 64 + j * 32; cw_[n16] = Pt[1][j] * Pt[0][j]; cw_[16 + n16] = Pt[1][j] * Ht[0][j] + Ht[1][j]; }
            __syncthreads();
#pragma unroll
            for (int j = 0; j < 2; ++j) {
                const LAS float* cr_ = carr + (ch & 1) * 512 + j * 32;
                float cin = 0.f, cc = hst[j];
#pragma unroll
                for (int w2 = 0; w2 < 8; ++w2) { if (w2 == wave) cin = cc; cc = cr_[w2 * 64 + n16] * cc + cr_[w2 * 64 + 16 + n16]; }
                hst[j] = cc;
#pragma unroll
                for (int s = 0; s < 2; ++s) {
                    const float sin_ = s == 0 ? cin : Pt[0][j] * cin + Ht[0][j];
                    float h = Pe[s][j] * sin_ + He[s][j];
#pragma unroll
                    for (int r = 0; r < 4; ++r) { h = av[s][j][r] * h + bv[s][j][r];
                        const float g = gcur[s][j][r];
#if GATE_GELU
                        *(LAS bf16*)(stg + 35 * 128 + 2048 + (16 * s + 4 * kg + r) * 64 + (16 * j + n16) * 2) = (bf16)f2bf(h * g); }
#else
                        const float e2 = g * __builtin_fmaf(g * g, -2.0f * 0.7978845608028654f * 1.4426950408889634f * 0.044715f, -2.0f * 0.7978845608028654f * 1.4426950408889634f);
                        *(LAS bf16*)(stg + 35 * 128 + 2048 + (16 * s + 4 * kg + r) * 64 + (16 * j + n16) * 2) = (bf16)f2bf((h * g) * __builtin_amdgcn_rcpf(1.0f + __builtin_amdgcn_exp2f(e2))); }
#endif
                }
            }
            asm volatile("s_waitcnt lgkmcnt(0)" ::: "memory");
#pragma unroll
            for (int i = 0; i < 2; ++i) { const v4u o = *(const LAS v4u*)(stg + 35 * 128 + 2048 + (16 * i + gt_tok) * 64 + gt_c8 * 16);
              *(GAS v4u*)(rnb + (unsigned)((t0 + 16 * i) * 3072 + (int)ooff)) = o; }
        }
    }
}
__device__ __forceinline__ void p_fixup_items(Frame& F, int first, int last, int gt, int NGT);
__device__ __forceinline__ void p_fixup(Frame& F) {
    const bf16* HALO = (const bf16*)(F.ws + WS_HALO); bf16* H = (bf16*)(F.ws + WS_H);
    const float* fw = F.in[18]; const float* fb = F.in[19];
    p_fixup_items(F, 0, (M / 256) * (DFF / 4), F.vcu * (NWAVES * 64) + F.tid, F.G * NWAVES * 64);
}
__device__ __forceinline__ void p_fixup_items(Frame& F, int first, int last, int gt, int NGT) {
    const bf16* HALO = (const bf16*)(F.ws + WS_HALO); bf16* H = (bf16*)(F.ws + WS_H);
    const float* fw = F.in[18]; const float* fb = F.in[19];
    for (int it = first + gt; it < last; it += NGT) {
        const int pm = it / (DFF / 4), c = (it % (DFF / 4)) * 4;
        const int col = (c >> 7) * 256 + (c & 127);
        const bool hasprev = (pm % (SEQ / 256)) != 0;
        f32x4 u[4][2];
#pragma unroll
        for (int r = 0; r < 4; ++r)
#pragma unroll
            for (int gv = 0; gv < 2; ++gv) {
                u[r][gv] = (f32x4){0.f, 0.f, 0.f, 0.f};
                unsigned long long raw = 0ull;
                if (r >= 2) raw = *(const GAS unsigned long long*)(HALO + ((size_t)pm * 4 + (r - 2)) * NUP + col + gv * 128);
                else if (hasprev) raw = *(const GAS unsigned long long*)(HALO + ((size_t)(pm - 1) * 4 + 2 + r) * NUP + col + gv * 128);
                u[r][gv] = (f32x4){bflo((unsigned)raw), bfhi((unsigned)raw), bflo((unsigned)(raw >> 32)), bfhi((unsigned)(raw >> 32))};
            }
        f32x4 w[3][2], bb[2];
#pragma unroll
        for (int gv = 0; gv < 2; ++gv) { bb[gv] = *(const GAS f32x4*)(fb + gv * DFF + c);
#pragma unroll
            for (int j = 0; j < 3; ++j) w[j][gv] = *(const GAS f32x4*)(fw + (size_t)j * NUP + gv * DFF + c); }
#pragma unroll
        for (int r = 0; r < 2; ++r) {
            const f32x4 yg = bb[0] + w[0][0] * u[r][0] + w[1][0] * u[r + 1][0] + w[2][0] * u[r + 2][0];
            const f32x4 yv = bb[1] + w[0][1] * u[r][1] + w[1][1] * u[r + 1][1] + w[2][1] * u[r + 2][1];
            float hh[4];
#pragma unroll
            for (int i = 0; i < 4; ++i) hh[i] = yg[i] * sigmoid_f(yg[i]) * yv[i];
            *(GAS unsigned long long*)(H + (size_t)(pm * 256 + r) * DFF + c) = (unsigned long long)pk2(hh[0], hh[1]) | ((unsigned long long)pk2(hh[2], hh[3]) << 32);
        }
    }
}
#ifndef STAG_IN
#define STAG_IN 5
#endif
#ifndef STAG_XCD
#define STAG_XCD 0
#endif
#ifndef STAG_N
#define STAG_N 3
#endif
#ifndef STAG_UP
#define STAG_UP 5
#endif
__device__ __forceinline__ void phase_stagger(Frame& F, int us) {
    const int g = STAG_XCD ? ((int)blockIdx.x & (STAG_XCD - 1)) : (((int)blockIdx.x >> 3) & 3);
    if (us > 0 && g) {
        if (F.tid == 0) { const unsigned long long t0 = wall_clock64(), dt = (unsigned long long)(g * us) * 100ull; while (wall_clock64() - t0 < dt) __builtin_amdgcn_s_sleep(4); }
        __syncthreads();
    }
}
#ifndef PG8_ALIGN
#define PG8_ALIGN true
#endif
#ifndef PG8_SP2
#define PG8_SP2 true
#endif
#ifndef PT_WG
#define PT_WG 0
#endif
#ifndef PHASE_T
#define PHASE_T (-1)
#endif
#if PHASE_T >= 0
#define PT_MARK(k) do { if (blockIdx.x == PT_WG && threadIdx.x == 0) { asm volatile("s_waitcnt vmcnt(0) lgkmcnt(0)" ::: "memory"); const unsigned long long t_ = __builtin_amdgcn_s_memrealtime(); asm volatile("s_waitcnt lgkmcnt(0)" ::: "memory"); \
    if (PHASE_T == 98) { if ((k) == 99) pt_t0 = t_; if ((k) == 11) pt_d = t_ - pt_t0; } else { if (pt_open) { pt_d = t_ - pt_t0; pt_open = false; } if ((k) == PHASE_T) { pt_t0 = t_; pt_open = true; } } } } while (0)
#define PT_FINISH() do { if (blockIdx.x == PT_WG && threadIdx.x == 0) { const unsigned long long t0_ = wall_clock64(); while (wall_clock64() - t0_ < pt_d) __builtin_amdgcn_s_sleep(8); } } while (0)
#else
#define PT_MARK(k) do { } while (0)
#define PT_FINISH() do { } while (0)
#endif
struct Args { const float* in[21]; float* out; unsigned char* ws; int ph_lo, ph_hi, li, pad; };
static_assert(sizeof(Args) == 23 * 8 + 16, "Args has no padding");
__global__ void __launch_bounds__(NWAVES * 64, 2) mk_fwd(Args args) {
    extern __shared__ __attribute__((aligned(16))) unsigned char lds[];
    Frame F;
    F.lds = (LAS unsigned char*)lds;
    F.MISC = (volatile LAS unsigned*)(F.lds + MISC_OFF);
    F.tid = threadIdx.x; F.lane = F.tid & 63; F.wave = __builtin_amdgcn_readfirstlane(F.tid >> 6);
    F.G = gridDim.x; { const int bx = blockIdx.x; F.vcu = (F.G % 8 == 0) ? (bx % 8) * (F.G / 8) + bx / 8 : bx; }
    unsigned long long pt_t0 = 0ull, pt_d = 0ull; bool pt_open = false; (void)pt_t0; (void)pt_d; (void)pt_open;
    PT_MARK(99);
    F.ws = args.ws; F.out = args.out; F.ctl = (gu32*)(args.ws + WS_CTL);
#pragma unroll
    for (int i = 0; i < 21; ++i) F.in[i] = args.in[i];
    for (int u = F.tid; u < (LDS_BYTES - LDSCTL_OFF) / 4; u += NWAVES * 64) ((LAS unsigned*)(F.lds + LDSCTL_OFF))[u] = 0u;
    __syncthreads();
    XcdBarrier bar; bar.bar = (unsigned*)(F.ctl + CW_BAR) + args.li * XCD_BAR_WORDS; bar.x = 0; bar.st = nullptr;
    if (MK_ONE_LAUNCH) bar = xcd_barrier_post((unsigned*)(F.ctl + CW_BAR) + args.li * XCD_BAR_WORDS, F.MISC + 8);
#define GRID_BAR() do { if (MK_ONE_LAUNCH) xcd_barrier(bar); } while (0)
    const int lo = args.ph_lo, hi = args.ph_hi;
#ifndef PHASE_MASK
#define PHASE_MASK 0x1FFFF
#endif
#define IN(k) ((((PHASE_MASK) >> (k)) & 1) && lo <= (k) && (k) < hi)
#define BOTH(k) (IN(k) && IN((k) + 1))
    unsigned char* ws = args.ws;
    typedef pg8::bf16_t pbf;

    PT_MARK(0);
    if (IN(0)) { p0_prologue(F); PT_MARK(12); p0_prologue_x(F); if (BOTH(0)) GRID_BAR(); }

    PT_MARK(1);
    if (IN(1)) {
        pg8::Gemm g{(const pbf*)(ws + WS_XB), (const pbf*)(ws + WS_WIN), M, NIN, 1024}; pg8::StaticOrder S; S.init(M, NIN, F.G, (int)blockIdx.x);
        pg8::EpiIn E{(pbf*)(ws + WS_PA), (pbf*)(ws + WS_RX), (size_t)(WS_RGATE - WS_RX) / 2, (const float*)(ws + WS_RINV1), (unsigned char*)F.out + OUT_KV, (pbf*)(ws + WS_KI), (float*)(ws + WS_WI), (const float*)(ws + WS_GAINS)};
        phase_stagger(F, STAG_IN);
        pg8::gemm_phase<pg8::EpiIn, pg8::StaticOrder, PG8_ALIGN, PG8_SP2>(F.lds + RING_OFF, g, S, E);
        if (p0_defer(F.G) && blockIdx.x >= 128) p0_transposes(F, P0_I_IN, P0_NITEMS, ((int)blockIdx.x - 128) * NWAVES + F.wave, 128 * NWAVES);
        PT_MARK(13);
        if (BOTH(1)) GRID_BAR();
    }
#ifndef RG_V2
#define RG_V2 1
#endif
#ifndef YOUNG_PRIO
#define YOUNG_PRIO 0
#endif
    if (YOUNG_PRIO && F.wave >= 4) __builtin_amdgcn_s_setprio(1);
    PT_MARK(3);
    if (IN(3)) { if (RG_V2) p4_rglru2(F); else p4_rglru(F); }
    PT_MARK(4);
    if (IN(4)) { p3_topk(F, args.li); PT_MARK(14); if (BOTH(4)) GRID_BAR(); }
#if TKPROBE == 9
    if (F.vcu == 0 && F.tid == 0) { const unsigned nfb = __hip_atomic_load(F.ctl + CW_QUEUE + 32, RLX_AGENT); const unsigned long long t0 = wall_clock64(); while (wall_clock64() - t0 < (unsigned long long)nfb * 100ull) __builtin_amdgcn_s_sleep(8); }
#endif
#if TKPROBE >= 31 && TKPROBE <= 33
    if (F.vcu == 0 && F.tid == 0) { const unsigned nfb = __hip_atomic_load(F.ctl + CW_QUEUE + 32, RLX_AGENT); const unsigned long long t0 = wall_clock64(); while (wall_clock64() - t0 < (unsigned long long)(nfb >> 11)) __builtin_amdgcn_s_sleep(8); }
#endif
#if TKPROBE == 21
    if (F.vcu == 0 && F.tid == 0) { const unsigned nfb = __hip_atomic_load(F.ctl + CW_QUEUE + 32, RLX_AGENT); const unsigned long long t0 = wall_clock64(); while (wall_clock64() - t0 < (unsigned long long)(nfb >> 10) * 100ull) __builtin_amdgcn_s_sleep(8); }
#endif
    PT_MARK(5);
    if (IN(5)) { p4_attn(F); if (BOTH(5)) GRID_BAR(); }
    if (YOUNG_PRIO) __builtin_amdgcn_s_setprio(0);
    PT_MARK(6);
    if (IN(6)) {
        pg8::Gemm g{(const pbf*)((unsigned char*)F.out + OUT_ARN), (const pbf*)(ws + WS_WOA), M, 1024, 1536}; pg8::StaticOrder S; S.init(M, 1024, F.G, (int)blockIdx.x);
        pg8::EpiMerge E{(pbf*)(ws + WS_MERGED), (const unsigned char*)(ws + WS_GA), (const unsigned char*)(ws + WS_GB)};
        phase_stagger(F, STAG_N);
        pg8::gemm_phase<pg8::EpiMerge, pg8::StaticOrder, PG8_ALIGN, PG8_SP2>(F.lds + RING_OFF, g, S, E);
        if (BOTH(6)) GRID_BAR();
    }
    PT_MARK(7);
    if (IN(7)) {
        pg8::Gemm g{(const pbf*)(ws + WS_MERGED), (const pbf*)(ws + WS_WOUT), M, 1024, 1024}; pg8::StaticOrder S; S.init(M, 1024, F.G, (int)blockIdx.x);
        pg8::EpiRes E{(const pbf*)(ws + WS_XB), (const float*)(ws + WS_RINV1), (pbf*)(ws + WS_X1B), (float*)(ws + WS_SSQ2)};
        phase_stagger(F, STAG_N);
        pg8::gemm_phase<pg8::EpiRes, pg8::StaticOrder, PG8_ALIGN, PG8_SP2>(F.lds + RING_OFF, g, S, E);
        if (BOTH(7)) GRID_BAR();
    }
    PT_MARK(8);
    if (IN(8)) {
        pg8::Gemm g{(const pbf*)(ws + WS_X1B), (const pbf*)(ws + WS_WUP), M, NUP, 1024}; pg8::StaticOrder S; S.init(M, NUP, F.G, (int)blockIdx.x);
#ifndef UP_INREG
#define UP_INREG 1
#endif
#if UP_INREG
        pg8::EpiUpR E{(pbf*)(ws + WS_H), (pbf*)(ws + WS_HALO), (const float*)(ws + WS_SSQ2), F.in[18], F.in[19], F.lds + XSLAB_OFF, DFF};
        phase_stagger(F, STAG_UP);
        pg8::gemm_phase<pg8::EpiUpR, pg8::StaticOrder, true, PG8_SP2>(F.lds + RING_OFF, g, S, E);
#else
        pg8::EpiUp E{(pbf*)(ws + WS_H), (pbf*)(ws + WS_HALO), (pbf*)(ws + WS_SCR) + (size_t)blockIdx.x * 65536, (const float*)(ws + WS_SSQ2), F.in[18], F.in[19], DFF};
        pg8::gemm_phase<pg8::EpiUp, pg8::StaticOrder, true, PG8_SP2>(F.lds + RING_OFF, g, S, E);
#endif
        if (BOTH(8)) GRID_BAR();
    }
#ifndef FIXUP_FOLD
#define FIXUP_FOLD 0
#endif
    PT_MARK(9);
    if (!FIXUP_FOLD && IN(9)) { p_fixup(F); if (BOTH(9)) GRID_BAR(); }
    PT_MARK(10);
    if (IN(10)) {
        pg8::Gemm g{(const pbf*)(ws + WS_H), (const pbf*)(ws + WS_WDN), M, 1024, DFF}; pg8::StaticOrder S; S.init(M, 1024, F.G, (int)blockIdx.x);
        pg8::EpiAcc E{(const pbf*)(ws + WS_X1B), F.out};
        if (FIXUP_FOLD) {
            const int nun = (128 * 4 + F.G - 1) / F.G;
            for (int i = 0; i < nun; ++i) { pg8::Unit uu; uu.pm = 0; uu.pn = 0; const bool has = S.next(i, uu); const int pmv = has ? uu.pm : -1;
                if (pmv >= 0) p_fixup_items(F, pmv * (DFF / 4), (pmv + 1) * (DFF / 4), F.tid, NWAVES * 64); }
            asm volatile("s_waitcnt vmcnt(0)" ::: "memory"); __builtin_amdgcn_fence(__ATOMIC_RELEASE, "workgroup"); __syncthreads();
        }
        phase_stagger(F, STAG_N);
        pg8::gemm_phase<pg8::EpiAcc, pg8::StaticOrder, PG8_ALIGN, PG8_SP2>(F.lds + RING_OFF, g, S, E);
    }
#if PHASE_T == 10 || PHASE_T == 98
    GRID_BAR();
#endif
    PT_MARK(11); PT_FINISH();
#if defined(TKSTAGE) && TKSTAGE >= 0
    if (blockIdx.x == 0 && threadIdx.x == 0) { const unsigned d_ = __hip_atomic_load(F.ctl + CW_QUEUE + 40, RLX_AGENT); const unsigned long long t0_ = wall_clock64(); while (wall_clock64() - t0_ < (unsigned long long)d_) __builtin_amdgcn_s_sleep(8); }
#endif
#undef IN
#undef BOTH
}

extern "C" void kernel_launch(void* const* d_in, const int* in_sizes, int n_in, void* d_out, int out_size, void* d_ws, size_t ws_size, hipStream_t stream) {
    static int grid = 0;
    if (grid == 0) {
        if (n_in != 21 || out_size != M * DM || ws_size < WS_END) { fprintf(stderr, "kernel_launch: unexpected shapes: n_in %d out %d ws %zu (need %zu)\n", n_in, out_size, ws_size, (size_t)WS_END); grid = -1; return; }
        int dev = 0, cus = 0;
        if (hipGetDevice(&dev) != hipSuccess || hipDeviceGetAttribute(&cus, hipDeviceAttributeMultiprocessorCount, dev) != hipSuccess) { grid = -1; return; }
        if (hipFuncSetAttribute((const void*)mk_fwd, hipFuncAttributeMaxDynamicSharedMemorySize, LDS_BYTES) != hipSuccess) { fprintf(stderr, "kernel_launch: hipFuncSetAttribute failed\n"); grid = -1; return; }
        (void)hipGetLastError();
        grid = cus;
    }
    if (grid < 0) return;
    if (hipMemsetAsync((char*)d_ws + WS_CTL, 0, CTL_ZERO_BYTES, stream) != hipSuccess) return;
    Args a{};
    for (int i = 0; i < 21; ++i) a.in[i] = (const float*)d_in[i];
    a.out = (float*)d_out; a.ws = (unsigned char*)d_ws;
#if MK_ONE_LAUNCH && defined(PROBE_DUP_LO)
    a.ph_lo = 0; a.ph_hi = PROBE_DUP_HI + 1; a.li = 0; hipLaunchKernelGGL(mk_fwd, dim3(grid), dim3(NWAVES * 64), LDS_BYTES, stream, a);
    a.ph_lo = PROBE_DUP_LO; a.ph_hi = PROBE_DUP_HI + 1; a.li = 1; hipLaunchKernelGGL(mk_fwd, dim3(grid), dim3(NWAVES * 64), LDS_BYTES, stream, a);
    if (PROBE_DUP_HI + 1 < NPH) { a.ph_lo = PROBE_DUP_HI + 1; a.ph_hi = NPH; a.li = 2; hipLaunchKernelGGL(mk_fwd, dim3(grid), dim3(NWAVES * 64), LDS_BYTES, stream, a); }
#elif MK_ONE_LAUNCH
    a.ph_lo = 0; a.ph_hi = NPH;
    hipLaunchKernelGGL(mk_fwd, dim3(grid), dim3(NWAVES * 64), LDS_BYTES, stream, a);
#else
    for (int p = 0; p < NPH; ++p) { a.ph_lo = p; a.ph_hi = p + 1; hipLaunchKernelGGL(mk_fwd, dim3(grid), dim3(NWAVES * 64), LDS_BYTES, stream, a); }
#endif
}
```
